# Optimizing an MI355X kernel written in HIP

```python
import math
import jax, jax.numpy as jnp
from jax import lax
import numpy as np

D_MODEL = 1024
BATCH = 16
SEQ = 4096
DEPTH = 1

HEAD_DIM = 64
N_HEADS_FOX = 8
N_HEADS_DIL = 8
WIDTH_FOX = N_HEADS_FOX * HEAD_DIM
WIDTH_DIL = N_HEADS_DIL * HEAD_DIM
D_MIX = WIDTH_FOX + WIDTH_DIL
D_IN = 3 * WIDTH_FOX + N_HEADS_FOX + 3 * WIDTH_DIL
BLOCK = 128
DILATED_PATTERNS = ((128, 1), (512, 4), (2048, 16))
ROPE_THETA = 500000.0
ROPE_DIMS = HEAD_DIM // 4
D_FF = 2816
CONV_WIDTH = 3
DEEPNORM_ALPHA = (2.0 * DEPTH) ** 0.25
DEEPNORM_BETA = (8.0 * DEPTH) ** -0.25
LN_EPS = 1e-5
RMS_EPS = 1e-6

kernel_name = "fox_dilated_hybrid_deepnorm_block"


def _layer_norm(x, g, b):
    xf = x.astype(jnp.float32)
    mu = jnp.mean(xf, axis=-1, keepdims=True)
    var = jnp.mean(jnp.square(xf - mu), axis=-1, keepdims=True)
    y = (xf - mu) * lax.rsqrt(var + LN_EPS)
    return (y * g.astype(jnp.float32) + b.astype(jnp.float32)).astype(x.dtype)


def _head_rms_norm(o, gain):
    of = o.astype(jnp.float32)
    of = of * lax.rsqrt(jnp.mean(jnp.square(of), axis=-1, keepdims=True) + RMS_EPS)
    B, S, H, Dh = o.shape
    return (of.reshape(B, S, H * Dh) * gain.astype(jnp.float32)).astype(o.dtype)


def _partial_rotary(t, positions):
    half = ROPE_DIMS // 2
    freqs = ROPE_THETA ** (-jnp.arange(0, ROPE_DIMS, 2, dtype=jnp.float32) / ROPE_DIMS)
    ang = positions.astype(jnp.float32)[:, :, None] * freqs
    cos = jnp.cos(ang)[:, :, None, :]
    sin = jnp.sin(ang)[:, :, None, :]
    tf = t.astype(jnp.float32)
    t1, t2, rest = tf[..., :half], tf[..., half:ROPE_DIMS], tf[..., ROPE_DIMS:]
    rot = jnp.concatenate([t1 * cos - t2 * sin, t2 * cos + t1 * sin, rest], axis=-1)
    return rot.astype(t.dtype)


def _forgetting_attention(q, k, v, log_f):
    B, S, H, Dh = q.shape
    nb = S // BLOCK
    scale = Dh ** -0.5
    F = jnp.cumsum(log_f, axis=1).transpose(0, 2, 1)
    qh, kh, vh = (t.transpose(0, 2, 1, 3) for t in (q, k, v))
    q_blocks = jnp.moveaxis(qh.reshape(B, H, nb, BLOCK, Dh), 2, 0)
    F_blocks = jnp.moveaxis(F.reshape(B, H, nb, BLOCK), 2, 0)
    k_pos = jnp.arange(S)

    def one_block(args):
        qb, Fq, n = args
        s = jnp.einsum('bhqd,bhkd->bhqk', qb, kh).astype(jnp.float32) * scale
        s = s + Fq[..., :, None] - F[:, :, None, :]
        q_pos = n * BLOCK + jnp.arange(BLOCK)
        s = jnp.where(k_pos[None, :] <= q_pos[:, None], s, -jnp.inf)
        p = jax.nn.softmax(s, axis=-1)
        return jnp.einsum('bhqk,bhkd->bhqd', p.astype(vh.dtype), vh)

    o = lax.map(one_block, (q_blocks, F_blocks, jnp.arange(nb)))
    o = jnp.moveaxis(o, 0, 2).reshape(B, H, S, Dh)
    return o.transpose(0, 2, 1, 3)


def _dilated_pattern(q, k, v, dilation, steps):
    B, S, H, Dh = q.shape
    L = S // dilation
    BB = B * dilation
    scale = Dh ** -0.5

    def to_sub(t):
        return t.reshape(B, L, dilation, H, Dh).transpose(0, 2, 3, 1, 4).reshape(BB, H, L, Dh)

    nb = -(-L // BLOCK)
    Lp = nb * BLOCK
    pad = ((0, 0), (0, 0), (0, Lp - L), (0, 0))
    qs, ks, vs = (jnp.pad(to_sub(t), pad).reshape(BB, H, nb, BLOCK, Dh) for t in (q, k, v))
    blk_pad = ((0, 0), (0, 0), (1, 0), (0, 0), (0, 0))
    k_cat = jnp.concatenate([jnp.pad(ks, blk_pad)[:, :, :-1], ks], axis=3)
    v_cat = jnp.concatenate([jnp.pad(vs, blk_pad)[:, :, :-1], vs], axis=3)

    s = jnp.einsum('bhnqd,bhnkd->bhnqk', qs, k_cat).astype(jnp.float32) * scale
    qi = jnp.arange(BLOCK)[:, None]
    kj = jnp.arange(2 * BLOCK)[None, :]
    dist = qi + BLOCK - kj
    k_pos = jnp.arange(nb)[:, None, None] * BLOCK + kj - BLOCK
    mask = (dist >= 0) & (dist <= steps) & (k_pos >= 0)
    s = jnp.where(mask, s, -jnp.inf)
    m = jnp.max(s, axis=-1, keepdims=True)
    p = jnp.exp(s - m)
    l = jnp.sum(p, axis=-1, keepdims=True)
    o = jnp.einsum('bhnqk,bhnkd->bhnqd', (p / l).astype(v.dtype), v_cat)
    lse = (m + jnp.log(l))[..., 0]

    o = o.reshape(BB, H, Lp, Dh)[:, :, :L]
    o = o.reshape(B, dilation, H, L, Dh).transpose(0, 3, 1, 2, 4).reshape(B, S, H, Dh)
    lse = lse.reshape(BB, H, Lp)[:, :, :L]
    lse = lse.reshape(B, dilation, H, L).transpose(0, 3, 1, 2).reshape(B, S, H)
    return o, lse


def _dilated_attention(q, k, v):
    outs, lses = [], []
    for window, dilation in DILATED_PATTERNS:
        o, lse = _dilated_pattern(q, k, v, dilation, window // dilation)
        outs.append(o)
        lses.append(lse)
    w = jax.nn.softmax(jnp.stack(lses, axis=0), axis=0)
    o = jnp.sum(w[..., None] * jnp.stack(outs, axis=0).astype(jnp.float32), axis=0)
    return o.astype(q.dtype)


def _token_mixer(h, positions, w_in, b_fgate, gn_a, gn_b, w_out):
    B, S, _ = h.shape
    z = h @ w_in
    o0 = 0
    qa = z[..., o0:o0 + WIDTH_FOX]; o0 += WIDTH_FOX
    ka = z[..., o0:o0 + WIDTH_FOX]; o0 += WIDTH_FOX
    va = z[..., o0:o0 + WIDTH_FOX]; o0 += WIDTH_FOX
    fa = z[..., o0:o0 + N_HEADS_FOX]; o0 += N_HEADS_FOX
    qb = z[..., o0:o0 + WIDTH_DIL]; o0 += WIDTH_DIL
    kb = z[..., o0:o0 + WIDTH_DIL]; o0 += WIDTH_DIL
    vb = z[..., o0:o0 + WIDTH_DIL]

    heads = lambda t, H: t.reshape(B, S, H, HEAD_DIM)
    log_f = jax.nn.log_sigmoid((fa + b_fgate).astype(jnp.float32))
    oa = _forgetting_attention(heads(qa, N_HEADS_FOX), heads(ka, N_HEADS_FOX),
                               heads(va, N_HEADS_FOX), log_f)
    qb = _partial_rotary(heads(qb, N_HEADS_DIL), positions)
    kb = _partial_rotary(heads(kb, N_HEADS_DIL), positions)
    ob = _dilated_attention(qb, kb, heads(vb, N_HEADS_DIL))

    merged = jnp.concatenate([_head_rms_norm(oa, gn_a), _head_rms_norm(ob, gn_b)], axis=-1)
    return merged @ w_out


def _conv_ffn(h, w_up, conv_w, conv_b, w_down):
    u = h @ w_up
    up = jnp.pad(u, ((0, 0), (CONV_WIDTH - 1, 0), (0, 0)))
    S = h.shape[1]
    y = conv_b + sum(up[:, i:i + S] * conv_w[i] for i in range(CONV_WIDTH))
    a, g = jnp.split(y, 2, axis=-1)
    return (jax.nn.silu(g) * a) @ w_down


def setup_inputs(seed: int = 0) -> dict:
    key = jax.random.key(seed)
    ks = jax.random.split(key, 20)
    n = jax.random.normal
    f32 = jnp.float32
    x = n(ks[0], (BATCH, SEQ, D_MODEL), f32)
    c = n(ks[1], (BATCH, D_MODEL), f32)
    offset = jax.random.randint(ks[2], (BATCH, 1), 0, 1024, dtype=jnp.int32)
    positions = (offset + jnp.arange(SEQ, dtype=jnp.int32)[None, :]).astype(jnp.int32)
    w_ada = n(ks[3], (DEPTH, D_MODEL, 6 * D_MODEL), f32) * D_MODEL ** -0.5
    b_ada = 0.02 * n(ks[4], (DEPTH, 6 * D_MODEL), f32)
    w_in = n(ks[5], (DEPTH, D_MODEL, D_IN), f32) * D_MODEL ** -0.5
    b_fgate = jnp.linspace(1.0, 6.0, N_HEADS_FOX, dtype=f32)[None, :] + 0.1 * n(ks[6], (DEPTH, N_HEADS_FOX), f32)
    gn_a = 1.0 + 0.02 * n(ks[7], (DEPTH, WIDTH_FOX), f32)
    gn_b = 1.0 + 0.02 * n(ks[8], (DEPTH, WIDTH_DIL), f32)
    w_out = n(ks[9], (DEPTH, D_MIX, D_MODEL), f32) * D_MIX ** -0.5 * DEEPNORM_BETA
    ln1_g = 1.0 + 0.02 * n(ks[10], (DEPTH, D_MODEL), f32)
    ln1_b = 0.02 * n(ks[11], (DEPTH, D_MODEL), f32)
    w_up = n(ks[12], (DEPTH, D_MODEL, 2 * D_FF), f32) * D_MODEL ** -0.5
    conv_w = n(ks[13], (DEPTH, CONV_WIDTH, 2 * D_FF), f32) * CONV_WIDTH ** -0.5
    conv_b = 0.02 * n(ks[14], (DEPTH, 2 * D_FF), f32)
    w_down = n(ks[15], (DEPTH, D_FF, D_MODEL), f32) * D_FF ** -0.5 * DEEPNORM_BETA
    ln2_g = 1.0 + 0.02 * n(ks[16], (DEPTH, D_MODEL), f32)
    ln2_b = 0.02 * n(ks[17], (DEPTH, D_MODEL), f32)
    return {"x": x, "c": c, "positions": positions, "w_ada": w_ada, "b_ada": b_ada,
            "w_in": w_in, "b_fgate": b_fgate, "gn_a": gn_a, "gn_b": gn_b, "w_out": w_out,
            "ln1_g": ln1_g, "ln1_b": ln1_b, "w_up": w_up, "conv_w": conv_w, "conv_b": conv_b,
            "w_down": w_down, "ln2_g": ln2_g, "ln2_b": ln2_b}


def reference(x, c, positions, w_ada, b_ada, w_in, b_fgate, gn_a, gn_b, w_out,
              ln1_g, ln1_b, w_up, conv_w, conv_b, w_down, ln2_g, ln2_b):
    for l in range(DEPTH):
        ada = jax.nn.silu(c) @ w_ada[l] + b_ada[l]
        sh_a, sc_a, g_a, sh_f, sc_f, g_f = (t[:, None, :] for t in jnp.split(ada, 6, axis=-1))
        h = x * (1.0 + sc_a) + sh_a
        mix = _token_mixer(h, positions, w_in[l], b_fgate[l], gn_a[l], gn_b[l], w_out[l])
        x = _layer_norm(DEEPNORM_ALPHA * x + g_a * mix, ln1_g[l], ln1_b[l])
        h = x * (1.0 + sc_f) + sh_f
        ffn = _conv_ffn(h, w_up[l], conv_w[l], conv_b[l], w_down[l])
        x = _layer_norm(DEEPNORM_ALPHA * x + g_f * ffn, ln2_g[l], ln2_b[l])
    return x
```

```cpp
#include <hip/hip_runtime.h>
#include <hip/hip_cooperative_groups.h>
#include <cstdio>
#include <cstdint>
namespace cg = cooperative_groups;

#ifndef MK_SPLIT
#define MK_SPLIT 0
#endif

constexpr int NB = 16, SEQ = 4096, DM = 1024, MTOK = NB * SEQ;
constexpr int DIN = 3080, NZ = 3072;
constexpr int DFF = 2816, NUP = 5632;
constexpr int NH = 8, HD = 64;
constexpr float ALPHA = 1.189207115002721f;
constexpr float LOG2E = 1.4426950408889634f;
constexpr float QSCALE = 0.125f * LOG2E;
constexpr float LN_EPS = 1e-5f, RMS_EPS = 1e-6f;
constexpr int ZQA = 0, ZKA = 512, ZVA = 1024, ZQB = 1536, ZKB = 2048, ZVB = 2560;

#define LAS __attribute__((address_space(3)))
typedef unsigned short bf16raw;
typedef unsigned v4u __attribute__((ext_vector_type(4)));
typedef unsigned v2u __attribute__((ext_vector_type(2)));
typedef float v4f __attribute__((ext_vector_type(4)));
typedef float v2f __attribute__((ext_vector_type(2)));

__device__ __forceinline__ unsigned f2bf(float f) { unsigned u = __builtin_bit_cast(unsigned, f); return (u + 0x7fffu + ((u >> 16) & 1u)) >> 16; }
__device__ __forceinline__ unsigned pk2(float lo, float hi) { return f2bf(lo) | (f2bf(hi) << 16); }
__device__ __forceinline__ float bflo(unsigned w) { return __builtin_bit_cast(float, w << 16); }
__device__ __forceinline__ float bfhi(unsigned w) { return __builtin_bit_cast(float, w & 0xffff0000u); }
__device__ __forceinline__ float wave_sum(float v) {
#pragma unroll
    for (int o = 1; o < 64; o <<= 1) v += __shfl_xor(v, o);
    return v;
}

namespace pg8 {
#define PG8_LAS __attribute__((address_space(3)))
typedef unsigned short bf16_t;
typedef short bf16x8 __attribute__((ext_vector_type(8)));
typedef float f32x4 __attribute__((ext_vector_type(4)));
typedef unsigned u32x4 __attribute__((ext_vector_type(4)));
constexpr int BM = 256, BK = 64, HALF = 128, HTB = HALF * BK * 2  , STAGE_BYTES = 8 * HTB, NXCD = 8, WGM = 8;

__host__ __device__ __forceinline__ int lds_byte(int r, int c) { const int st = (r >> 4) * 2 + (c >> 5), rr = r & 15, cc = c & 31, ob = rr * 64 + cc * 2; return st * 1024 + (ob ^ (((ob >> 9) & 1) << 5)); }
__host__ __device__ __forceinline__ void stage_rc(int b, int& R, int& C) { const int st = b / 1024, sb = b % 1024, swz = sb ^ (((sb >> 9) & 1) << 5); R = (st >> 1) * 16 + swz / 64; C = (st & 1) * 32 + (swz % 64) / 2; }
__host__ __device__ __forceinline__ int perm32(int rho) { const int n = rho >> 4, i = rho & 15; return 8 * (i >> 2) + 4 * n + (i & 3); }

struct Unit { int pm, pn; };
struct Gemm { const bf16_t* A; const bf16_t* Bt; int M, N, K; };

struct StaticOrder {
    int nM, nN, nwg, G, c;
    __host__ __device__ void init(int M, int N, int G_, int c_) { nM = M / BM; nN = N / BM; nwg = nM * nN; G = G_; c = c_; }
    __host__ __device__ bool next(int i, Unit& u) const {
        const long L = (long)i * G + c; if (L >= nwg) return false;
        int wgid = (int)L; { const int q = nwg / NXCD, r = nwg % NXCD, xcd = wgid % NXCD, off = wgid / NXCD; wgid = (xcd < r ? xcd * (q + 1) : r * (q + 1) + (xcd - r) * q) + off; }
        const int nig = WGM * nN, gid = wgid / nig, fm = gid * WGM, gsz = (nM - fm) < WGM ? (nM - fm) : WGM;
        u.pm = fm + ((wgid % nig) % gsz); u.pn = (wgid % nig) / gsz; return true;
    }
    __device__ __forceinline__ void a_ready(const Unit&) const {}
    __device__ __forceinline__ void done(const Unit&) const {}
};

__device__ __forceinline__ unsigned cvt_pk_bf16(float lo, float hi) { unsigned r; asm volatile("v_cvt_pk_bf16_f32 %0, %1, %2" : "=v"(r) : "v"(lo), "v"(hi)); return r; }
typedef float f32x2 __attribute__((ext_vector_type(2)));

struct EpiIn {
    static constexpr bool PERM = true, AFTER_DRAIN = false;
    bf16_t* Z; const float* CS;
    __device__ __forceinline__ void operator()(const f32x4 (&acc)[2][2][4][2], const Unit& u, int wr, int wc, int fr, int fq) const {
        const int row0 = u.pm * BM + wr * 64 + fr, col0 = u.pn * BM + wc * 32 + 8 * fq;
        const bool isq = (u.pn < 2) || (u.pn == 6) || (u.pn == 7);
        const float sc = isq ? QSCALE : 1.0f;
        const bool rot = (u.pn >= 6) && (u.pn < 10) && ((wc & 1) == 0) && (fq < 2);
#pragma unroll
        for (int ai = 0; ai < 2; ++ai)
#pragma unroll
            for (int m = 0; m < 4; ++m) {
                const int row = row0 + ai * HALF + m * 16;
                f32x4 cs = (f32x4){1.f, 1.f, 1.f, 1.f}, sn = (f32x4){0.f, 0.f, 0.f, 0.f};
                if (rot) { cs = *(const f32x4*)(CS + (size_t)row * 16 + 4 * fq); sn = *(const f32x4*)(CS + (size_t)row * 16 + 8 + 4 * fq); }
                bf16_t* rowp = Z + (size_t)row * NZ + col0;
#pragma unroll
                for (int bj = 0; bj < 2; ++bj) {
                    f32x4 v0 = acc[ai][bj][m][0], v1 = acc[ai][bj][m][1];
                    const f32x4 t1 = v0 * cs - v1 * sn, t2 = v1 * cs + v0 * sn;
                    v0 = t1 * sc; v1 = t2 * sc;
                    u32x4 w; w.x = cvt_pk_bf16(v0[0], v0[1]); w.y = cvt_pk_bf16(v0[2], v0[3]); w.z = cvt_pk_bf16(v1[0], v1[1]); w.w = cvt_pk_bf16(v1[2], v1[3]);
                    *(u32x4*)(rowp + bj * HALF) = w;
                }
            }
    }
};
struct EpiOut {
    static constexpr bool PERM = false, AFTER_DRAIN = false;
    const float* x; float* y; const float* ada;
    __device__ __forceinline__ void operator()(const f32x4 (&acc)[2][2][4][2], const Unit& u, int wr, int wc, int fr, int fq) const {
        const int row0 = u.pm * BM + wr * 64 + fr, col0 = u.pn * BM + wc * 32 + 4 * fq;
        const float* ga = ada + (size_t)(u.pm >> 4) * (6 * DM) + 2 * DM + col0;
#pragma unroll
        for (int bj = 0; bj < 2; ++bj)
#pragma unroll
            for (int n = 0; n < 2; ++n) {
                const f32x4 g = *(const f32x4*)(ga + bj * HALF + n * 16);
#pragma unroll
                for (int ai = 0; ai < 2; ++ai)
#pragma unroll
                    for (int m = 0; m < 4; ++m) {
                        const size_t off = (size_t)(row0 + ai * HALF + m * 16) * DM + col0 + bj * HALF + n * 16;
                        const f32x4 xv = *(const f32x4*)(x + off);
                        *(f32x4*)(y + off) = xv * ALPHA + g * acc[ai][bj][m][n];
                    }
                asm volatile("" ::: "memory");
            }
    }
};
struct EpiRaw {
    static constexpr bool PERM = true, AFTER_DRAIN = false;
    bf16_t* O; int ldc;
    __device__ __forceinline__ void operator()(const f32x4 (&acc)[2][2][4][2], const Unit& u, int wr, int wc, int fr, int fq) const {
        const int row0 = u.pm * BM + wr * 64 + fr, col0 = u.pn * BM + wc * 32 + 8 * fq;
#pragma unroll
        for (int ai = 0; ai < 2; ++ai)
#pragma unroll
            for (int m = 0; m < 4; ++m) { bf16_t* rowp = O + (size_t)(row0 + ai * HALF + m * 16) * ldc + col0;
#pragma unroll
                for (int bj = 0; bj < 2; ++bj) { const f32x4 v0 = acc[ai][bj][m][0], v1 = acc[ai][bj][m][1];
                    u32x4 w; w.x = cvt_pk_bf16(v0[0], v0[1]); w.y = cvt_pk_bf16(v0[2], v0[3]); w.z = cvt_pk_bf16(v1[0], v1[1]); w.w = cvt_pk_bf16(v1[2], v1[3]);
                    *(u32x4*)(rowp + bj * HALF) = w; } }
    }
};
struct EpiDown {
    static constexpr bool PERM = false, AFTER_DRAIN = false;
    float* y; const float* st; const float* ada; const float* lng; const float* lnb;
    __device__ __forceinline__ void operator()(const f32x4 (&acc)[2][2][4][2], const Unit& u, int wr, int wc, int fr, int fq) const {
        const int row0 = u.pm * BM + wr * 64 + fr, col0 = u.pn * BM + wc * 32 + 4 * fq;
        const float* gf = ada + (size_t)(u.pm >> 4) * (6 * DM) + 5 * DM + col0;
        f32x2 sr[2][4];
#pragma unroll
        for (int ai = 0; ai < 2; ++ai)
#pragma unroll
            for (int m = 0; m < 4; ++m) sr[ai][m] = *(const f32x2*)(st + (size_t)(row0 + ai * HALF + m * 16) * 2);
#pragma unroll
        for (int bj = 0; bj < 2; ++bj)
#pragma unroll
            for (int n = 0; n < 2; ++n) {
                const int co = bj * HALF + n * 16;
                const f32x4 g = *(const f32x4*)(gf + co), lg = *(const f32x4*)(lng + col0 + co), lb = *(const f32x4*)(lnb + col0 + co);
#pragma unroll
                for (int ai = 0; ai < 2; ++ai)
#pragma unroll
                    for (int m = 0; m < 4; ++m) {
                        const size_t off = (size_t)(row0 + ai * HALF + m * 16) * DM + col0 + co;
                        const f32x4 yv = *(const f32x4*)(y + off);
                        const f32x4 x1 = (yv - sr[ai][m].x) * sr[ai][m].y * lg + lb;
                        *(f32x4*)(y + off) = x1 * ALPHA + g * acc[ai][bj][m][n];
                    }
                asm volatile("" ::: "memory");
            }
    }
};

template <class Epi, class Sched, bool ALIGN_EPI = false, bool SP2 = false>
__device__ __forceinline__ void gemm_phase(PG8_LAS unsigned char* lds, const Gemm g, const Sched& S, const Epi& E) {
    const int tid = threadIdx.x, wid = __builtin_amdgcn_readfirstlane(tid >> 6), lane = tid & 63, wr = wid >> 2, wc = wid & 3, fr = lane & 15, fq = lane >> 4;
    const int K = g.K, nt = K / BK;
    unsigned voffA[2], voffB[2];
#pragma unroll
    for (int i = 0; i < 2; ++i) { int R, C; stage_rc(tid * 16 + i * 8192, R, C); const int Rb = Epi::PERM ? ((R & ~31) + perm32(R & 31)) : R;
        voffA[i] = (unsigned)(R * K + C) * 2u; voffB[i] = (unsigned)(Rb * K + C) * 2u; }
    const size_t kstep = (size_t)(BK * 2);
    const size_t hstep = (size_t)HALF * K * 2;
    const size_t tstep = 2 * hstep;
    const unsigned ldsw = (unsigned)wid * 1024u;
    const int aoff = lds_byte(wr * 64 + fr, fq * 8), boff = lds_byte(wc * 32 + fr, fq * 8);
#define PG8_SA(b, h) (((b) * 2 + (h)) * HTB)
#define PG8_SB(b, h) ((4 + (b) * 2 + (h)) * HTB)
#define PG8_STAGE(bufoff, gbase, voff) do { _Pragma("unroll") for (int _i = 0; _i < 2; ++_i) \
        __builtin_amdgcn_global_load_lds((const unsigned*)((const char*)(gbase) + (voff)[_i]), (PG8_LAS unsigned*)(lds + (bufoff) + ldsw + _i * 8192), 16, 0, 0); } while (0)
#define PG8_LDA(dst, b, h) do { _Pragma("unroll") for (int m = 0; m < 4; ++m) _Pragma("unroll") for (int k = 0; k < 2; ++k) dst[m][k] = *(const PG8_LAS bf16x8*)(lds + PG8_SA(b, h) + aoff + m * 2048 + k * 1024); } while (0)
#define PG8_LDB(dst, b, h) do { _Pragma("unroll") for (int n = 0; n < 2; ++n) _Pragma("unroll") for (int k = 0; k < 2; ++k) dst[n][k] = *(const PG8_LAS bf16x8*)(lds + PG8_SB(b, h) + boff + n * 2048 + k * 1024); } while (0)
#define PG8_MMA(ai, bj, At, Bt) do { __builtin_amdgcn_s_setprio(1); _Pragma("unroll") for (int m = 0; m < 4; ++m) _Pragma("unroll") for (int n = 0; n < 2; ++n) _Pragma("unroll") for (int k = 0; k < 2; ++k) \
        acc[ai][bj][m][n] = __builtin_amdgcn_mfma_f32_16x16x32_bf16(Bt[n][k], At[m][k], acc[ai][bj][m][n], 0, 0, 0); __builtin_amdgcn_s_setprio(0); } while (0)
#define PG8_WAIT_V(n) asm volatile("s_waitcnt vmcnt(" #n ")" ::: "memory")
#define PG8_WAIT_L(n) asm volatile("s_waitcnt lgkmcnt(" #n ")" ::: "memory")
#define PG8_BAR __builtin_amdgcn_s_barrier()
#define PG8_SCHED __builtin_amdgcn_sched_barrier(0)
    Unit cur, nxt; int ui = 0;
    if (!S.next(0, cur)) return;
    f32x4 acc[2][2][4][2];
#pragma unroll
    for (int a = 0; a < 2; ++a)
#pragma unroll
        for (int b = 0; b < 2; ++b)
#pragma unroll
            for (int m = 0; m < 4; ++m)
#pragma unroll
                for (int n = 0; n < 2; ++n) acc[a][b][m][n] = (f32x4){0.f, 0.f, 0.f, 0.f};
    bf16x8 At[4][2], B0[2][2], B1[2][2];
    const char* cA = (const char*)g.A + (size_t)cur.pm * tstep; const char* cB = (const char*)g.Bt + (size_t)cur.pn * tstep;
    S.a_ready(cur);
    if constexpr (SP2) {
        PG8_STAGE(PG8_SB(0, 0), cB, voffB); PG8_STAGE(PG8_SB(0, 1), cB + hstep, voffB); PG8_STAGE(PG8_SA(0, 0), cA, voffA); PG8_STAGE(PG8_SA(0, 1), cA + hstep, voffA);
        if (wr == 1) PG8_BAR;
        PG8_WAIT_V(2); PG8_BAR;
        PG8_STAGE(PG8_SB(1, 0), cB + kstep, voffB); PG8_STAGE(PG8_SA(1, 0), cA + kstep, voffA); PG8_STAGE(PG8_SB(1, 1), cB + hstep + kstep, voffB);
        PG8_WAIT_V(6); PG8_BAR;
    } else {
        PG8_STAGE(PG8_SB(0, 0), cB, voffB); PG8_STAGE(PG8_SA(0, 0), cA, voffA); PG8_STAGE(PG8_SB(0, 1), cB + hstep, voffB); PG8_STAGE(PG8_SA(0, 1), cA + hstep, voffA);
        if (wr == 1) PG8_BAR;
        PG8_WAIT_V(4); PG8_BAR;
        PG8_STAGE(PG8_SB(1, 0), cB + kstep, voffB); PG8_STAGE(PG8_SA(1, 0), cA + kstep, voffA); PG8_STAGE(PG8_SB(1, 1), cB + hstep + kstep, voffB);
        PG8_WAIT_V(6); PG8_BAR;
    }
    for (;;) {
        const bool has_next = S.next(ui + 1, nxt);
        const char* nA = has_next ? (const char*)g.A + (size_t)nxt.pm * tstep : cA; const char* nB = has_next ? (const char*)g.Bt + (size_t)nxt.pn * tstep : cB;
        for (int t = 0; t < nt; t += 2) {
            const bool last = (t == nt - 2);
            const char* a1 = cA + (size_t)(t + 1) * kstep;
            const char* a2 = last ? nA : cA + (size_t)(t + 2) * kstep; const char* b2 = last ? nB : cB + (size_t)(t + 2) * kstep;
            const char* a3 = a2 + kstep; const char* b3 = b2 + kstep;
            if (last && has_next) S.a_ready(nxt);
            if constexpr (SP2) {
            PG8_LDB(B0, 0, 0); PG8_LDB(B1, 0, 1); PG8_SCHED; PG8_LDA(At, 0, 0); PG8_STAGE(PG8_SA(1, 1), a1 + hstep, voffA);
            PG8_WAIT_V(8); PG8_WAIT_L(0); PG8_BAR; PG8_MMA(0, 0, At, B0); PG8_MMA(0, 1, At, B1); PG8_BAR; PG8_SCHED;
            PG8_LDA(At, 0, 1); PG8_STAGE(PG8_SB(0, 0), b2, voffB); PG8_STAGE(PG8_SB(0, 1), b2 + hstep, voffB); PG8_STAGE(PG8_SA(0, 0), a2, voffA);
            PG8_WAIT_V(8); PG8_WAIT_L(0); PG8_BAR; PG8_MMA(1, 0, At, B0); PG8_MMA(1, 1, At, B1); PG8_BAR; PG8_SCHED;
            PG8_LDB(B0, 1, 0); PG8_LDB(B1, 1, 1); PG8_SCHED; PG8_LDA(At, 1, 0); PG8_STAGE(PG8_SA(0, 1), a2 + hstep, voffA);
            PG8_WAIT_V(8); PG8_WAIT_L(0); PG8_BAR; PG8_MMA(0, 0, At, B0); PG8_MMA(0, 1, At, B1); PG8_BAR; PG8_SCHED;
            PG8_LDA(At, 1, 1); PG8_STAGE(PG8_SB(1, 0), b3, voffB); PG8_STAGE(PG8_SB(1, 1), b3 + hstep, voffB); PG8_STAGE(PG8_SA(1, 0), a3, voffA);
            PG8_WAIT_V(8); PG8_WAIT_L(0); PG8_BAR; PG8_MMA(1, 0, At, B0); PG8_MMA(1, 1, At, B1); PG8_BAR; PG8_SCHED;
            } else {
            PG8_LDB(B0, 0, 0); PG8_SCHED; PG8_LDA(At, 0, 0); PG8_STAGE(PG8_SA(1, 1), a1 + hstep, voffA);
            PG8_WAIT_L(8); PG8_BAR; PG8_WAIT_L(0); PG8_MMA(0, 0, At, B0); PG8_BAR; PG8_SCHED;
            PG8_LDB(B1, 0, 1); PG8_STAGE(PG8_SB(0, 0), b2, voffB);
            PG8_BAR; PG8_WAIT_L(0); PG8_MMA(0, 1, At, B1); PG8_BAR;
            PG8_LDA(At, 0, 1); PG8_STAGE(PG8_SA(0, 0), a2, voffA);
            PG8_BAR; PG8_WAIT_L(0); PG8_MMA(1, 0, At, B0); PG8_BAR; PG8_SCHED;
            PG8_STAGE(PG8_SB(0, 1), b2 + hstep, voffB);
            PG8_WAIT_V(6); PG8_BAR; PG8_MMA(1, 1, At, B1); PG8_BAR;
            PG8_LDB(B0, 1, 0); PG8_SCHED; PG8_LDA(At, 1, 0); PG8_STAGE(PG8_SA(0, 1), a2 + hstep, voffA);
            PG8_WAIT_L(8); PG8_BAR; PG8_WAIT_L(0); PG8_MMA(0, 0, At, B0); PG8_BAR; PG8_SCHED;
            PG8_LDB(B1, 1, 1); PG8_STAGE(PG8_SB(1, 0), b3, voffB);
            PG8_BAR; PG8_WAIT_L(0); PG8_MMA(0, 1, At, B1); PG8_BAR;
            PG8_LDA(At, 1, 1); PG8_STAGE(PG8_SA(1, 0), a3, voffA);
            PG8_BAR; PG8_WAIT_L(0); PG8_MMA(1, 0, At, B0); PG8_BAR; PG8_SCHED;
            PG8_STAGE(PG8_SB(1, 1), b3 + hstep, voffB);
            PG8_WAIT_V(6); PG8_BAR; PG8_MMA(1, 1, At, B1); PG8_BAR;
            }
        }
        if constexpr (ALIGN_EPI) { if (wr == 0) PG8_BAR; }
        if constexpr (!Epi::AFTER_DRAIN) { E(acc, cur, wr, wc, fr, fq); S.done(cur); }
        if (!has_next) break;
#pragma unroll
        for (int a = 0; a < 2; ++a)
#pragma unroll
            for (int b = 0; b < 2; ++b)
#pragma unroll
                for (int m = 0; m < 4; ++m)
#pragma unroll
                    for (int n = 0; n < 2; ++n) acc[a][b][m][n] = (f32x4){0.f, 0.f, 0.f, 0.f};
        cur = nxt; cA = nA; cB = nB; ++ui;
        if constexpr (ALIGN_EPI) { if (wr == 1) PG8_BAR; }
    }
    PG8_WAIT_V(0);
    if constexpr (!ALIGN_EPI) { if (wr == 0) PG8_BAR; }
    PG8_BAR;
    if constexpr (Epi::AFTER_DRAIN) { E.fused(acc, cur, wr, wc, fr, fq, lds, wid, lane); S.done(cur); }
#undef PG8_SA
#undef PG8_SB
#undef PG8_STAGE
#undef PG8_LDA
#undef PG8_LDB
#undef PG8_MMA
#undef PG8_WAIT_V
#undef PG8_WAIT_L
#undef PG8_BAR
#undef PG8_SCHED
}
}

namespace att {
typedef short bf16x8 __attribute__((ext_vector_type(8)));
typedef short s16x4 __attribute__((ext_vector_type(4)));
typedef float f32x16 __attribute__((ext_vector_type(16)));
constexpr int LDS_K = 0, LDS_V = 8192, LDS_FB = 16384, LDS_WS = 16384 + 256, LDS_OST = 20480, OST_STRIDE = 68, OST_BYTES = 32 * OST_STRIDE * 4;
constexpr int LDS_TOTAL = LDS_OST + 8 * OST_BYTES;
constexpr float NEG = -1.0e30f;
__device__ __forceinline__ int crow(int r, int hi) { return (r & 3) + 8 * (r >> 2) + 4 * hi; }
__device__ __forceinline__ void glds16(const void* gsrc, unsigned lds_dst) { unsigned keep;
    asm volatile("s_mov_b32 %0, m0\n\ts_mov_b32 m0, %2\n\ts_nop 0\n\tglobal_load_lds_dwordx4 %1, off\n\ts_mov_b32 m0, %0" : "=&s"(keep) : "v"(gsrc), "s"(lds_dst) : "memory"); }
typedef float f32x2_t __attribute__((ext_vector_type(2))); typedef __bf16 bf16x2_t __attribute__((ext_vector_type(2)));
__device__ __forceinline__ unsigned cvtpk_s(float lo, float hi) { f32x2_t v = {lo, hi}; bf16x2_t b = __builtin_convertvector(v, bf16x2_t); return __builtin_bit_cast(unsigned, b); }
__device__ __forceinline__ void pv(f32x16* o, int vb, bf16x8 pa0, bf16x8 pa1, bf16x8 pa2, bf16x8 pa3) {
#pragma unroll
    for (int d0 = 0; d0 < 2; ++d0) { s16x4 lo[4], hi[4];
#pragma unroll
        for (int ks = 0; ks < 4; ++ks) {
            asm volatile("ds_read_b64_tr_b16 %0,%1 offset:%c2" : "=&v"(lo[ks]) : "v"(vb), "i"(d0 * 4096 + ks * 1024) : "memory");
            asm volatile("ds_read_b64_tr_b16 %0,%1 offset:%c2" : "=&v"(hi[ks]) : "v"(vb), "i"(d0 * 4096 + ks * 1024 + 512) : "memory"); }
        asm volatile("s_waitcnt lgkmcnt(0)" ::: "memory"); __builtin_amdgcn_sched_barrier(0);
#define ATT_PK(k) (bf16x8){lo[k][0], lo[k][1], lo[k][2], lo[k][3], hi[k][0], hi[k][1], hi[k][2], hi[k][3]}
        o[d0] = __builtin_amdgcn_mfma_f32_32x32x16_bf16(pa0, ATT_PK(0), o[d0], 0, 0, 0);
        o[d0] = __builtin_amdgcn_mfma_f32_32x32x16_bf16(pa1, ATT_PK(1), o[d0], 0, 0, 0);
        o[d0] = __builtin_amdgcn_mfma_f32_32x32x16_bf16(pa2, ATT_PK(2), o[d0], 0, 0, 0);
        o[d0] = __builtin_amdgcn_mfma_f32_32x32x16_bf16(pa3, ATT_PK(3), o[d0], 0, 0, 0);
#undef ATT_PK
    }
}
struct AUnit { int b, h, mode, pat, d, cls, i0, kt0, nt; };
constexpr int N_FOX_UNITS = NB * NH * (SEQ / 256), N_DIL_UNITS = NB * NH * 48, N_UNITS = N_FOX_UNITS + N_DIL_UNITS;
__device__ __forceinline__ AUnit decode_unit(int idx) {
    AUnit u;
    if (idx < N_FOX_UNITS) { const int qb = 15 - (idx >> 7), bh = idx & 127; u.b = bh >> 3; u.h = bh & 7; u.mode = 0; u.pat = 0; u.d = 1; u.cls = 0; u.i0 = 256 * qb; u.kt0 = 0; u.nt = 4 * (qb + 1); }
    else { const int j = idx - N_FOX_UNITS, bh = j / 48, r = j % 48; u.b = bh >> 3; u.h = bh & 7; u.mode = 1; u.nt = 6;
        if (r < 16) { u.pat = 0; u.d = 1; u.cls = 0; u.i0 = 256 * r; }
        else if (r < 32) { u.pat = 1; u.d = 4; u.cls = (r - 16) >> 2; u.i0 = 256 * ((r - 16) & 3); }
        else { u.pat = 2; u.d = 16; u.cls = r - 32; u.i0 = 0; }
        u.kt0 = u.i0 - 128; }
    return u;
}
__device__ __forceinline__ void attn_unit_simple(const AUnit U, const bf16raw* __restrict__ Z, const float* __restrict__ FABS, bf16raw* MG, const float* __restrict__ gn_a,
                                                 bf16raw* OP, float* LSE, LAS unsigned char* shm) {
    const int tid = threadIdx.x, lane = tid & 63, r32 = lane & 31, hi = lane >> 5; const int wid = __builtin_amdgcn_readfirstlane(tid >> 6);
    const long rowbase = (long)U.b * SEQ + U.cls;
    const int qcol = (U.mode == 0 ? ZQA : ZQB) + U.h * HD, kcol = qcol + 512, vcol = qcol + 1024;
    const int qi = U.i0 + wid * 32 + r32;
    const long qrow = rowbase + (long)qi * U.d;
    const unsigned lds0 = (unsigned)(uintptr_t)shm;
    LAS float* fb = (LAS float*)(shm + LDS_FB);
    LAS float* wsf = (LAS float*)(shm + LDS_WS) + wid * 64;
    LAS float* stg = (LAS float*)(shm + LDS_OST + wid * OST_BYTES);
    bf16x8 qr[4];
#pragma unroll
    for (int d0 = 0; d0 < 4; ++d0) qr[d0] = *(const bf16x8*)(Z + qrow * NZ + qcol + d0 * 16 + hi * 8);
    const float* Fh = FABS + (size_t)(U.b * NH + U.h) * SEQ;
    const float aq = (U.mode == 0) ? Fh[qi] * LOG2E : 0.f;
    float m = NEG, l = 0.f; f32x16 o[2];
#pragma unroll
    for (int r = 0; r < 16; ++r) { o[0][r] = 0.f; o[1][r] = 0.f; }
    const int vb0 = (int)(lds0 + LDS_V) + ((lane >> 4) & 1) * 32 + (lane & 3) * 8 + (4 * hi + ((lane & 15) >> 2)) * 64;
    const LAS unsigned char* kp = shm + LDS_K + hi * 1024 + r32 * 16;
    for (int t = 0; t < U.nt; ++t) {
        const int kb0 = U.kt0 + 64 * t;
        __syncthreads();
        { int ks = kb0 + lane; ks = ks < 0 ? 0 : ks;
          glds16(Z + (rowbase + (long)ks * U.d) * NZ + kcol + wid * 8, (unsigned)__builtin_amdgcn_readfirstlane(lds0 + LDS_K + wid * 1024));
          int vs = kb0 + 16 * (wid & 3) + (lane >> 2); vs = vs < 0 ? 0 : vs;
          glds16(Z + (rowbase + (long)vs * U.d) * NZ + vcol + (wid >> 2) * 32 + (lane & 3) * 8, (unsigned)__builtin_amdgcn_readfirstlane(lds0 + LDS_V + wid * 1024));
          if (U.mode == 0 && wid == 0) fb[lane] = -Fh[kb0 + lane] * LOG2E; }
        asm volatile("s_waitcnt vmcnt(0) lgkmcnt(0)" ::: "memory");
        __syncthreads();
        f32x16 p0, p1;
#pragma unroll
        for (int r = 0; r < 16; ++r) { p0[r] = 0.f; p1[r] = 0.f; }
#pragma unroll
        for (int d0 = 0; d0 < 4; ++d0) {
            const bf16x8 b0 = *(const LAS bf16x8*)(kp + d0 * 2048), b1 = *(const LAS bf16x8*)(kp + d0 * 2048 + 512);
            p0 = __builtin_amdgcn_mfma_f32_32x32x16_bf16(b0, qr[d0], p0, 0, 0, 0);
            p1 = __builtin_amdgcn_mfma_f32_32x32x16_bf16(b1, qr[d0], p1, 0, 0, 0);
        }
        if (U.mode == 0) {
#pragma unroll
            for (int g = 0; g < 4; ++g) { const v4f f0 = *(const LAS v4f*)(fb + 8 * g + 4 * hi), f1 = *(const LAS v4f*)(fb + 32 + 8 * g + 4 * hi);
#pragma unroll
                for (int e = 0; e < 4; ++e) { p0[4 * g + e] += aq + f0[e]; p1[4 * g + e] += aq + f1[e]; } }
        }
#pragma unroll
        for (int r = 0; r < 16; ++r) { const int kv = kb0 + crow(r, hi), kv1 = kv + 32;
            const bool ok0 = (U.mode == 0) ? (kv <= qi) : (kv <= qi && kv >= qi - 128 && kv >= 0);
            const bool ok1 = (U.mode == 0) ? (kv1 <= qi) : (kv1 <= qi && kv1 >= qi - 128 && kv1 >= 0);
            p0[r] = ok0 ? p0[r] : NEG; p1[r] = ok1 ? p1[r] : NEG; }
        float rm = NEG;
#pragma unroll
        for (int r = 0; r < 16; ++r) rm = fmaxf(rm, fmaxf(p0[r], p1[r]));
        rm = fmaxf(rm, __shfl_xor(rm, 32));
        const float mn = fmaxf(m, rm), alpha = __builtin_amdgcn_exp2f(m - mn); m = mn;
        if (hi == 0) wsf[r32] = alpha;
        float sacc = 0.f;
#pragma unroll
        for (int r = 0; r < 16; ++r) { p0[r] = __builtin_amdgcn_exp2f(p0[r] - m); p1[r] = __builtin_amdgcn_exp2f(p1[r] - m); sacc += p0[r] + p1[r]; }
        l = l * alpha + sacc;
        asm volatile("s_waitcnt lgkmcnt(0)" ::: "memory");
#pragma unroll
        for (int g = 0; g < 4; ++g) { const v4f a4 = *(const LAS v4f*)(wsf + 8 * g + 4 * hi);
#pragma unroll
            for (int e = 0; e < 4; ++e) { o[0][4 * g + e] *= a4[e]; o[1][4 * g + e] *= a4[e]; } }
        v4u pw0, pw1, pw2, pw3;
        pw0 = (v4u){cvtpk_s(p0[0], p0[1]), cvtpk_s(p0[2], p0[3]), cvtpk_s(p0[4], p0[5]), cvtpk_s(p0[6], p0[7])};
        pw1 = (v4u){cvtpk_s(p0[8], p0[9]), cvtpk_s(p0[10], p0[11]), cvtpk_s(p0[12], p0[13]), cvtpk_s(p0[14], p0[15])};
        pw2 = (v4u){cvtpk_s(p1[0], p1[1]), cvtpk_s(p1[2], p1[3]), cvtpk_s(p1[4], p1[5]), cvtpk_s(p1[6], p1[7])};
        pw3 = (v4u){cvtpk_s(p1[8], p1[9]), cvtpk_s(p1[10], p1[11]), cvtpk_s(p1[12], p1[13]), cvtpk_s(p1[14], p1[15])};
        pv(o, vb0, __builtin_bit_cast(bf16x8, pw0), __builtin_bit_cast(bf16x8, pw1), __builtin_bit_cast(bf16x8, pw2), __builtin_bit_cast(bf16x8, pw3));
    }
    l += __shfl_xor(l, 32);
    if (hi == 0) { wsf[r32] = 1.0f / l; wsf[32 + r32] = m + __builtin_amdgcn_logf(l); }
    asm volatile("s_waitcnt lgkmcnt(0)" ::: "memory");
#pragma unroll
    for (int g = 0; g < 4; ++g) { const v4f a4 = *(const LAS v4f*)(wsf + 8 * g + 4 * hi);
#pragma unroll
        for (int e = 0; e < 4; ++e) { const int r = 4 * g + e, q = crow(r, hi);
            stg[q * OST_STRIDE + r32] = o[0][r] * a4[e]; stg[q * OST_STRIDE + 32 + r32] = o[1][r] * a4[e]; } }
    asm volatile("s_waitcnt lgkmcnt(0)" ::: "memory");
#pragma unroll
    for (int i = 0; i < 4; ++i) {
        const int row = i * 8 + (lane >> 3), c8 = (lane & 7) * 8;
        const v4f a = *(const LAS v4f*)(stg + row * OST_STRIDE + c8), c = *(const LAS v4f*)(stg + row * OST_STRIDE + c8 + 4);
        const long grow = rowbase + (long)(U.i0 + wid * 32 + row) * U.d;
        if (U.mode == 0) {
            float ss = (a[0] * a[0] + a[1] * a[1]) + (a[2] * a[2] + a[3] * a[3]) + (c[0] * c[0] + c[1] * c[1]) + (c[2] * c[2] + c[3] * c[3]);
            ss += __shfl_xor(ss, 1); ss += __shfl_xor(ss, 2); ss += __shfl_xor(ss, 4);
            const float rs = 1.0f / sqrtf(ss * (1.0f / 64.0f) + RMS_EPS);
            const v4f g0 = *(const v4f*)(gn_a + U.h * HD + c8), g1 = *(const v4f*)(gn_a + U.h * HD + c8 + 4);
            v4u w; w.x = pk2(a[0] * rs * g0[0], a[1] * rs * g0[1]); w.y = pk2(a[2] * rs * g0[2], a[3] * rs * g0[3]);
            w.z = pk2(c[0] * rs * g1[0], c[1] * rs * g1[1]); w.w = pk2(c[2] * rs * g1[2], c[3] * rs * g1[3]);
            *(v4u*)(MG + grow * DM + U.h * HD + c8) = w;
        } else {
            v4u w; w.x = pk2(a[0], a[1]); w.y = pk2(a[2], a[3]); w.z = pk2(c[0], c[1]); w.w = pk2(c[2], c[3]);
            *(v4u*)(OP + ((size_t)U.pat * MTOK + grow) * 512 + U.h * HD + c8) = w;
            if ((lane & 7) == 0) LSE[((size_t)U.pat * MTOK + grow) * NH + U.h] = wsf[32 + row];
        }
    }
}
}

constexpr size_t MiB = 1u << 20;
constexpr size_t WS_ADA = 1 * MiB;
constexpr size_t WS_WIN = 2 * MiB, WS_WOUT = 9 * MiB, WS_WUP = 12 * MiB, WS_WDN = 24 * MiB;
constexpr size_t WS_FLOC = 30 * MiB, WS_FABS = 32 * MiB;
constexpr size_t WS_CT = 34 * MiB;
constexpr size_t WS_CS = 36 * MiB;
constexpr size_t WS_LSE = 40 * MiB;
constexpr size_t WS_ST1 = 48 * MiB;
constexpr size_t WS_H = 64 * MiB;
constexpr size_t WS_Z = 192 * MiB;
constexpr size_t WS_OP = 576 * MiB;
constexpr size_t WS_MG = 768 * MiB;
constexpr size_t WS_U = 192 * MiB;
constexpr size_t WS_G = 544 * MiB;
constexpr size_t WS_END = 896 * MiB;

constexpr int LDS_BYTES = 147456;
constexpr int RING_BYTES = 131072;

struct Params {
    const float *x, *c; const int* pos; const float *w_ada, *b_ada, *w_in, *b_fgate, *gn_a, *gn_b, *w_out, *ln1_g, *ln1_b, *w_up, *conv_w, *conv_b, *w_down, *ln2_g, *ln2_b;
    float* out; unsigned char* ws; int ph_lo, ph_hi;
};

__device__ __forceinline__ int src_in(int n) {
    if (n < 1536) return n;
    const int s = n & 63; int sd = s;
    if (n < 2560 && s < 16) { const int a = s >> 2; sd = ((((a & 1) << 1) | (a >> 1)) << 2) | (s & 3); }
    return n - s + sd + 8;
}
template <int MAP> __device__ __forceinline__ void transpose_item(const float* W, int ldw, int K, int N, bf16raw* WT, LAS float* scr, int item, int lane) {
    const int nblk = N / 32, kb = item / nblk, nb = item % nblk, k0 = 64 * kb, n0 = 32 * nb;
    const int nsrc = (MAP == 1) ? src_in(n0 + (lane & 31)) : n0 + (lane & 31);
#pragma unroll 8
    for (int i = 0; i < 32; ++i) { const int kk = 2 * i + (lane >> 5); scr[kk * 33 + (lane & 31)] = W[(size_t)(k0 + kk) * ldw + nsrc]; }
    asm volatile("s_waitcnt lgkmcnt(0)" ::: "memory");
    const int c = lane & 7;
#pragma unroll
    for (int j = 0; j < 4; ++j) { const int n = (lane >> 3) + 8 * j; const LAS float* s = scr + (8 * c) * 33 + n;
        v4u o; o.x = pk2(s[0 * 33], s[1 * 33]); o.y = pk2(s[2 * 33], s[3 * 33]); o.z = pk2(s[4 * 33], s[5 * 33]); o.w = pk2(s[6 * 33], s[7 * 33]);
        *(v4u*)(WT + (size_t)(n0 + n) * K + k0 + 8 * c) = o; }
    asm volatile("s_waitcnt lgkmcnt(0)" ::: "memory");
}

__device__ __forceinline__ void phase_prologue(const Params& p, LAS unsigned char* lds) {
    const int tid = threadIdx.x, lane = tid & 63, wave = __builtin_amdgcn_readfirstlane(tid >> 6);
    float* ADA = (float*)(p.ws + WS_ADA);
    for (int task = blockIdx.x; task < 96; task += gridDim.x) {
        LAS float* scT = (LAS float*)lds;
        LAS float* red = (LAS float*)(lds + 65536);
        for (int i = tid; i < NB * DM; i += 512) { const int b = i >> 10, k = i & 1023; const float v = p.c[i]; scT[k * 16 + b] = v / (1.0f + __expf(-v)); }
        __syncthreads();
        const int col = task * 64 + lane;
        float acc[16];
#pragma unroll
        for (int b = 0; b < 16; ++b) acc[b] = 0.f;
#pragma unroll 4
        for (int kk = 0; kk < 128; ++kk) { const int k = wave * 128 + kk; const float wv = p.w_ada[(size_t)k * (6 * DM) + col];
#pragma unroll
            for (int q = 0; q < 4; ++q) { const v4f s4 = *(const LAS v4f*)(scT + k * 16 + 4 * q);
                acc[4 * q + 0] += s4[0] * wv; acc[4 * q + 1] += s4[1] * wv; acc[4 * q + 2] += s4[2] * wv; acc[4 * q + 3] += s4[3] * wv; } }
#pragma unroll
        for (int b = 0; b < 16; ++b) red[(wave * 16 + b) * 64 + lane] = acc[b];
        __syncthreads();
        for (int i = tid; i < 16 * 64; i += 512) { const int b = i >> 6, cl = i & 63; float s = p.b_ada[task * 64 + cl];
#pragma unroll
            for (int w = 0; w < 8; ++w) s += red[(w * 16 + b) * 64 + cl];
            ADA[(size_t)b * (6 * DM) + task * 64 + cl] = s; }
        __syncthreads();
    }
    LAS float* scr = (LAS float*)(lds + wave * 16384);
    const int gw = blockIdx.x * 8 + wave, NGW = gridDim.x * 8;
    constexpr int I_IN = (DM / 64) * (NZ / 32), I_OUT = (DM / 64) * (DM / 32), I_UP = (DM / 64) * (NUP / 32), I_DN = (DFF / 64) * (DM / 32);
    for (int it = gw; it < I_IN + I_OUT + I_UP + I_DN; it += NGW) {
        int r = it;
        if (r < I_IN) { transpose_item<1>(p.w_in, DIN, DM, NZ, (bf16raw*)(p.ws + WS_WIN), scr, r, lane); continue; } r -= I_IN;
        if (r < I_OUT) { transpose_item<0>(p.w_out, DM, DM, DM, (bf16raw*)(p.ws + WS_WOUT), scr, r, lane); continue; } r -= I_OUT;
        if (r < I_UP) { transpose_item<0>(p.w_up, NUP, DM, NUP, (bf16raw*)(p.ws + WS_WUP), scr, r, lane); continue; } r -= I_UP;
        transpose_item<0>(p.w_down, DM, DFF, DM, (bf16raw*)(p.ws + WS_WDN), scr, r, lane);
    }
}

__device__ __forceinline__ void phase_pre1(const Params& p, LAS unsigned char* lds) {
    const int tid = threadIdx.x, lane = tid & 63, wave = __builtin_amdgcn_readfirstlane(tid >> 6);
    const float* ADA = (const float*)(p.ws + WS_ADA);
    bf16raw* H = (bf16raw*)(p.ws + WS_H);
    float* FLOC = (float*)(p.ws + WS_FLOC); float* CT = (float*)(p.ws + WS_CT); float* CS = (float*)(p.ws + WS_CS);
    LAS float* lfs = (LAS float*)lds;
    float wf[4][4][8];
#pragma unroll
    for (int j = 0; j < 4; ++j)
#pragma unroll
        for (int e = 0; e < 4; ++e) { const float* wp = p.w_in + (size_t)(4 * lane + 256 * j + e) * DIN + 1536;
            const v4f a = *(const v4f*)wp, b = *(const v4f*)(wp + 4);
            wf[j][e][0] = a[0]; wf[j][e][1] = a[1]; wf[j][e][2] = a[2]; wf[j][e][3] = a[3]; wf[j][e][4] = b[0]; wf[j][e][5] = b[1]; wf[j][e][6] = b[2]; wf[j][e][7] = b[3]; }
    for (int chunk = blockIdx.x; chunk < MTOK / 256; chunk += gridDim.x) {
        const int b = chunk >> 4, t0 = (chunk & 15) * 256;
        v4f sc[4], sh[4];
#pragma unroll
        for (int j = 0; j < 4; ++j) { sh[j] = *(const v4f*)(ADA + (size_t)b * (6 * DM) + 4 * lane + 256 * j); sc[j] = *(const v4f*)(ADA + (size_t)b * (6 * DM) + DM + 4 * lane + 256 * j) + 1.0f; }
        for (int i = 0; i < 32; ++i) {
            const int rl = wave * 32 + i; const size_t row = (size_t)b * SEQ + t0 + rl;
            const v4f* xr = (const v4f*)(p.x + row * DM) + lane;
            float s[8];
#pragma unroll
            for (int hh = 0; hh < 8; ++hh) s[hh] = 0.f;
            unsigned long long* o8 = (unsigned long long*)(H + row * DM) + lane;
#pragma unroll
            for (int j = 0; j < 4; ++j) { const v4f hv = xr[64 * j] * sc[j] + sh[j];
                o8[64 * j] = (unsigned long long)pk2(hv[0], hv[1]) | ((unsigned long long)pk2(hv[2], hv[3]) << 32);
#pragma unroll
                for (int e = 0; e < 4; ++e)
#pragma unroll
                    for (int hh = 0; hh < 8; ++hh) s[hh] += hv[e] * wf[j][e][hh]; }
#pragma unroll
            for (int hh = 0; hh < 8; ++hh) s[hh] = wave_sum(s[hh]);
            if (lane < 8) { float v = s[0];
#pragma unroll
                for (int hh = 1; hh < 8; ++hh) v = (lane == hh) ? s[hh] : v;
                v += p.b_fgate[lane];
                lfs[rl * 8 + lane] = fminf(v, 0.f) - log1pf(expf(-fabsf(v))); }
        }
        for (int i = tid; i < 256 * 8; i += 512) { const int rl = i >> 3, fi = i & 7; const size_t row = (size_t)b * SEQ + t0 + rl;
            const float fr = (fi == 0) ? 1.0f : (fi == 1) ? 0.1939227432012558f : (fi == 2) ? 0.03760603070259094f : (fi == 3) ? 0.007292664609849453f : (fi == 4) ? 0.0014142135623842478f
                           : (fi == 5) ? 0.00027424818836152554f : (fi == 6) ? 5.3182957344688475e-05f : 1.0313385246263351e-05f;
            double rev = (double)p.pos[row] * (double)fr * 0.15915494309189535; rev -= __builtin_floor(rev);
            const float rf = (float)rev;
            CS[row * 16 + fi] = __builtin_amdgcn_cosf(rf); CS[row * 16 + 8 + fi] = __builtin_amdgcn_sinf(rf); }
        __syncthreads();
        { const int hh = wave; float a0 = lfs[(4 * lane + 0) * 8 + hh], a1 = lfs[(4 * lane + 1) * 8 + hh], a2 = lfs[(4 * lane + 2) * 8 + hh], a3 = lfs[(4 * lane + 3) * 8 + hh];
          a1 += a0; a2 += a1; a3 += a2; float run = a3;
#pragma unroll
          for (int o = 1; o < 64; o <<= 1) { const float v = __shfl_up(run, o); if (lane >= o) run += v; }
          const float excl = run - a3;
          *(v4f*)(FLOC + (size_t)(b * NH + hh) * SEQ + t0 + 4 * lane) = (v4f){a0 + excl, a1 + excl, a2 + excl, a3 + excl};
          if (lane == 63) CT[(b * NH + hh) * 16 + (chunk & 15)] = run; }
        __syncthreads();
    }
}
__device__ __forceinline__ void phase_fabs(const Params& p) {
    const float* FLOC = (const float*)(p.ws + WS_FLOC); const float* CT = (const float*)(p.ws + WS_CT); float* FABS = (float*)(p.ws + WS_FABS);
    for (int i = blockIdx.x * 512 + threadIdx.x; i < NB * NH * SEQ; i += gridDim.x * 512) {
        const int bh = i >> 12, t = i & 4095, ch = t >> 8; float off = 0.f;
        for (int c2 = 0; c2 < ch; ++c2) off += CT[bh * 16 + c2];
        FABS[i] = FLOC[i] + off; }
}
__device__ __forceinline__ void phase_merge(const Params& p) {
    const int lane = threadIdx.x & 63, wave = threadIdx.x >> 6;
    const bf16raw* OP = (const bf16raw*)(p.ws + WS_OP); const float* LSE = (const float*)(p.ws + WS_LSE); bf16raw* MG = (bf16raw*)(p.ws + WS_MG);
    const int hh = lane >> 3;
    const v4f g0 = *(const v4f*)(p.gn_b + lane * 8), g1 = *(const v4f*)(p.gn_b + lane * 8 + 4);
    for (size_t row = (size_t)blockIdx.x * 8 + wave; row < (size_t)MTOK; row += (size_t)gridDim.x * 8) {
        float ls[3]; v4u w[3];
#pragma unroll
        for (int q = 0; q < 3; ++q) { ls[q] = LSE[((size_t)q * MTOK + row) * NH + hh]; w[q] = *(const v4u*)(OP + ((size_t)q * MTOK + row) * 512 + lane * 8); }
        const float mx = fmaxf(ls[0], fmaxf(ls[1], ls[2]));
        float e[3]; e[0] = __builtin_amdgcn_exp2f(ls[0] - mx); e[1] = __builtin_amdgcn_exp2f(ls[1] - mx); e[2] = __builtin_amdgcn_exp2f(ls[2] - mx);
        const float inv = 1.0f / (e[0] + e[1] + e[2]);
        float o[8];
#pragma unroll
        for (int k = 0; k < 8; ++k) o[k] = 0.f;
#pragma unroll
        for (int q = 0; q < 3; ++q) { const float wq = e[q] * inv;
            o[0] += wq * bflo(w[q].x); o[1] += wq * bfhi(w[q].x); o[2] += wq * bflo(w[q].y); o[3] += wq * bfhi(w[q].y);
            o[4] += wq * bflo(w[q].z); o[5] += wq * bfhi(w[q].z); o[6] += wq * bflo(w[q].w); o[7] += wq * bfhi(w[q].w); }
        float ss = 0.f;
#pragma unroll
        for (int k = 0; k < 8; ++k) ss += o[k] * o[k];
        ss += __shfl_xor(ss, 1); ss += __shfl_xor(ss, 2); ss += __shfl_xor(ss, 4);
        const float rs = 1.0f / sqrtf(ss * (1.0f / 64.0f) + RMS_EPS);
        v4u ow; ow.x = pk2(o[0] * rs * g0[0], o[1] * rs * g0[1]); ow.y = pk2(o[2] * rs * g0[2], o[3] * rs * g0[3]);
        ow.z = pk2(o[4] * rs * g1[0], o[5] * rs * g1[1]); ow.w = pk2(o[6] * rs * g1[2], o[7] * rs * g1[3]);
        *(v4u*)(MG + row * DM + 512 + lane * 8) = ow;
    }
}
__device__ __forceinline__ void phase_ln1(const Params& p) {
    const int lane = threadIdx.x & 63, wave = threadIdx.x >> 6;
    const float* ADA = (const float*)(p.ws + WS_ADA); bf16raw* H = (bf16raw*)(p.ws + WS_H); float* ST = (float*)(p.ws + WS_ST1);
    v4f lg[4], lb[4];
#pragma unroll
    for (int j = 0; j < 4; ++j) { lg[j] = *(const v4f*)(p.ln1_g + 4 * lane + 256 * j); lb[j] = *(const v4f*)(p.ln1_b + 4 * lane + 256 * j); }
    for (size_t row = (size_t)blockIdx.x * 8 + wave; row < (size_t)MTOK; row += (size_t)gridDim.x * 8) {
        const int b = (int)(row >> 12);
        const v4f* yr = (const v4f*)(p.out + row * DM) + lane;
        v4f v[4]; float s = 0.f;
#pragma unroll
        for (int j = 0; j < 4; ++j) { v[j] = yr[64 * j]; s += (v[j][0] + v[j][1]) + (v[j][2] + v[j][3]); }
        const float mean = wave_sum(s) * (1.0f / DM); float s2 = 0.f;
#pragma unroll
        for (int j = 0; j < 4; ++j) { v[j] = v[j] - mean; s2 += (v[j][0] * v[j][0] + v[j][1] * v[j][1]) + (v[j][2] * v[j][2] + v[j][3] * v[j][3]); }
        const float rstd = 1.0f / sqrtf(wave_sum(s2) * (1.0f / DM) + LN_EPS);
        if (lane == 0) *(v2f*)(ST + row * 2) = (v2f){mean, rstd};
        unsigned long long* o8 = (unsigned long long*)(H + row * DM) + lane;
#pragma unroll
        for (int j = 0; j < 4; ++j) { const v4f x1 = v[j] * rstd * lg[j] + lb[j];
            const v4f shf = *(const v4f*)(ADA + (size_t)b * (6 * DM) + 3 * DM + 4 * lane + 256 * j), scf = *(const v4f*)(ADA + (size_t)b * (6 * DM) + 4 * DM + 4 * lane + 256 * j);
            const v4f hv = x1 * (scf + 1.0f) + shf;
            o8[64 * j] = (unsigned long long)pk2(hv[0], hv[1]) | ((unsigned long long)pk2(hv[2], hv[3]) << 32); }
    }
}
__device__ __forceinline__ void phase_conv(const Params& p, int half) {
    const bf16raw* U = (const bf16raw*)(p.ws + WS_U); bf16raw* G = (bf16raw*)(p.ws + WS_G) + (size_t)half * (MTOK / 2) * DFF;
    constexpr int CH = DFF / 8;
    for (size_t i = (size_t)blockIdx.x * 512 + threadIdx.x; i < (size_t)(MTOK / 2) * CH; i += (size_t)gridDim.x * 512) {
        const int tl = (int)(i / CH), ch = (int)(i % CH), j0 = ch * 8, posn = tl & (SEQ - 1);
        float y[2][8];
#pragma unroll
        for (int part = 0; part < 2; ++part) {
            const int col = part * DFF + j0;
            const v4f b0 = *(const v4f*)(p.conv_b + col), b1 = *(const v4f*)(p.conv_b + col + 4);
            y[part][0] = b0[0]; y[part][1] = b0[1]; y[part][2] = b0[2]; y[part][3] = b0[3]; y[part][4] = b1[0]; y[part][5] = b1[1]; y[part][6] = b1[2]; y[part][7] = b1[3];
#pragma unroll
            for (int tap = 0; tap < 3; ++tap) { const int dt = 2 - tap;
                if (posn >= dt) { const v4u uw = *(const v4u*)(U + (size_t)(tl - dt) * NUP + col);
                    const v4f w0 = *(const v4f*)(p.conv_w + tap * NUP + col), w1 = *(const v4f*)(p.conv_w + tap * NUP + col + 4);
                    y[part][0] += w0[0] * bflo(uw.x); y[part][1] += w0[1] * bfhi(uw.x); y[part][2] += w0[2] * bflo(uw.y); y[part][3] += w0[3] * bfhi(uw.y);
                    y[part][4] += w1[0] * bflo(uw.z); y[part][5] += w1[1] * bfhi(uw.z); y[part][6] += w1[2] * bflo(uw.w); y[part][7] += w1[3] * bfhi(uw.w); } }
        }
        float r[8];
#pragma unroll
        for (int k = 0; k < 8; ++k) r[k] = y[0][k] * y[1][k] / (1.0f + __expf(-y[1][k]));
        v4u ow; ow.x = pk2(r[0], r[1]); ow.y = pk2(r[2], r[3]); ow.z = pk2(r[4], r[5]); ow.w = pk2(r[6], r[7]);
        *(v4u*)(G + (size_t)tl * DFF + j0) = ow;
    }
}
__device__ __forceinline__ void phase_ln2(const Params& p) {
    const int lane = threadIdx.x & 63, wave = threadIdx.x >> 6;
    v4f lg[4], lb[4];
#pragma unroll
    for (int j = 0; j < 4; ++j) { lg[j] = *(const v4f*)(p.ln2_g + 4 * lane + 256 * j); lb[j] = *(const v4f*)(p.ln2_b + 4 * lane + 256 * j); }
    for (size_t row = (size_t)blockIdx.x * 8 + wave; row < (size_t)MTOK; row += (size_t)gridDim.x * 8) {
        v4f* yr = (v4f*)(p.out + row * DM) + lane;
        v4f v[4]; float s = 0.f;
#pragma unroll
        for (int j = 0; j < 4; ++j) { v[j] = yr[64 * j]; s += (v[j][0] + v[j][1]) + (v[j][2] + v[j][3]); }
        const float mean = wave_sum(s) * (1.0f / DM); float s2 = 0.f;
#pragma unroll
        for (int j = 0; j < 4; ++j) { v[j] = v[j] - mean; s2 += (v[j][0] * v[j][0] + v[j][1] * v[j][1]) + (v[j][2] * v[j][2] + v[j][3] * v[j][3]); }
        const float rstd = 1.0f / sqrtf(wave_sum(s2) * (1.0f / DM) + LN_EPS);
#pragma unroll
        for (int j = 0; j < 4; ++j) yr[64 * j] = v[j] * rstd * lg[j] + lb[j];
    }
}

constexpr int N_PHASES = 14;
__global__ void __launch_bounds__(512, 2) fwd_megakernel(Params p) {
    extern __shared__ __attribute__((aligned(16))) unsigned char lds_raw[];
    LAS unsigned char* lds = (LAS unsigned char*)lds_raw;
    cg::grid_group grid = cg::this_grid();
    const int lo = p.ph_lo, hi = p.ph_hi;
#define IN(k) (lo <= (k) && (k) < hi)
#define SEAM(k) do { if (IN(k) && IN((k) + 1)) grid.sync(); } while (0)
    bf16raw* H = (bf16raw*)(p.ws + WS_H); bf16raw* Z = (bf16raw*)(p.ws + WS_Z); bf16raw* MG = (bf16raw*)(p.ws + WS_MG);
    const float* ADA = (const float*)(p.ws + WS_ADA);
    if (IN(0)) { phase_prologue(p, lds); } SEAM(0);
    if (IN(1)) { phase_pre1(p, lds); } SEAM(1);
    if (IN(2)) {
        phase_fabs(p);
        pg8::Gemm g{H, (const bf16raw*)(p.ws + WS_WIN), MTOK, NZ, DM}; pg8::StaticOrder S; S.init(MTOK, NZ, gridDim.x, (int)blockIdx.x);
        pg8::EpiIn E{Z, (const float*)(p.ws + WS_CS)};
        pg8::gemm_phase<pg8::EpiIn, pg8::StaticOrder, true, true>(lds, g, S, E);
    } SEAM(2);
    if (IN(3)) {
        for (int u = blockIdx.x; u < att::N_UNITS; u += gridDim.x) {
            const att::AUnit U = att::decode_unit(u);
            att::attn_unit_simple(U, Z, (const float*)(p.ws + WS_FABS), MG, p.gn_a, (bf16raw*)(p.ws + WS_OP), (float*)(p.ws + WS_LSE), lds);
            __syncthreads();
        }
    } SEAM(3);
    if (IN(4)) { phase_merge(p); } SEAM(4);
    if (IN(5)) {
        pg8::Gemm g{MG, (const bf16raw*)(p.ws + WS_WOUT), MTOK, DM, DM}; pg8::StaticOrder S; S.init(MTOK, DM, gridDim.x, (int)blockIdx.x);
        pg8::EpiOut E{p.x, p.out, ADA};
        pg8::gemm_phase<pg8::EpiOut, pg8::StaticOrder, true, true>(lds, g, S, E);
    } SEAM(5);
    if (IN(6)) { phase_ln1(p); } SEAM(6);
#pragma unroll 1
    for (int half = 0; half < 2; ++half) {
        if (IN(7 + 2 * half)) {
            pg8::Gemm g{H + (size_t)half * (MTOK / 2) * DM, (const bf16raw*)(p.ws + WS_WUP), MTOK / 2, NUP, DM}; pg8::StaticOrder S; S.init(MTOK / 2, NUP, gridDim.x, (int)blockIdx.x);
            pg8::EpiRaw E{(bf16raw*)(p.ws + WS_U), NUP};
            pg8::gemm_phase<pg8::EpiRaw, pg8::StaticOrder, true, true>(lds, g, S, E);
        } SEAM(7 + 2 * half);
        if (IN(8 + 2 * half)) { phase_conv(p, half); } SEAM(8 + 2 * half);
    }
    if (IN(11)) {
        pg8::Gemm g{(const bf16raw*)(p.ws + WS_G), (const bf16raw*)(p.ws + WS_WDN), MTOK, DM, DFF}; pg8::StaticOrder S; S.init(MTOK, DM, gridDim.x, (int)blockIdx.x);
        pg8::EpiDown E{p.out, (const float*)(p.ws + WS_ST1), ADA, p.ln1_g, p.ln1_b};
        pg8::gemm_phase<pg8::EpiDown, pg8::StaticOrder, true, true>(lds, g, S, E);
    } SEAM(11);
    if (IN(12)) { phase_ln2(p); }
#undef IN
#undef SEAM
}

extern "C" void kernel_launch(void* const* d_in, const int* in_sizes, int n_in, void* d_out, int out_size, void* d_ws, size_t ws_size, hipStream_t stream) {
    static int grid = 0;
    if (grid == 0) {
        if (n_in != 18 || out_size != MTOK * DM || ws_size < WS_END) { fprintf(stderr, "kernel_launch: unexpected problem (n_in %d out %d ws %zu)\n", n_in, out_size, ws_size); grid = -1; return; }
        int dev = 0, cus = 0, per_cu = 0;
        hipGetDevice(&dev); hipDeviceGetAttribute(&cus, hipDeviceAttributeMultiprocessorCount, dev);
        if (hipFuncSetAttribute((const void*)fwd_megakernel, hipFuncAttributeMaxDynamicSharedMemorySize, LDS_BYTES) != hipSuccess) { fprintf(stderr, "kernel_launch: hipFuncSetAttribute failed\n"); grid = -1; return; }
        if (hipOccupancyMaxActiveBlocksPerMultiprocessor(&per_cu, (const void*)fwd_megakernel, 512, LDS_BYTES) != hipSuccess || per_cu < 1) { fprintf(stderr, "kernel_launch: occupancy query says %d\n", per_cu); per_cu = 1; }
        (void)hipGetLastError();
        if (per_cu > 1) per_cu = 1;
        grid = cus * per_cu;
    }
    if (grid < 0) return;
    Params p{};
    p.x = (const float*)d_in[0]; p.c = (const float*)d_in[1]; p.pos = (const int*)d_in[2]; p.w_ada = (const float*)d_in[3]; p.b_ada = (const float*)d_in[4];
    p.w_in = (const float*)d_in[5]; p.b_fgate = (const float*)d_in[6]; p.gn_a = (const float*)d_in[7]; p.gn_b = (const float*)d_in[8]; p.w_out = (const float*)d_in[9];
    p.ln1_g = (const float*)d_in[10]; p.ln1_b = (const float*)d_in[11]; p.w_up = (const float*)d_in[12]; p.conv_w = (const float*)d_in[13]; p.conv_b = (const float*)d_in[14];
    p.w_down = (const float*)d_in[15]; p.ln2_g = (const float*)d_in[16]; p.ln2_b = (const float*)d_in[17];
    p.out = (float*)d_out; p.ws = (unsigned char*)d_ws;
#if MK_SPLIT
    for (int ph = 0; ph < N_PHASES - 1; ++ph) { p.ph_lo = ph; p.ph_hi = ph + 1; hipLaunchKernelGGL(fwd_megakernel, dim3(grid), dim3(512), LDS_BYTES, stream, p); }
#else
    p.ph_lo = 0; p.ph_hi = N_PHASES;
    void* args[] = {&p};
    hipError_t e = hipLaunchCooperativeKernel((const void*)fwd_megakernel, dim3(grid), dim3(512), args, LDS_BYTES, stream);
    if (e != hipSuccess) fprintf(stderr, "cooperative launch failed: %s (grid %d)\n", hipGetErrorString(e), grid);
#endif
}
```

```cpp
#include <hip/hip_runtime.h>
#include <hip/hip_cooperative_groups.h>
#include <cstdio>
#include <cstdint>
namespace cg = cooperative_groups;

#ifndef MK_SPLIT
#define MK_SPLIT 0
#endif

constexpr int NB = 16, SEQ = 4096, DM = 1024, MTOK = NB * SEQ;
constexpr int DIN = 3080, NZ = 3072;
constexpr int DFF = 2816, NUP = 5632;
constexpr int NH = 8, HD = 64;
constexpr float ALPHA = 1.189207115002721f;
constexpr float LOG2E = 1.4426950408889634f;
constexpr float QSCALE = 0.125f * LOG2E;
constexpr float LN_EPS = 1e-5f, RMS_EPS = 1e-6f;
constexpr int ZQA = 0, ZKA = 512, ZVA = 1024, ZQB = 1536, ZKB = 2048, ZVB = 2560;

#define LAS __attribute__((address_space(3)))
typedef unsigned short bf16raw;
typedef unsigned v4u __attribute__((ext_vector_type(4)));
typedef unsigned v2u __attribute__((ext_vector_type(2)));
typedef float v4f __attribute__((ext_vector_type(4)));
typedef float v2f __attribute__((ext_vector_type(2)));

__device__ __forceinline__ unsigned f2bf(float f) { unsigned u = __builtin_bit_cast(unsigned, f); return (u + 0x7fffu + ((u >> 16) & 1u)) >> 16; }
__device__ __forceinline__ unsigned pk2(float lo, float hi) { return f2bf(lo) | (f2bf(hi) << 16); }
__device__ __forceinline__ float bflo(unsigned w) { return __builtin_bit_cast(float, w << 16); }
__device__ __forceinline__ float bfhi(unsigned w) { return __builtin_bit_cast(float, w & 0xffff0000u); }
__device__ __forceinline__ int lane_id() { int l; asm volatile("v_mbcnt_lo_u32_b32 %0, -1, 0\n\tv_mbcnt_hi_u32_b32 %0, -1, %0" : "=v"(l)); return l; }
__device__ __forceinline__ float sum8_dpp(float v) {
    v += __builtin_bit_cast(float, __builtin_amdgcn_mov_dpp(__builtin_bit_cast(int, v), 0xB1, 0xF, 0xF, true));
    v += __builtin_bit_cast(float, __builtin_amdgcn_mov_dpp(__builtin_bit_cast(int, v), 0x4E, 0xF, 0xF, true));
    v += __builtin_bit_cast(float, __builtin_amdgcn_mov_dpp(__builtin_bit_cast(int, v), 0x141, 0xF, 0xF, true));
    return v;
}
__device__ __forceinline__ float wave_sum(float v) {
#pragma unroll
    for (int o = 1; o < 64; o <<= 1) v += __shfl_xor(v, o);
    return v;
}

namespace pg8 {
#define PG8_LAS __attribute__((address_space(3)))
typedef unsigned short bf16_t;
typedef short bf16x8 __attribute__((ext_vector_type(8)));
typedef float f32x4 __attribute__((ext_vector_type(4)));
typedef unsigned u32x4 __attribute__((ext_vector_type(4)));
constexpr int BM = 256, BK = 64, HALF = 128, HTB = HALF * BK * 2  , STAGE_BYTES = 8 * HTB, NXCD = 8, WGM = 8;

__host__ __device__ __forceinline__ int lds_byte(int r, int c) { const int st = (r >> 4) * 2 + (c >> 5), rr = r & 15, cc = c & 31, ob = rr * 64 + cc * 2; return st * 1024 + (ob ^ (((ob >> 9) & 1) << 5)); }
__host__ __device__ __forceinline__ void stage_rc(int b, int& R, int& C) { const int st = b / 1024, sb = b % 1024, swz = sb ^ (((sb >> 9) & 1) << 5); R = (st >> 1) * 16 + swz / 64; C = (st & 1) * 32 + (swz % 64) / 2; }
__host__ __device__ __forceinline__ int perm32(int rho) { const int n = rho >> 4, i = rho & 15; return 8 * (i >> 2) + 4 * n + (i & 3); }

struct Unit { int pm, pn; };
struct Gemm { const bf16_t* A; const bf16_t* Bt; int M, N, K; };

struct StaticOrder {
    int nM, nN, nwg, G, c;
    __host__ __device__ void init(int M, int N, int G_, int c_) { nM = M / BM; nN = N / BM; nwg = nM * nN; G = G_; c = c_; }
    __host__ __device__ bool next(int i, Unit& u) const {
        const long L = (long)i * G + c; if (L >= nwg) return false;
        int wgid = (int)L; { const int q = nwg / NXCD, r = nwg % NXCD, xcd = wgid % NXCD, off = wgid / NXCD; wgid = (xcd < r ? xcd * (q + 1) : r * (q + 1) + (xcd - r) * q) + off; }
        const int nig = WGM * nN, gid = wgid / nig, fm = gid * WGM, gsz = (nM - fm) < WGM ? (nM - fm) : WGM;
        u.pm = fm + ((wgid % nig) % gsz); u.pn = (wgid % nig) / gsz; return true;
    }
    __device__ __forceinline__ void a_ready(const Unit&) const {}
    __device__ __forceinline__ void done(const Unit&) const {}
};

__device__ __forceinline__ unsigned cvt_pk_bf16(float lo, float hi) { unsigned r; asm volatile("v_cvt_pk_bf16_f32 %0, %1, %2" : "=v"(r) : "v"(lo), "v"(hi)); return r; }
typedef float f32x2 __attribute__((ext_vector_type(2)));

struct EpiIn {
    static constexpr bool PERM = true, AFTER_DRAIN = false;
    bf16_t* Z; const float* CS;
    __device__ __forceinline__ void operator()(const f32x4 (&acc)[2][2][4][2], const Unit& u, int wr, int wc, int fr, int fq) const {
        const int row0 = u.pm * BM + wr * 64 + fr, col0 = u.pn * BM + wc * 32 + 8 * fq;
        const bool isq = (u.pn < 2) || (u.pn == 6) || (u.pn == 7);
        const float sc = isq ? QSCALE : 1.0f;
        const bool rot = (u.pn >= 6) && (u.pn < 10) && ((wc & 1) == 0) && (fq < 2);
#pragma unroll
        for (int ai = 0; ai < 2; ++ai)
#pragma unroll
            for (int m = 0; m < 4; ++m) {
                const int row = row0 + ai * HALF + m * 16;
                f32x4 cs = (f32x4){1.f, 1.f, 1.f, 1.f}, sn = (f32x4){0.f, 0.f, 0.f, 0.f};
                if (rot) { cs = *(const f32x4*)(CS + (size_t)row * 16 + 4 * fq); sn = *(const f32x4*)(CS + (size_t)row * 16 + 8 + 4 * fq); }
                bf16_t* rowp = Z + (size_t)row * NZ + col0;
#pragma unroll
                for (int bj = 0; bj < 2; ++bj) {
                    f32x4 v0 = acc[ai][bj][m][0], v1 = acc[ai][bj][m][1];
                    const f32x4 t1 = v0 * cs - v1 * sn, t2 = v1 * cs + v0 * sn;
                    v0 = t1 * sc; v1 = t2 * sc;
                    u32x4 w; w.x = cvt_pk_bf16(v0[0], v0[1]); w.y = cvt_pk_bf16(v0[2], v0[3]); w.z = cvt_pk_bf16(v1[0], v1[1]); w.w = cvt_pk_bf16(v1[2], v1[3]);
                    *(u32x4*)(rowp + bj * HALF) = w;
                }
            }
    }
};
struct EpiOut {
    static constexpr bool PERM = false, AFTER_DRAIN = false;
    const float* x; float* y; const float* ada;
    __device__ __forceinline__ void operator()(const f32x4 (&acc)[2][2][4][2], const Unit& u, int wr, int wc, int fr, int fq) const {
        const int row0 = u.pm * BM + wr * 64 + fr, col0 = u.pn * BM + wc * 32 + 4 * fq;
        const float* ga = ada + (size_t)(u.pm >> 4) * (6 * DM) + 2 * DM + col0;
#pragma unroll
        for (int bj = 0; bj < 2; ++bj)
#pragma unroll
            for (int n = 0; n < 2; ++n) {
                const f32x4 g = *(const f32x4*)(ga + bj * HALF + n * 16);
#pragma unroll
                for (int ai = 0; ai < 2; ++ai)
#pragma unroll
                    for (int m = 0; m < 4; ++m) {
                        const size_t off = (size_t)(row0 + ai * HALF + m * 16) * DM + col0 + bj * HALF + n * 16;
                        const f32x4 xv = *(const f32x4*)(x + off);
                        *(f32x4*)(y + off) = xv * ALPHA + g * acc[ai][bj][m][n];
                    }
                asm volatile("" ::: "memory");
            }
    }
};
struct EpiRaw {
    static constexpr bool PERM = true, AFTER_DRAIN = false;
    bf16_t* O; int ldc;
    __device__ __forceinline__ void operator()(const f32x4 (&acc)[2][2][4][2], const Unit& u, int wr, int wc, int fr, int fq) const {
        const int row0 = u.pm * BM + wr * 64 + fr, col0 = u.pn * BM + wc * 32 + 8 * fq;
#pragma unroll
        for (int ai = 0; ai < 2; ++ai)
#pragma unroll
            for (int m = 0; m < 4; ++m) { bf16_t* rowp = O + (size_t)(row0 + ai * HALF + m * 16) * ldc + col0;
#pragma unroll
                for (int bj = 0; bj < 2; ++bj) { const f32x4 v0 = acc[ai][bj][m][0], v1 = acc[ai][bj][m][1];
                    u32x4 w; w.x = cvt_pk_bf16(v0[0], v0[1]); w.y = cvt_pk_bf16(v0[2], v0[3]); w.z = cvt_pk_bf16(v1[0], v1[1]); w.w = cvt_pk_bf16(v1[2], v1[3]);
                    *(u32x4*)(rowp + bj * HALF) = w; } }
    }
};
struct EpiDown {
    static constexpr bool PERM = false, AFTER_DRAIN = false;
    float* y; const float* st; const float* ada; const float* lng; const float* lnb;
    __device__ __forceinline__ void operator()(const f32x4 (&acc)[2][2][4][2], const Unit& u, int wr, int wc, int fr, int fq) const {
        const int row0 = u.pm * BM + wr * 64 + fr, col0 = u.pn * BM + wc * 32 + 4 * fq;
        const float* gf = ada + (size_t)(u.pm >> 4) * (6 * DM) + 5 * DM + col0;
        f32x2 sr[2][4];
#pragma unroll
        for (int ai = 0; ai < 2; ++ai)
#pragma unroll
            for (int m = 0; m < 4; ++m) sr[ai][m] = *(const f32x2*)(st + (size_t)(row0 + ai * HALF + m * 16) * 2);
#pragma unroll
        for (int bj = 0; bj < 2; ++bj)
#pragma unroll
            for (int n = 0; n < 2; ++n) {
                const int co = bj * HALF + n * 16;
                const f32x4 g = *(const f32x4*)(gf + co), lg = *(const f32x4*)(lng + col0 + co), lb = *(const f32x4*)(lnb + col0 + co);
#pragma unroll
                for (int ai = 0; ai < 2; ++ai)
#pragma unroll
                    for (int m = 0; m < 4; ++m) {
                        const size_t off = (size_t)(row0 + ai * HALF + m * 16) * DM + col0 + co;
                        const f32x4 yv = *(const f32x4*)(y + off);
                        const f32x4 x1 = (yv - sr[ai][m].x) * sr[ai][m].y * lg + lb;
                        *(f32x4*)(y + off) = x1 * ALPHA + g * acc[ai][bj][m][n];
                    }
                asm volatile("" ::: "memory");
            }
    }
};

template <class Epi, class Sched, bool ALIGN_EPI = false, bool SP2 = false>
__device__ __forceinline__ void gemm_phase(PG8_LAS unsigned char* lds, const Gemm g, const Sched& S, const Epi& E, const int tid) {
    const int wid = __builtin_amdgcn_readfirstlane(tid >> 6), lane = tid & 63, wr = wid >> 2, wc = wid & 3, fr = lane & 15, fq = lane >> 4;
    const int K = g.K, nt = K / BK;
    unsigned voffA[2], voffB[2];
#pragma unroll
    for (int i = 0; i < 2; ++i) { int R, C; stage_rc(tid * 16 + i * 8192, R, C); const int Rb = Epi::PERM ? ((R & ~31) + perm32(R & 31)) : R;
        voffA[i] = (unsigned)(R * K + C) * 2u; voffB[i] = (unsigned)(Rb * K + C) * 2u; }
    const size_t kstep = (size_t)(BK * 2);
    const size_t hstep = (size_t)HALF * K * 2;
    const size_t tstep = 2 * hstep;
    const unsigned ldsw = (unsigned)wid * 1024u;
    const int aoff = lds_byte(wr * 64 + fr, fq * 8), boff = lds_byte(wc * 32 + fr, fq * 8);
#define PG8_SA(b, h) (((b) * 2 + (h)) * HTB)
#define PG8_SB(b, h) ((4 + (b) * 2 + (h)) * HTB)
#define PG8_STAGE(bufoff, gbase, voff) do { _Pragma("unroll") for (int _i = 0; _i < 2; ++_i) \
        __builtin_amdgcn_global_load_lds((const unsigned*)((const char*)(gbase) + (voff)[_i]), (PG8_LAS unsigned*)(lds + (bufoff) + ldsw + _i * 8192), 16, 0, 0); } while (0)
#define PG8_LDA(dst, b, h) do { _Pragma("unroll") for (int m = 0; m < 4; ++m) _Pragma("unroll") for (int k = 0; k < 2; ++k) dst[m][k] = *(const PG8_LAS bf16x8*)(lds + PG8_SA(b, h) + aoff + m * 2048 + k * 1024); } while (0)
#define PG8_LDB(dst, b, h) do { _Pragma("unroll") for (int n = 0; n < 2; ++n) _Pragma("unroll") for (int k = 0; k < 2; ++k) dst[n][k] = *(const PG8_LAS bf16x8*)(lds + PG8_SB(b, h) + boff + n * 2048 + k * 1024); } while (0)
#define PG8_MMA(ai, bj, At, Bt) do { __builtin_amdgcn_s_setprio(1); _Pragma("unroll") for (int m = 0; m < 4; ++m) _Pragma("unroll") for (int n = 0; n < 2; ++n) _Pragma("unroll") for (int k = 0; k < 2; ++k) \
        acc[ai][bj][m][n] = __builtin_amdgcn_mfma_f32_16x16x32_bf16(Bt[n][k], At[m][k], acc[ai][bj][m][n], 0, 0, 0); __builtin_amdgcn_s_setprio(0); } while (0)
#define PG8_WAIT_V(n) asm volatile("s_waitcnt vmcnt(" #n ")" ::: "memory")
#define PG8_WAIT_L(n) asm volatile("s_waitcnt lgkmcnt(" #n ")" ::: "memory")
#define PG8_BAR __builtin_amdgcn_s_barrier()
#define PG8_SCHED __builtin_amdgcn_sched_barrier(0)
    Unit cur, nxt; int ui = 0;
    if (!S.next(0, cur)) return;
    f32x4 acc[2][2][4][2];
#pragma unroll
    for (int a = 0; a < 2; ++a)
#pragma unroll
        for (int b = 0; b < 2; ++b)
#pragma unroll
            for (int m = 0; m < 4; ++m)
#pragma unroll
                for (int n = 0; n < 2; ++n) acc[a][b][m][n] = (f32x4){0.f, 0.f, 0.f, 0.f};
    bf16x8 At[4][2], B0[2][2], B1[2][2];
    const char* cA = (const char*)g.A + (size_t)cur.pm * tstep; const char* cB = (const char*)g.Bt + (size_t)cur.pn * tstep;
    S.a_ready(cur);
    if constexpr (SP2) {
        PG8_STAGE(PG8_SB(0, 0), cB, voffB); PG8_STAGE(PG8_SB(0, 1), cB + hstep, voffB); PG8_STAGE(PG8_SA(0, 0), cA, voffA); PG8_STAGE(PG8_SA(0, 1), cA + hstep, voffA);
        if (wr == 1) PG8_BAR;
        PG8_WAIT_V(2); PG8_BAR;
        PG8_STAGE(PG8_SB(1, 0), cB + kstep, voffB); PG8_STAGE(PG8_SA(1, 0), cA + kstep, voffA); PG8_STAGE(PG8_SB(1, 1), cB + hstep + kstep, voffB);
        PG8_WAIT_V(6); PG8_BAR;
    } else {
        PG8_STAGE(PG8_SB(0, 0), cB, voffB); PG8_STAGE(PG8_SA(0, 0), cA, voffA); PG8_STAGE(PG8_SB(0, 1), cB + hstep, voffB); PG8_STAGE(PG8_SA(0, 1), cA + hstep, voffA);
        if (wr == 1) PG8_BAR;
        PG8_WAIT_V(4); PG8_BAR;
        PG8_STAGE(PG8_SB(1, 0), cB + kstep, voffB); PG8_STAGE(PG8_SA(1, 0), cA + kstep, voffA); PG8_STAGE(PG8_SB(1, 1), cB + hstep + kstep, voffB);
        PG8_WAIT_V(6); PG8_BAR;
    }
    for (;;) {
        const bool has_next = S.next(ui + 1, nxt);
        const char* nA = has_next ? (const char*)g.A + (size_t)nxt.pm * tstep : cA; const char* nB = has_next ? (const char*)g.Bt + (size_t)nxt.pn * tstep : cB;
        for (int t = 0; t < nt; t += 2) {
            const bool last = (t == nt - 2);
            const char* a1 = cA + (size_t)(t + 1) * kstep;
            const char* a2 = last ? nA : cA + (size_t)(t + 2) * kstep; const char* b2 = last ? nB : cB + (size_t)(t + 2) * kstep;
            const char* a3 = a2 + kstep; const char* b3 = b2 + kstep;
            if (last && has_next) S.a_ready(nxt);
            if constexpr (SP2) {
            PG8_LDB(B0, 0, 0); PG8_LDB(B1, 0, 1); PG8_SCHED; PG8_LDA(At, 0, 0); PG8_STAGE(PG8_SA(1, 1), a1 + hstep, voffA);
            PG8_WAIT_V(8); PG8_WAIT_L(0); PG8_BAR; PG8_MMA(0, 0, At, B0); PG8_MMA(0, 1, At, B1); PG8_BAR; PG8_SCHED;
            PG8_LDA(At, 0, 1); PG8_STAGE(PG8_SB(0, 0), b2, voffB); PG8_STAGE(PG8_SB(0, 1), b2 + hstep, voffB); PG8_STAGE(PG8_SA(0, 0), a2, voffA);
            PG8_WAIT_V(8); PG8_WAIT_L(0); PG8_BAR; PG8_MMA(1, 0, At, B0); PG8_MMA(1, 1, At, B1); PG8_BAR; PG8_SCHED;
            PG8_LDB(B0, 1, 0); PG8_LDB(B1, 1, 1); PG8_SCHED; PG8_LDA(At, 1, 0); PG8_STAGE(PG8_SA(0, 1), a2 + hstep, voffA);
            PG8_WAIT_V(8); PG8_WAIT_L(0); PG8_BAR; PG8_MMA(0, 0, At, B0); PG8_MMA(0, 1, At, B1); PG8_BAR; PG8_SCHED;
            PG8_LDA(At, 1, 1); PG8_STAGE(PG8_SB(1, 0), b3, voffB); PG8_STAGE(PG8_SB(1, 1), b3 + hstep, voffB); PG8_STAGE(PG8_SA(1, 0), a3, voffA);
            PG8_WAIT_V(8); PG8_WAIT_L(0); PG8_BAR; PG8_MMA(1, 0, At, B0); PG8_MMA(1, 1, At, B1); PG8_BAR; PG8_SCHED;
            } else {
            PG8_LDB(B0, 0, 0); PG8_SCHED; PG8_LDA(At, 0, 0); PG8_STAGE(PG8_SA(1, 1), a1 + hstep, voffA);
            PG8_WAIT_L(8); PG8_BAR; PG8_WAIT_L(0); PG8_MMA(0, 0, At, B0); PG8_BAR; PG8_SCHED;
            PG8_LDB(B1, 0, 1); PG8_STAGE(PG8_SB(0, 0), b2, voffB);
            PG8_BAR; PG8_WAIT_L(0); PG8_MMA(0, 1, At, B1); PG8_BAR;
            PG8_LDA(At, 0, 1); PG8_STAGE(PG8_SA(0, 0), a2, voffA);
            PG8_BAR; PG8_WAIT_L(0); PG8_MMA(1, 0, At, B0); PG8_BAR; PG8_SCHED;
            PG8_STAGE(PG8_SB(0, 1), b2 + hstep, voffB);
            PG8_WAIT_V(6); PG8_BAR; PG8_MMA(1, 1, At, B1); PG8_BAR;
            PG8_LDB(B0, 1, 0); PG8_SCHED; PG8_LDA(At, 1, 0); PG8_STAGE(PG8_SA(0, 1), a2 + hstep, voffA);
            PG8_WAIT_L(8); PG8_BAR; PG8_WAIT_L(0); PG8_MMA(0, 0, At, B0); PG8_BAR; PG8_SCHED;
            PG8_LDB(B1, 1, 1); PG8_STAGE(PG8_SB(1, 0), b3, voffB);
            PG8_BAR; PG8_WAIT_L(0); PG8_MMA(0, 1, At, B1); PG8_BAR;
            PG8_LDA(At, 1, 1); PG8_STAGE(PG8_SA(1, 0), a3, voffA);
            PG8_BAR; PG8_WAIT_L(0); PG8_MMA(1, 0, At, B0); PG8_BAR; PG8_SCHED;
            PG8_STAGE(PG8_SB(1, 1), b3 + hstep, voffB);
            PG8_WAIT_V(6); PG8_BAR; PG8_MMA(1, 1, At, B1); PG8_BAR;
            }
        }
        if constexpr (ALIGN_EPI) { if (wr == 0) PG8_BAR; }
        if constexpr (!Epi::AFTER_DRAIN) { E(acc, cur, wr, wc, fr, fq); S.done(cur); }
        if (!has_next) break;
#pragma unroll
        for (int a = 0; a < 2; ++a)
#pragma unroll
            for (int b = 0; b < 2; ++b)
#pragma unroll
                for (int m = 0; m < 4; ++m)
#pragma unroll
                    for (int n = 0; n < 2; ++n) acc[a][b][m][n] = (f32x4){0.f, 0.f, 0.f, 0.f};
        cur = nxt; cA = nA; cB = nB; ++ui;
        if constexpr (ALIGN_EPI) { if (wr == 1) PG8_BAR; }
    }
    PG8_WAIT_V(0);
    if constexpr (!ALIGN_EPI) { if (wr == 0) PG8_BAR; }
    PG8_BAR;
    if constexpr (Epi::AFTER_DRAIN) { E.fused(acc, cur, wr, wc, fr, fq, lds, wid, lane); S.done(cur); }
#undef PG8_SA
#undef PG8_SB
#undef PG8_STAGE
#undef PG8_LDA
#undef PG8_LDB
#undef PG8_MMA
#undef PG8_WAIT_V
#undef PG8_WAIT_L
#undef PG8_BAR
#undef PG8_SCHED
}
}

namespace att {
typedef short bf16x8 __attribute__((ext_vector_type(8)));
typedef short s16x4 __attribute__((ext_vector_type(4)));
typedef float f32x16 __attribute__((ext_vector_type(16)));
constexpr int LDS_K = 0, LDS_V = 8192, LDS_FB = 16384, LDS_WS = 16384 + 256, LDS_OST = 20480, OST_STRIDE = 68, OST_BYTES = 32 * OST_STRIDE * 4;
constexpr int LDS_TOTAL = LDS_OST + 8 * OST_BYTES;
constexpr float NEG = -1.0e30f;
__device__ __forceinline__ int crow(int r, int hi) { return (r & 3) + 8 * (r >> 2) + 4 * hi; }
__device__ __forceinline__ void glds16(const void* gsrc, unsigned lds_dst) { unsigned keep;
    asm volatile("s_mov_b32 %0, m0\n\ts_mov_b32 m0, %2\n\ts_nop 0\n\tglobal_load_lds_dwordx4 %1, off\n\ts_mov_b32 m0, %0" : "=&s"(keep) : "v"(gsrc), "s"(lds_dst) : "memory"); }
typedef float f32x2_t __attribute__((ext_vector_type(2))); typedef __bf16 bf16x2_t __attribute__((ext_vector_type(2)));
__device__ __forceinline__ unsigned cvtpk_s(float lo, float hi) { f32x2_t v = {lo, hi}; bf16x2_t b = __builtin_convertvector(v, bf16x2_t); return __builtin_bit_cast(unsigned, b); }
__device__ __forceinline__ void pv(f32x16* o, int vb, bf16x8 pa0, bf16x8 pa1, bf16x8 pa2, bf16x8 pa3) {
#pragma unroll
    for (int d0 = 0; d0 < 2; ++d0) { s16x4 lo[4], hi[4];
#pragma unroll
        for (int ks = 0; ks < 4; ++ks) {
            asm volatile("ds_read_b64_tr_b16 %0,%1 offset:%c2" : "=&v"(lo[ks]) : "v"(vb), "i"(d0 * 4096 + ks * 1024) : "memory");
            asm volatile("ds_read_b64_tr_b16 %0,%1 offset:%c2" : "=&v"(hi[ks]) : "v"(vb), "i"(d0 * 4096 + ks * 1024 + 512) : "memory"); }
        asm volatile("s_waitcnt lgkmcnt(0)" ::: "memory"); __builtin_amdgcn_sched_barrier(0);
#define ATT_PK(k) (bf16x8){lo[k][0], lo[k][1], lo[k][2], lo[k][3], hi[k][0], hi[k][1], hi[k][2], hi[k][3]}
        o[d0] = __builtin_amdgcn_mfma_f32_32x32x16_bf16(pa0, ATT_PK(0), o[d0], 0, 0, 0);
        o[d0] = __builtin_amdgcn_mfma_f32_32x32x16_bf16(pa1, ATT_PK(1), o[d0], 0, 0, 0);
        o[d0] = __builtin_amdgcn_mfma_f32_32x32x16_bf16(pa2, ATT_PK(2), o[d0], 0, 0, 0);
        o[d0] = __builtin_amdgcn_mfma_f32_32x32x16_bf16(pa3, ATT_PK(3), o[d0], 0, 0, 0);
#undef ATT_PK
    }
}
struct AUnit { int b, h, mode, pat, d, cls, i0, kt0, nt; };
constexpr int N_FOX_UNITS = NB * NH * (SEQ / 256), N_DIL_UNITS = NB * NH * 48, N_UNITS = N_FOX_UNITS + N_DIL_UNITS;
__device__ __forceinline__ AUnit decode_unit(int idx) {
    AUnit u;
    if (idx < N_FOX_UNITS) { const int qb = 15 - (idx >> 7), bh = idx & 127; u.b = bh >> 3; u.h = bh & 7; u.mode = 0; u.pat = 0; u.d = 1; u.cls = 0; u.i0 = 256 * qb; u.kt0 = 0; u.nt = 4 * (qb + 1); }
    else { const int j = idx - N_FOX_UNITS, bh = j / 48, r = j % 48; u.b = bh >> 3; u.h = bh & 7; u.mode = 1; u.nt = 6;
        if (r < 16) { u.pat = 0; u.d = 1; u.cls = 0; u.i0 = 256 * r; }
        else if (r < 32) { u.pat = 1; u.d = 4; u.cls = (r - 16) >> 2; u.i0 = 256 * ((r - 16) & 3); }
        else { u.pat = 2; u.d = 16; u.cls = r - 32; u.i0 = 0; }
        u.kt0 = u.i0 - 128; }
    return u;
}
__device__ __forceinline__ void attn_unit_simple(const AUnit U, const bf16raw* __restrict__ Z, const float* __restrict__ FABS, bf16raw* MG, const float* __restrict__ gn_a,
                                                 bf16raw* OP, float* LSE, LAS unsigned char* shm, const int tid) {
    const int lane = tid & 63, r32 = lane & 31, hi = lane >> 5; const int wid = __builtin_amdgcn_readfirstlane(tid >> 6);
    const long rowbase = (long)U.b * SEQ + U.cls;
    const int qcol = (U.mode == 0 ? ZQA : ZQB) + U.h * HD, kcol = qcol + 512, vcol = qcol + 1024;
    const int qi = U.i0 + wid * 32 + r32;
    const long qrow = rowbase + (long)qi * U.d;
    const unsigned lds0 = (unsigned)(uintptr_t)shm;
    LAS float* fb = (LAS float*)(shm + LDS_FB);
    LAS float* wsf = (LAS float*)(shm + LDS_WS) + wid * 64;
    LAS float* stg = (LAS float*)(shm + LDS_OST + wid * OST_BYTES);
    bf16x8 qr[4];
#pragma unroll
    for (int d0 = 0; d0 < 4; ++d0) qr[d0] = *(const bf16x8*)(Z + qrow * NZ + qcol + d0 * 16 + hi * 8);
    const float* Fh = FABS + (size_t)(U.b * NH + U.h) * SEQ;
    const float aq = (U.mode == 0) ? Fh[qi] * LOG2E : 0.f;
    float m = NEG, l = 0.f; f32x16 o[2];
#pragma unroll
    for (int r = 0; r < 16; ++r) { o[0][r] = 0.f; o[1][r] = 0.f; }
    const int vb0 = (int)(lds0 + LDS_V) + ((lane >> 4) & 1) * 32 + (lane & 3) * 8 + (4 * hi + ((lane & 15) >> 2)) * 64;
    const LAS unsigned char* kp = shm + LDS_K + hi * 1024 + r32 * 16;
    for (int t = 0; t < U.nt; ++t) {
        const int kb0 = U.kt0 + 64 * t;
        __syncthreads();
        { int ks = kb0 + lane; ks = ks < 0 ? 0 : ks;
          glds16(Z + (rowbase + (long)ks * U.d) * NZ + kcol + wid * 8, (unsigned)__builtin_amdgcn_readfirstlane(lds0 + LDS_K + wid * 1024));
          int vs = kb0 + 16 * (wid & 3) + (lane >> 2); vs = vs < 0 ? 0 : vs;
          glds16(Z + (rowbase + (long)vs * U.d) * NZ + vcol + (wid >> 2) * 32 + (lane & 3) * 8, (unsigned)__builtin_amdgcn_readfirstlane(lds0 + LDS_V + wid * 1024));
          if (U.mode == 0 && wid == 0) fb[lane] = -Fh[kb0 + lane] * LOG2E; }
        asm volatile("s_waitcnt vmcnt(0) lgkmcnt(0)" ::: "memory");
        __syncthreads();
        f32x16 p0, p1;
#pragma unroll
        for (int r = 0; r < 16; ++r) { p0[r] = 0.f; p1[r] = 0.f; }
#pragma unroll
        for (int d0 = 0; d0 < 4; ++d0) {
            const bf16x8 b0 = *(const LAS bf16x8*)(kp + d0 * 2048), b1 = *(const LAS bf16x8*)(kp + d0 * 2048 + 512);
            p0 = __builtin_amdgcn_mfma_f32_32x32x16_bf16(b0, qr[d0], p0, 0, 0, 0);
            p1 = __builtin_amdgcn_mfma_f32_32x32x16_bf16(b1, qr[d0], p1, 0, 0, 0);
        }
        if (U.mode == 0) {
#pragma unroll
            for (int g = 0; g < 4; ++g) { const v4f f0 = *(const LAS v4f*)(fb + 8 * g + 4 * hi), f1 = *(const LAS v4f*)(fb + 32 + 8 * g + 4 * hi);
#pragma unroll
                for (int e = 0; e < 4; ++e) { p0[4 * g + e] += aq + f0[e]; p1[4 * g + e] += aq + f1[e]; } }
        }
#pragma unroll
        for (int r = 0; r < 16; ++r) { const int kv = kb0 + crow(r, hi), kv1 = kv + 32;
            const bool ok0 = (U.mode == 0) ? (kv <= qi) : (kv <= qi && kv >= qi - 128 && kv >= 0);
            const bool ok1 = (U.mode == 0) ? (kv1 <= qi) : (kv1 <= qi && kv1 >= qi - 128 && kv1 >= 0);
            p0[r] = ok0 ? p0[r] : NEG; p1[r] = ok1 ? p1[r] : NEG; }
        float rm = NEG;
#pragma unroll
        for (int r = 0; r < 16; ++r) rm = fmaxf(rm, fmaxf(p0[r], p1[r]));
        rm = fmaxf(rm, __shfl_xor(rm, 32));
        const float mn = fmaxf(m, rm), alpha = __builtin_amdgcn_exp2f(m - mn); m = mn;
        if (hi == 0) wsf[r32] = alpha;
        float sacc = 0.f;
#pragma unroll
        for (int r = 0; r < 16; ++r) { p0[r] = __builtin_amdgcn_exp2f(p0[r] - m); p1[r] = __builtin_amdgcn_exp2f(p1[r] - m); sacc += p0[r] + p1[r]; }
        l = l * alpha + sacc;
        asm volatile("s_waitcnt lgkmcnt(0)" ::: "memory");
#pragma unroll
        for (int g = 0; g < 4; ++g) { const v4f a4 = *(const LAS v4f*)(wsf + 8 * g + 4 * hi);
#pragma unroll
            for (int e = 0; e < 4; ++e) { o[0][4 * g + e] *= a4[e]; o[1][4 * g + e] *= a4[e]; } }
        v4u pw0, pw1, pw2, pw3;
        pw0 = (v4u){cvtpk_s(p0[0], p0[1]), cvtpk_s(p0[2], p0[3]), cvtpk_s(p0[4], p0[5]), cvtpk_s(p0[6], p0[7])};
        pw1 = (v4u){cvtpk_s(p0[8], p0[9]), cvtpk_s(p0[10], p0[11]), cvtpk_s(p0[12], p0[13]), cvtpk_s(p0[14], p0[15])};
        pw2 = (v4u){cvtpk_s(p1[0], p1[1]), cvtpk_s(p1[2], p1[3]), cvtpk_s(p1[4], p1[5]), cvtpk_s(p1[6], p1[7])};
        pw3 = (v4u){cvtpk_s(p1[8], p1[9]), cvtpk_s(p1[10], p1[11]), cvtpk_s(p1[12], p1[13]), cvtpk_s(p1[14], p1[15])};
        pv(o, vb0, __builtin_bit_cast(bf16x8, pw0), __builtin_bit_cast(bf16x8, pw1), __builtin_bit_cast(bf16x8, pw2), __builtin_bit_cast(bf16x8, pw3));
    }
    l += __shfl_xor(l, 32);
    if (hi == 0) { wsf[r32] = 1.0f / l; wsf[32 + r32] = m + __builtin_amdgcn_logf(l); }
    asm volatile("s_waitcnt lgkmcnt(0)" ::: "memory");
#pragma unroll
    for (int g = 0; g < 4; ++g) { const v4f a4 = *(const LAS v4f*)(wsf + 8 * g + 4 * hi);
#pragma unroll
        for (int e = 0; e < 4; ++e) { const int r = 4 * g + e, q = crow(r, hi);
            stg[q * OST_STRIDE + r32] = o[0][r] * a4[e]; stg[q * OST_STRIDE + 32 + r32] = o[1][r] * a4[e]; } }
    asm volatile("s_waitcnt lgkmcnt(0)" ::: "memory");
#pragma unroll
    for (int i = 0; i < 4; ++i) {
        const int row = i * 8 + (lane >> 3), c8 = (lane & 7) * 8;
        const v4f a = *(const LAS v4f*)(stg + row * OST_STRIDE + c8), c = *(const LAS v4f*)(stg + row * OST_STRIDE + c8 + 4);
        const long grow = rowbase + (long)(U.i0 + wid * 32 + row) * U.d;
        if (U.mode == 0) {
            float ss = (a[0] * a[0] + a[1] * a[1]) + (a[2] * a[2] + a[3] * a[3]) + (c[0] * c[0] + c[1] * c[1]) + (c[2] * c[2] + c[3] * c[3]);
            ss = sum8_dpp(ss);
            const float rs = 1.0f / sqrtf(ss * (1.0f / 64.0f) + RMS_EPS);
            const v4f g0 = *(const v4f*)(gn_a + U.h * HD + c8), g1 = *(const v4f*)(gn_a + U.h * HD + c8 + 4);
            v4u w; w.x = pk2(a[0] * rs * g0[0], a[1] * rs * g0[1]); w.y = pk2(a[2] * rs * g0[2], a[3] * rs * g0[3]);
            w.z = pk2(c[0] * rs * g1[0], c[1] * rs * g1[1]); w.w = pk2(c[2] * rs * g1[2], c[3] * rs * g1[3]);
            *(v4u*)(MG + grow * DM + U.h * HD + c8) = w;
        } else {
            v4u w; w.x = pk2(a[0], a[1]); w.y = pk2(a[2], a[3]); w.z = pk2(c[0], c[1]); w.w = pk2(c[2], c[3]);
            *(v4u*)(OP + ((size_t)U.pat * MTOK + grow) * 512 + U.h * HD + c8) = w;
            if ((lane & 7) == 0) LSE[((size_t)U.pat * MTOK + grow) * NH + U.h] = wsf[32 + row];
        }
    }
}
}

namespace fox {
typedef short bf16x8 __attribute__((ext_vector_type(8)));
typedef short s16x4 __attribute__((ext_vector_type(4)));
typedef float f32x16 __attribute__((ext_vector_type(16)));
typedef unsigned u32x4 __attribute__((ext_vector_type(4)));
constexpr int NW = 8, QBLK = 32, QB = QBLK * NW, KVBLK = 64;
__device__ __forceinline__ int crow(int r, int hi) { return (r & 3) + 8 * (r >> 2) + 4 * hi; }
#define SBAR() __builtin_amdgcn_sched_barrier(0)
__device__ __forceinline__ void cmask(f32x16& p0, f32x16& p1, int jb, int qrel, int hi) {
    const float NEGI = -INFINITY; int kb = 64 * jb + 4 * hi;
#pragma unroll
    for (int r = 0; r < 16; ++r) { int kv = kb + (r & 3) + 8 * (r >> 2); if (kv > qrel) p0[r] = NEGI; if (kv + 32 > qrel) p1[r] = NEGI; }
}
constexpr int NSLOT = 3, SLOTB = 9216, XOFF = 8192;
constexpr int LDS_K = 0, LDS_V = NSLOT * SLOTB, LDS_WS = 2 * NSLOT * SLOTB, LDS_OST = LDS_WS + NW * 64 * 4, OST_STRIDE = 68, OST_BYTES = 32 * OST_STRIDE * 4, LDS_BYTES = LDS_OST + NW * OST_BYTES;
__device__ __forceinline__ void glds16(const void* sbase, unsigned voff, unsigned lds_dst) { unsigned keep;
    asm volatile("s_mov_b32 %0, m0\n\ts_mov_b32 m0, %3\n\ts_nop 0\n\tglobal_load_lds_dwordx4 %1, %2\n\ts_mov_b32 m0, %0" : "=&s"(keep) : "v"(voff), "s"(sbase), "s"(lds_dst) : "memory"); }
__device__ __forceinline__ void glds4(const void* sbase, unsigned voff, unsigned lds_dst) { unsigned keep;
    asm volatile("s_mov_b32 %0, m0\n\ts_mov_b32 m0, %3\n\ts_nop 0\n\tglobal_load_lds_dword %1, %2\n\ts_mov_b32 m0, %0" : "=&s"(keep) : "v"(voff), "s"(sbase), "s"(lds_dst) : "memory"); }
__device__ __forceinline__ float max3f(float a, float b, float c) { float r; asm("v_max3_f32 %0, %1, %2, %3" : "=v"(r) : "v"(a), "v"(b), "v"(c)); return r; }
__device__ __forceinline__ float max2f(float a, float b) { float r; asm("v_max_f32_e32 %0, %1, %2" : "=v"(r) : "v"(a), "v"(b)); return r; }
__device__ __forceinline__ float fadd_s(float a, float b) { float r; asm("v_add_f32_e32 %0, %1, %2" : "=v"(r) : "v"(a), "v"(b)); return r; }
__device__ __forceinline__ float fsub_s(float a, float b) { float r; asm("v_sub_f32_e32 %0, %1, %2" : "=v"(r) : "v"(a), "v"(b)); return r; }
typedef float f32x2_t __attribute__((ext_vector_type(2))); typedef __bf16 bf16x2_t __attribute__((ext_vector_type(2)));
__device__ __forceinline__ unsigned cvtpk_s(float lo, float hi) { f32x2_t v = {lo, hi}; bf16x2_t b = __builtin_convertvector(v, bf16x2_t); return __builtin_bit_cast(unsigned, b); }
#define WAIT_BAR(N) asm volatile("s_waitcnt vmcnt(" #N ") lgkmcnt(0)\n\ts_barrier" ::: "memory")
__device__ __forceinline__ s16x4 make_qx(float a, int hi) {
    const unsigned w1 = cvtpk_s(a, 0.f); const float h = __builtin_bit_cast(float, w1 << 16);
    const float r1 = a - h; const unsigned w2 = cvtpk_s(r1, 0.f); const float m = __builtin_bit_cast(float, w2 << 16);
    const float r2 = r1 - m; const unsigned w3 = cvtpk_s(r2, 1.0f);
    unsigned x = (w1 & 0xffffu) | (w2 << 16), y = w3;
    if (hi) { x = 0x3f803f80u; y = 0u; }
    typedef unsigned u32x2 __attribute__((ext_vector_type(2)));
    return __builtin_bit_cast(s16x4, (u32x2){x, y});
}
typedef __attribute__((address_space(3))) const char* lds_cptr;
typedef short v4i16_t __attribute__((ext_vector_type(4)));
__device__ __forceinline__ void kload8(bf16x8* kf, lds_cptr kp) {
    kf[0] = *(const __attribute__((address_space(3))) bf16x8*)(kp);        kf[1] = *(const __attribute__((address_space(3))) bf16x8*)(kp + 512);
    kf[2] = *(const __attribute__((address_space(3))) bf16x8*)(kp + 2048); kf[3] = *(const __attribute__((address_space(3))) bf16x8*)(kp + 2560);
    kf[4] = *(const __attribute__((address_space(3))) bf16x8*)(kp + 4096); kf[5] = *(const __attribute__((address_space(3))) bf16x8*)(kp + 4608);
    kf[6] = *(const __attribute__((address_space(3))) bf16x8*)(kp + 6144); kf[7] = *(const __attribute__((address_space(3))) bf16x8*)(kp + 6656);
}
__device__ __forceinline__ void kload2(bf16x8* kf, lds_cptr kp, int j) { kf[2 * j] = *(const __attribute__((address_space(3))) bf16x8*)(kp + j * 2048); kf[2 * j + 1] = *(const __attribute__((address_space(3))) bf16x8*)(kp + j * 2048 + 512); }
__device__ __forceinline__ void xload2(s16x4* kx, lds_cptr xp) { kx[0] = *(const __attribute__((address_space(3))) s16x4*)(xp); kx[1] = *(const __attribute__((address_space(3))) s16x4*)(xp + 256); }
__device__ __forceinline__ s16x4 vtr(lds_cptr p) { return __builtin_bit_cast(s16x4, __builtin_amdgcn_ds_read_tr16_b64_v4i16((__attribute__((address_space(3))) v4i16_t*)p)); }
__device__ __forceinline__ float rowmax(const f32x16& p0, const f32x16& p1) {
    float a = max3f(p0[0], p0[1], p1[0]), b = max3f(p0[2], p0[3], p1[1]); a = max3f(a, p1[2], p1[3]);
#pragma unroll
    for (int r = 4; r < 16; r += 4) { a = max3f(a, p0[r], p0[r + 1]); b = max3f(b, p0[r + 2], p0[r + 3]); a = max3f(a, p1[r], p1[r + 1]); b = max3f(b, p1[r + 2], p1[r + 3]); }
    const float m = max2f(a, b);
    auto rr = __builtin_amdgcn_permlane32_swap(__float_as_uint(m), __float_as_uint(m), false, false);
    return max2f(__uint_as_float(rr[0]), __uint_as_float(rr[1]));
}
__device__ __forceinline__ void pv(f32x16* o, int vb, bf16x8 pa0, bf16x8 pa1, bf16x8 pa2, bf16x8 pa3) {
#pragma unroll
    for (int d0 = 0; d0 < 2; ++d0) { s16x4 lo[4], hi[4];
#pragma unroll
        for (int ks = 0; ks < 4; ++ks) {
            asm volatile("ds_read_b64_tr_b16 %0,%1 offset:%c2" : "=&v"(lo[ks]) : "v"(vb), "i"(d0 * 4096 + ks * 1024) : "memory");
            asm volatile("ds_read_b64_tr_b16 %0,%1 offset:%c2" : "=&v"(hi[ks]) : "v"(vb), "i"(d0 * 4096 + ks * 1024 + 512) : "memory"); }
        asm volatile("s_waitcnt lgkmcnt(0)" ::: "memory"); SBAR();
#define PK(k) (bf16x8){lo[k][0], lo[k][1], lo[k][2], lo[k][3], hi[k][0], hi[k][1], hi[k][2], hi[k][3]}
        o[d0] = __builtin_amdgcn_mfma_f32_32x32x16_bf16(pa0, PK(0), o[d0], 0, 0, 0);
        o[d0] = __builtin_amdgcn_mfma_f32_32x32x16_bf16(pa1, PK(1), o[d0], 0, 0, 0);
        o[d0] = __builtin_amdgcn_mfma_f32_32x32x16_bf16(pa2, PK(2), o[d0], 0, 0, 0);
        o[d0] = __builtin_amdgcn_mfma_f32_32x32x16_bf16(pa3, PK(3), o[d0], 0, 0, 0);
#undef PK
    }
}
#define MF16(a, b, c) __builtin_amdgcn_mfma_f32_32x32x16_bf16(a, b, c, 0, 0, 0)
#define MF8(a, b, c) __builtin_amdgcn_mfma_f32_32x32x8bf16_1k(a, b, c, 0, 0, 0)

template <int THRL> __device__ __forceinline__ void fox_unit(int b, int h, int qb, const bf16raw* __restrict__ Z, const float* __restrict__ FABS, const unsigned char* __restrict__ KXT,
                                                             bf16raw* MG, const float* __restrict__ gn_a, LAS unsigned char* shm, const int tid) {
    const int lane = tid & 63, r32 = lane & 31, hi = lane >> 5; const int wid = __builtin_amdgcn_readfirstlane(tid >> 6);
    const long rowbase = (long)b * SEQ; const int q0 = qb * QB;
    const bf16raw* Qw = Z + (rowbase + q0 + wid * QBLK) * NZ + ZQA + h * HD;
    const bf16raw* Kh = Z + rowbase * NZ + ZKA + h * HD, *Vh = Z + rowbase * NZ + ZVA + h * HD;
    const unsigned char* Xh = KXT + (size_t)(b * NH + h) * (SEQ / 64) * 1024;
    const unsigned lds0 = (unsigned)(uintptr_t)shm;
    LAS float* wsf = (LAS float*)(shm + LDS_WS) + wid * 64;
    const unsigned kvo = (unsigned)(lane * NZ + wid * 8) * 2u, vvo = (unsigned)((16 * (wid & 3) + (lane >> 2)) * NZ + (wid >> 2) * 32 + (lane & 3) * 8) * 2u, xvo = (unsigned)((wid & 3) * 256 + lane * 4);
    const unsigned kdst = lds0 + LDS_K + wid * 1024, vdst = lds0 + LDS_V + wid * 1024, xdst = lds0 + LDS_K + XOFF + (wid & 3) * 256;
#define DMA_K(t, slot) do { glds16(Kh + (long)(t) * KVBLK * NZ, kvo, (unsigned)__builtin_amdgcn_readfirstlane(kdst + (slot))); glds4(Xh + (size_t)(t) * 1024, xvo, (unsigned)__builtin_amdgcn_readfirstlane(xdst + (slot))); } while (0)
#define DMA_V(t, slot) glds16(Vh + (long)(t) * KVBLK * NZ, vvo, (unsigned)__builtin_amdgcn_readfirstlane(vdst + (slot)))
    const int vb0 = (int)(lds0 + LDS_V) + ((lane >> 4) & 1) * 32 + (lane & 3) * 8 + (4 * hi + ((lane & 15) >> 2)) * 64;
    bf16x8 kf[8]; s16x4 kx[2];
    const lds_cptr shm3 = (lds_cptr)shm; const lds_cptr kp0 = shm3 + LDS_K + hi * 1024 + r32 * 16; const lds_cptr xp0 = shm3 + LDS_K + XOFF + hi * 512 + r32 * 8;
    const lds_cptr vp0 = shm3 + LDS_V + ((lane >> 4) & 1) * 32 + (lane & 3) * 8 + (4 * hi + ((lane & 15) >> 2)) * 64;
    const int NT = (q0 + QB) / KVBLK;
    DMA_K(0, 0); DMA_V(0, 0); DMA_K(1, SLOTB);
    bf16x8 qr[4];
#pragma unroll
    for (int d0 = 0; d0 < 4; ++d0) qr[d0] = *reinterpret_cast<const bf16x8*>(&Qw[(long)r32 * NZ + d0 * 16 + hi * 8]);
    const float fq2 = FABS[(size_t)(b * NH + h) * SEQ + q0 + wid * QBLK + r32] * LOG2E;
    float mhat = 0.f, l_reg = 0.f; f32x16 o[2]; o[0] = f32x16{}; o[1] = f32x16{};
    s16x4 qx = make_qx(fq2, hi);
    const f32x16 zero16 = f32x16{};
    const int qrel = wid * QBLK + r32;
#define CMASK(P0, P1, t) do { int jb_ = (t) - (NT - 4); if (jb_ >= 0) cmask(P0, P1, jb_, qrel, hi); } while (0)
    bool resc = false;
#define START(P0, P1) do { const float rm = rowmax(P0, P1); resc = false; \
    { const float dl = rm; mhat = fadd_s(mhat, dl); \
      _Pragma("unroll") for (int r = 0; r < 16; ++r) { P0[r] = fsub_s(P0[r], dl); P1[r] = fsub_s(P1[r], dl); } \
      qx = make_qx(fq2 - mhat, hi); asm volatile("" : "+v"(qx)); } \
    _Pragma("unroll") for (int r = 0; r < 16; ++r) P0[r] = __builtin_amdgcn_exp2f(P0[r]); } while (0)
#define RESC() do { if (resc) { asm volatile("s_waitcnt lgkmcnt(0)" ::: "memory"); \
      _Pragma("unroll") for (int d_ = 0; d_ < 2; ++d_) _Pragma("unroll") for (int r = 0; r < 16; ++r) o[d_][r] *= wsf[crow(r, hi)]; } } while (0)
    f32x16 pA0, pA1, pB0, pB1;
    int sl_prev = 0, sl_cur = 0, sl_next = SLOTB;
#define ROT() do { sl_prev = sl_cur; sl_cur = sl_next; sl_next = (sl_next == (NSLOT - 1) * SLOTB) ? 0 : sl_next + SLOTB; } while (0)
    DMA_K(2, 2 * SLOTB);
    WAIT_BAR(5);
    kload8(kf, kp0); xload2(kx, xp0);
    pA0 = MF8(kx[0], qx, zero16); pA1 = MF8(kx[1], qx, zero16);
#pragma unroll
    for (int d0 = 0; d0 < 4; ++d0) { pA0 = MF16(kf[2 * d0], qr[d0], pA0); pA1 = MF16(kf[2 * d0 + 1], qr[d0], pA1); }
    asm volatile("s_nop 15\n\ts_nop 7" : "+v"(pA0), "+v"(pA1)); CMASK(pA0, pA1, 0);
    START(pA0, pA1);
    _Pragma("unroll") for (int r = 0; r < 16; ++r) pA1[r] = __builtin_amdgcn_exp2f(pA1[r]);
    WAIT_BAR(0);
    DMA_K(3, 0); DMA_V(1, SLOTB);
    ROT();
    kload8(kf, kp0 + sl_cur); xload2(kx, xp0 + sl_cur);
    WAIT_BAR(3);
    s16x4 vlo[8], vhi[8]; u32x4 pw0, pw1, pw2, pw3;
#define PKW(P, B) cvtpk_s(P[B], P[B + 1])
#define PAF(k) __builtin_bit_cast(bf16x8, pw##k)
#define VFR(i) (bf16x8){vlo[i][0], vlo[i][1], vlo[i][2], vlo[i][3], vhi[i][0], vhi[i][1], vhi[i][2], vhi[i][3]}
#define PIN(x) asm volatile("" : "+v"(x))
#define MX3(a, b, c) __builtin_fmaxf(__builtin_fmaxf((a), (b)), (c))
#define GAPA(MF, A0, A1, A2, A3, W0, W1, PW) do { MF; sacc += A0; sacc += A1; sacc += A2; sacc += A3; PIN(sacc); W0; W1; PIN(PW); SBAR(); } while (0)
#define EX(v) __builtin_amdgcn_exp2f(v)
#define GAPB(MF, X, B) do { MF; X[B] = EX(X[B]); X[B + 1] = EX(X[B + 1]); X[B + 2] = EX(X[B + 2]); X[B + 3] = EX(X[B + 3]); PIN(X); SBAR(); } while (0)
#define VRD(i) do { vlo[i] = vtr(vp_ + (((i) >> 2) * 4096 + ((i) & 3) * 1024)); vhi[i] = vtr(vp_ + (((i) >> 2) * 4096 + ((i) & 3) * 1024 + 512)); } while (0)
#define KRD(G, j) do { if (G) { kload2(kf, kp0 + sl_next, j); SBAR(); } } while (0)
#define XRD(G) do { if (G) { xload2(kx, xp0 + sl_next); SBAR(); } } while (0)
#define STEP(C0, C1, P0, P1, t, GK, GV, GL) do { SBAR(); \
    const lds_cptr vp_ = vp0 + sl_prev; \
    C0 = MF8(kx[0], qx, zero16); C1 = MF8(kx[1], qx, zero16); SBAR(); \
    VRD(0); SBAR(); float sacc = (P0[0] + P0[1]); \
    GAPA(C0 = MF16(kf[0], qr[0], C0), P0[2], P0[3], P0[4], P0[5],     pw0[0] = PKW(P0, 0), pw0[1] = PKW(P0, 2), pw0); \
    VRD(4); SBAR(); GAPA(C1 = MF16(kf[1], qr[0], C1), P0[6], P0[7], P0[8], P0[9],     pw0[2] = PKW(P0, 4), pw0[3] = PKW(P0, 6), pw0); \
    VRD(1); SBAR(); GAPA(C0 = MF16(kf[2], qr[1], C0),   P0[10], P0[11], P0[12], P0[13], pw1[0] = PKW(P0, 8), pw1[1] = PKW(P0, 10), pw1); \
    VRD(5); SBAR(); GAPA(C1 = MF16(kf[3], qr[1], C1),   P0[14], P0[15], P1[0], P1[1],   pw1[2] = PKW(P0, 12), pw1[3] = PKW(P0, 14), pw1); \
    VRD(2); SBAR(); GAPA(C0 = MF16(kf[4], qr[2], C0),   P1[2], P1[3], P1[4], P1[5],     pw2[0] = PKW(P1, 0), pw2[1] = PKW(P1, 2), pw2); \
    VRD(6); SBAR(); GAPA(C1 = MF16(kf[5], qr[2], C1),   P1[6], P1[7], P1[8], P1[9],     pw2[2] = PKW(P1, 4), pw2[3] = PKW(P1, 6), pw2); \
    VRD(3); SBAR(); GAPA(C0 = MF16(kf[6], qr[3], C0),   P1[10], P1[11], P1[12], P1[13], pw3[0] = PKW(P1, 8), pw3[1] = PKW(P1, 10), pw3); \
    VRD(7); SBAR(); GAPA(C1 = MF16(kf[7], qr[3], C1),   P1[14], P1[15], 0.f, 0.f,       pw3[2] = PKW(P1, 12), pw3[3] = PKW(P1, 14), pw3); \
    l_reg += sacc; \
    if (GK) { DMA_K((t) + 3, sl_cur); } if (GV) { DMA_V((t) + 1, sl_next); } \
    CMASK(C0, C1, t); \
    { float a = MX3(C0[0], C0[1], C1[0]), b_ = MX3(C0[2], C0[3], C1[1]); a = MX3(a, C1[2], C1[3]); \
      _Pragma("unroll") for (int r = 4; r < 16; r += 4) { a = MX3(a, C0[r], C0[r + 1]); b_ = MX3(b_, C0[r + 2], C0[r + 3]); a = MX3(a, C1[r], C1[r + 1]); b_ = MX3(b_, C1[r + 2], C1[r + 3]); } \
      float rm = __builtin_fmaxf(a, b_); { auto rr = __builtin_amdgcn_permlane32_swap(__float_as_uint(rm), __float_as_uint(rm), false, false); rm = __builtin_fmaxf(__uint_as_float(rr[0]), __uint_as_float(rr[1])); } \
      resc = false; \
      if (__builtin_expect(__any(rm > (float)THRL), 0)) { const float dl = __builtin_fmaxf(rm, 0.f); mhat += dl; \
        _Pragma("unroll") for (int r = 0; r < 16; ++r) { C0[r] -= dl; C1[r] -= dl; } \
        qx = make_qx(fq2 - mhat, hi); asm volatile("" : "+v"(qx)); \
        const float f = __builtin_amdgcn_exp2f(-dl); l_reg *= f; if (hi == 0) wsf[r32] = f; resc = true; } } \
    SBAR(); \
    GAPB(o[0] = MF16(PAF(0), VFR(0), o[0]), C0, 0); \
    GAPB(o[1] = MF16(PAF(0), VFR(4), o[1]), C0, 4); \
    KRD(GL, 0); GAPB(o[0] = MF16(PAF(1), VFR(1), o[0]), C0, 8); \
    KRD(GL, 1); GAPB(o[1] = MF16(PAF(1), VFR(5), o[1]), C0, 12); \
    KRD(GL, 2); GAPB(o[0] = MF16(PAF(2), VFR(2), o[0]), C1, 0); \
    KRD(GL, 3); GAPB(o[1] = MF16(PAF(2), VFR(6), o[1]), C1, 4); \
    XRD(GL); GAPB(o[0] = MF16(PAF(3), VFR(3), o[0]), C1, 8); \
    GAPB(o[1] = MF16(PAF(3), VFR(7), o[1]), C1, 12); \
    } while (0)
    int t = 1;
#undef CMASK
#define CMASK(P0, P1, t) do { } while (0)
    for (; t + 5 < NT; t += 2) {
        STEP(pB0, pB1, pA0, pA1, t, true, true, true);     WAIT_BAR(3); RESC(); ROT();
        STEP(pA0, pA1, pB0, pB1, t + 1, true, true, true); WAIT_BAR(3); RESC(); ROT();
    }
#undef CMASK
#define CMASK(P0, P1, t) do { int jb_ = (t) - (NT - 4); if (jb_ >= 0) cmask(P0, P1, jb_, qrel, hi); } while (0)
#define ENDW(tt) do { if ((tt) + 3 < NT) { WAIT_BAR(3); } else if ((tt) + 2 < NT) { WAIT_BAR(1); } else { WAIT_BAR(0); } } while (0)
    for (; t + 1 < NT; t += 2) {
        STEP(pB0, pB1, pA0, pA1, t, (t + 3 < NT), (t + 1 < NT), (t + 1 < NT));         ENDW(t);     RESC(); ROT();
        STEP(pA0, pA1, pB0, pB1, t + 1, (t + 4 < NT), (t + 2 < NT), (t + 2 < NT));     ENDW(t + 1); RESC(); ROT();
    }
    STEP(pB0, pB1, pA0, pA1, NT - 1, false, false, false); RESC();
    { float sacc = pB0[0] + pB0[1]; _Pragma("unroll") for (int r = 2; r < 16; ++r) sacc += pB0[r]; _Pragma("unroll") for (int r = 0; r < 16; ++r) sacc += pB1[r]; l_reg += sacc;
      pw0 = (u32x4){PKW(pB0, 0), PKW(pB0, 2), PKW(pB0, 4), PKW(pB0, 6)}; pw1 = (u32x4){PKW(pB0, 8), PKW(pB0, 10), PKW(pB0, 12), PKW(pB0, 14)};
      pw2 = (u32x4){PKW(pB1, 0), PKW(pB1, 2), PKW(pB1, 4), PKW(pB1, 6)}; pw3 = (u32x4){PKW(pB1, 8), PKW(pB1, 10), PKW(pB1, 12), PKW(pB1, 14)};
      SBAR(); pv(o, vb0 + sl_cur, PAF(0), PAF(1), PAF(2), PAF(3)); }
#undef PKW
#undef PAF
#undef VFR
#undef PIN
#undef MX3
#undef GAPA
#undef GAPB
#undef EX
#undef VRD
#undef KRD
#undef XRD
#undef STEP
#undef ENDW
    { auto rr = __builtin_amdgcn_permlane32_swap(__float_as_uint(l_reg), __float_as_uint(l_reg), false, false); l_reg = __uint_as_float(rr[0]) + __uint_as_float(rr[1]); }
    if (hi == 0) wsf[32 + r32] = l_reg; asm volatile("s_waitcnt lgkmcnt(0)" ::: "memory");
    float rli[16];
#pragma unroll
    for (int r = 0; r < 16; ++r) rli[r] = __builtin_amdgcn_rcpf(wsf[32 + crow(r, hi)]);
    { LAS float* stg = (LAS float*)(shm + LDS_OST + wid * OST_BYTES);
#pragma unroll
      for (int r = 0; r < 16; ++r) { const int orow = crow(r, hi);
#pragma unroll
          for (int d0 = 0; d0 < 2; ++d0) stg[orow * OST_STRIDE + d0 * 32 + r32] = o[d0][r] * rli[r]; }
      asm volatile("s_waitcnt lgkmcnt(0)" ::: "memory");
      bf16raw* Ow = MG + (rowbase + q0 + wid * QBLK) * DM + h * HD;
#pragma unroll
      for (int i = 0; i < 4; ++i) { const int row = i * 8 + (lane >> 3), c8 = (lane & 7) * 8;
          const v4f a = *(const LAS v4f*)(stg + row * OST_STRIDE + c8), c = *(const LAS v4f*)(stg + row * OST_STRIDE + c8 + 4);
          float ss = (a[0] * a[0] + a[1] * a[1]) + (a[2] * a[2] + a[3] * a[3]) + (c[0] * c[0] + c[1] * c[1]) + (c[2] * c[2] + c[3] * c[3]);
          ss = sum8_dpp(ss);
          const float rs = 1.0f / sqrtf(ss * (1.0f / 64.0f) + RMS_EPS);
          const v4f g0 = *(const v4f*)(gn_a + h * HD + c8), g1 = *(const v4f*)(gn_a + h * HD + c8 + 4);
          u32x4 w; w.x = cvtpk_s(a[0] * rs * g0[0], a[1] * rs * g0[1]); w.y = cvtpk_s(a[2] * rs * g0[2], a[3] * rs * g0[3]);
          w.z = cvtpk_s(c[0] * rs * g1[0], c[1] * rs * g1[1]); w.w = cvtpk_s(c[2] * rs * g1[2], c[3] * rs * g1[3]);
          *(u32x4*)(Ow + (long)row * DM + c8) = w; } }
    asm volatile("s_waitcnt lgkmcnt(0)\n\ts_barrier" ::: "memory");
#undef DMA_K
#undef DMA_V
#undef CMASK
#undef START
#undef RESC
#undef ROT
}
#undef SBAR
#undef WAIT_BAR
#undef MF16
#undef MF8
}
#define XB_TMO      128
#define XB_XCNT(j)  (256  + 64 * (j))
#define XB_XSUB(j)  (1280 + 64 * (j))
#define XB_XGEN(j)  (2304 + 64 * (j))
#define XB_TOP      3328
#define XB_TOPGEN   3392
#define XCD_BAR_WORDS 3456
#define XB_SPIN_CAP (1u << 18)

__device__ __forceinline__ unsigned xb_ld(unsigned* p)              { return __hip_atomic_load(p, __ATOMIC_RELAXED, __HIP_MEMORY_SCOPE_AGENT); }
__device__ __forceinline__ unsigned xb_add(unsigned* p, unsigned v) { return __hip_atomic_fetch_add(p, v, __ATOMIC_RELAXED, __HIP_MEMORY_SCOPE_AGENT); }
__device__ __forceinline__ unsigned xb_xcc_id() { return (unsigned)__builtin_amdgcn_s_getreg((3 << 11) | 20) & 0xFu; }
#define XB_SPIN(cond, bar) do { unsigned _sp = 0; while (cond) { __builtin_amdgcn_s_sleep(1); \
    if ((++_sp & 255u) == 0u) { if (xb_ld(&(bar)[XB_TMO])) break; if (_sp > XB_SPIN_CAP) { atomicAdd(&(bar)[XB_TMO], 1u); break; } } } } while (0)

struct XcdBarrier {
    unsigned* bar; unsigned x;
    volatile LAS unsigned* st;
};

__device__ __forceinline__ XcdBarrier xcd_barrier_post(unsigned* bar, volatile LAS unsigned* st, const int tid) {
    XcdBarrier b; b.bar = bar; b.x = xb_xcc_id(); b.st = st;
    if (tid == 0) (void)xb_add(&bar[XB_XCNT(b.x)], 1u);
    return b;
}
__device__ __forceinline__ void xcd_barrier_complete(unsigned* bar, unsigned x, unsigned& nloc, unsigned& nx) {
    const unsigned G = gridDim.x * gridDim.y * gridDim.z;
    unsigned sum, cnt, mine, sp = 0u;
    for (;;) {
        sum = 0u; cnt = 0u; mine = 0u;
#pragma unroll
        for (unsigned j = 0; j < 16; ++j) { const unsigned c = xb_ld(&bar[XB_XCNT(j)]); sum += c; cnt += (c > 0u) ? 1u : 0u; mine = (j == x) ? c : mine; }
        if (sum == G) break;
        __builtin_amdgcn_s_sleep(1);
        if ((++sp & 255u) == 0u) { if (xb_ld(&bar[XB_TMO])) break; if (sp > XB_SPIN_CAP) { atomicAdd(&bar[XB_TMO], 1u); break; } }
    }
    nloc = mine > 0u ? mine : 1u; nx = cnt > 0u ? cnt : 1u;
}

__device__ __forceinline__ void xcd_barrier(const XcdBarrier& b, const int tid) {
    asm volatile("s_waitcnt vmcnt(0)" ::: "memory");
    __syncthreads();
    if (tid == 0) {
        unsigned* bar = b.bar;
        __builtin_amdgcn_s_waitcnt(0);
        unsigned nloc = b.st[0], nx = b.st[1];
        if (nloc == 0u) { xcd_barrier_complete(bar, b.x, nloc, nx); b.st[0] = nloc; b.st[1] = nx; }
        const unsigned old = xb_add(&bar[XB_XSUB(b.x)], 1u);
        const unsigned gen = old / nloc;
        if (old + 1u == (gen + 1u) * nloc) {
            __builtin_amdgcn_fence(__ATOMIC_RELEASE, "agent");
            asm volatile("s_waitcnt vmcnt(0)" ::: "memory");
            const unsigned og = xb_add(&bar[XB_TOP], 1u);
            const unsigned tg = og / nx;
            if (og + 1u == (tg + 1u) * nx) xb_add(&bar[XB_TOPGEN], 1u);
            else XB_SPIN(xb_ld(&bar[XB_TOPGEN]) == tg, bar);
            __builtin_amdgcn_fence(__ATOMIC_ACQUIRE, "agent");
            xb_add(&bar[XB_XGEN(b.x)], 1u);
            asm volatile("s_waitcnt vmcnt(0)" ::: "memory");
        } else {
            XB_SPIN(xb_ld(&bar[XB_XGEN(b.x)]) == gen, bar);
            __builtin_amdgcn_fence(__ATOMIC_ACQUIRE, "agent");
            asm volatile("s_waitcnt vmcnt(0)" ::: "memory");
        }
    }
    __syncthreads();
}

constexpr size_t MiB = 1u << 20;
#define RLX_AGENT __ATOMIC_RELAXED, __HIP_MEMORY_SCOPE_AGENT
constexpr size_t WS_ADA = 1 * MiB;
constexpr size_t WS_WIN = 2 * MiB, WS_WOUT = 9 * MiB, WS_WUP = 12 * MiB, WS_WDN = 24 * MiB;
constexpr size_t WS_FLOC = 30 * MiB, WS_FABS = 32 * MiB;
constexpr size_t WS_CT = 34 * MiB;
constexpr size_t WS_CS = 36 * MiB;
constexpr size_t WS_LSE = 40 * MiB;
constexpr size_t WS_ST1 = 48 * MiB;
constexpr size_t WS_KXT = 52 * MiB;
constexpr size_t WS_H = 64 * MiB;
constexpr size_t WS_Z = 192 * MiB;
constexpr size_t WS_OP = 576 * MiB;
constexpr size_t WS_MG = 768 * MiB;
constexpr size_t WS_U = 192 * MiB;
constexpr size_t WS_G = 544 * MiB;
constexpr size_t WS_END = 896 * MiB;

constexpr int LDS_BYTES = 147456;
constexpr int RING_BYTES = 131072;

struct Params {
    const float *x, *c; const int* pos; const float *w_ada, *b_ada, *w_in, *b_fgate, *gn_a, *gn_b, *w_out, *ln1_g, *ln1_b, *w_up, *conv_w, *conv_b, *w_down, *ln2_g, *ln2_b;
    float* out; unsigned char* ws; int ph_lo, ph_hi;
};

__device__ __forceinline__ int src_in(int n) {
    if (n < 1536) return n;
    const int s = n & 63; int sd = s;
    if (n < 2560 && s < 16) { const int a = s >> 2; sd = ((((a & 1) << 1) | (a >> 1)) << 2) | (s & 3); }
    return n - s + sd + 8;
}
template <int MAP> __device__ __forceinline__ void transpose_item(const float* W, int ldw, int K, int N, bf16raw* WT, LAS float* scr, int item, int lane) {
    const int nblk = N / 32, kb = item / nblk, nb = item % nblk, k0 = 64 * kb, n0 = 32 * nb;
    const int nsrc = (MAP == 1) ? src_in(n0 + (lane & 31)) : n0 + (lane & 31);
#pragma unroll 8
    for (int i = 0; i < 32; ++i) { const int kk = 2 * i + (lane >> 5); scr[kk * 33 + (lane & 31)] = W[(size_t)(k0 + kk) * ldw + nsrc]; }
    asm volatile("s_waitcnt lgkmcnt(0)" ::: "memory");
    const int c = lane & 7;
#pragma unroll
    for (int j = 0; j < 4; ++j) { const int n = (lane >> 3) + 8 * j; const LAS float* s = scr + (8 * c) * 33 + n;
        v4u o; o.x = pk2(s[0 * 33], s[1 * 33]); o.y = pk2(s[2 * 33], s[3 * 33]); o.z = pk2(s[4 * 33], s[5 * 33]); o.w = pk2(s[6 * 33], s[7 * 33]);
        *(v4u*)(WT + (size_t)(n0 + n) * K + k0 + 8 * c) = o; }
    asm volatile("s_waitcnt lgkmcnt(0)" ::: "memory");
}

__device__ __forceinline__ void phase_prologue(const Params& p, LAS unsigned char* lds, const int tid) {
    const int lane = tid & 63, wave = __builtin_amdgcn_readfirstlane(tid >> 6);
    float* ADA = (float*)(p.ws + WS_ADA);
    for (int task = blockIdx.x; task < 96; task += gridDim.x) {
        LAS float* scT = (LAS float*)lds;
        LAS float* red = (LAS float*)(lds + 65536);
        for (int i = tid; i < NB * DM; i += 512) { const int b = i >> 10, k = i & 1023; const float v = p.c[i]; scT[k * 16 + b] = v / (1.0f + __expf(-v)); }
        __syncthreads();
        const int col = task * 64 + lane;
        float acc[16];
#pragma unroll
        for (int b = 0; b < 16; ++b) acc[b] = 0.f;
#pragma unroll 4
        for (int kk = 0; kk < 128; ++kk) { const int k = wave * 128 + kk; const float wv = p.w_ada[(size_t)k * (6 * DM) + col];
#pragma unroll
            for (int q = 0; q < 4; ++q) { const v4f s4 = *(const LAS v4f*)(scT + k * 16 + 4 * q);
                acc[4 * q + 0] += s4[0] * wv; acc[4 * q + 1] += s4[1] * wv; acc[4 * q + 2] += s4[2] * wv; acc[4 * q + 3] += s4[3] * wv; } }
#pragma unroll
        for (int b = 0; b < 16; ++b) red[(wave * 16 + b) * 64 + lane] = acc[b];
        __syncthreads();
        for (int i = tid; i < 16 * 64; i += 512) { const int b = i >> 6, cl = i & 63; float s = p.b_ada[task * 64 + cl];
#pragma unroll
            for (int w = 0; w < 8; ++w) s += red[(w * 16 + b) * 64 + cl];
            ADA[(size_t)b * (6 * DM) + task * 64 + cl] = s; }
        __syncthreads();
    }
    LAS float* scr = (LAS float*)(lds + wave * 16384);
    const int gw = blockIdx.x * 8 + wave, NGW = gridDim.x * 8;
    constexpr int I_IN = (DM / 64) * (NZ / 32), I_OUT = (DM / 64) * (DM / 32), I_UP = (DM / 64) * (NUP / 32), I_DN = (DFF / 64) * (DM / 32);
    for (int it = gw; it < I_IN + I_OUT + I_UP + I_DN; it += NGW) {
        int r = it;
        if (r < I_IN) { transpose_item<1>(p.w_in, DIN, DM, NZ, (bf16raw*)(p.ws + WS_WIN), scr, r, lane); continue; } r -= I_IN;
        if (r < I_OUT) { transpose_item<0>(p.w_out, DM, DM, DM, (bf16raw*)(p.ws + WS_WOUT), scr, r, lane); continue; } r -= I_OUT;
        if (r < I_UP) { transpose_item<0>(p.w_up, NUP, DM, NUP, (bf16raw*)(p.ws + WS_WUP), scr, r, lane); continue; } r -= I_UP;
        transpose_item<0>(p.w_down, DM, DFF, DM, (bf16raw*)(p.ws + WS_WDN), scr, r, lane);
    }
}

__device__ __forceinline__ void phase_pre1(const Params& p, LAS unsigned char* lds, const int tid) {
    const int lane = tid & 63, wave = __builtin_amdgcn_readfirstlane(tid >> 6);
    const float* ADA = (const float*)(p.ws + WS_ADA);
    bf16raw* H = (bf16raw*)(p.ws + WS_H);
    float* FLOC = (float*)(p.ws + WS_FLOC); float* CT = (float*)(p.ws + WS_CT); float* CS = (float*)(p.ws + WS_CS);
    LAS float* lfs = (LAS float*)lds;
    float wf[4][4][8];
#pragma unroll
    for (int j = 0; j < 4; ++j)
#pragma unroll
        for (int e = 0; e < 4; ++e) { const float* wp = p.w_in + (size_t)(4 * lane + 256 * j + e) * DIN + 1536;
            const v4f a = *(const v4f*)wp, b = *(const v4f*)(wp + 4);
            wf[j][e][0] = a[0]; wf[j][e][1] = a[1]; wf[j][e][2] = a[2]; wf[j][e][3] = a[3]; wf[j][e][4] = b[0]; wf[j][e][5] = b[1]; wf[j][e][6] = b[2]; wf[j][e][7] = b[3]; }
    for (int chunk = blockIdx.x; chunk < MTOK / 256; chunk += gridDim.x) {
        const int b = chunk >> 4, t0 = (chunk & 15) * 256;
        v4f sc[4], sh[4];
#pragma unroll
        for (int j = 0; j < 4; ++j) { sh[j] = *(const v4f*)(ADA + (size_t)b * (6 * DM) + 4 * lane + 256 * j); sc[j] = *(const v4f*)(ADA + (size_t)b * (6 * DM) + DM + 4 * lane + 256 * j) + 1.0f; }
        for (int i = 0; i < 32; ++i) {
            const int rl = wave * 32 + i; const size_t row = (size_t)b * SEQ + t0 + rl;
            const v4f* xr = (const v4f*)(p.x + row * DM) + lane;
            float s[8];
#pragma unroll
            for (int hh = 0; hh < 8; ++hh) s[hh] = 0.f;
            unsigned long long* o8 = (unsigned long long*)(H + row * DM) + lane;
#pragma unroll
            for (int j = 0; j < 4; ++j) { const v4f hv = xr[64 * j] * sc[j] + sh[j];
                o8[64 * j] = (unsigned long long)pk2(hv[0], hv[1]) | ((unsigned long long)pk2(hv[2], hv[3]) << 32);
#pragma unroll
                for (int e = 0; e < 4; ++e)
#pragma unroll
                    for (int hh = 0; hh < 8; ++hh) s[hh] += hv[e] * wf[j][e][hh]; }
#pragma unroll
            for (int hh = 0; hh < 8; ++hh) s[hh] = wave_sum(s[hh]);
            if (lane < 8) { float v = s[0];
#pragma unroll
                for (int hh = 1; hh < 8; ++hh) v = (lane == hh) ? s[hh] : v;
                v += p.b_fgate[lane];
                lfs[rl * 8 + lane] = fminf(v, 0.f) - log1pf(expf(-fabsf(v))); }
        }
        for (int i = tid; i < 256 * 8; i += 512) { const int rl = i >> 3, fi = i & 7; const size_t row = (size_t)b * SEQ + t0 + rl;
            const float fr = (fi == 0) ? 1.0f : (fi == 1) ? 0.1939227432012558f : (fi == 2) ? 0.03760603070259094f : (fi == 3) ? 0.007292664609849453f : (fi == 4) ? 0.0014142135623842478f
                           : (fi == 5) ? 0.00027424818836152554f : (fi == 6) ? 5.3182957344688475e-05f : 1.0313385246263351e-05f;
            double rev = (double)p.pos[row] * (double)fr * 0.15915494309189535; rev -= __builtin_floor(rev);
            const float rf = (float)rev;
            CS[row * 16 + fi] = __builtin_amdgcn_cosf(rf); CS[row * 16 + 8 + fi] = __builtin_amdgcn_sinf(rf); }
        __syncthreads();
        { const int hh = wave; float a0 = lfs[(4 * lane + 0) * 8 + hh], a1 = lfs[(4 * lane + 1) * 8 + hh], a2 = lfs[(4 * lane + 2) * 8 + hh], a3 = lfs[(4 * lane + 3) * 8 + hh];
          a1 += a0; a2 += a1; a3 += a2; float run = a3;
#pragma unroll
          for (int o = 1; o < 64; o <<= 1) { const float v = __shfl_up(run, o); if (lane >= o) run += v; }
          const float excl = run - a3;
          *(v4f*)(FLOC + (size_t)(b * NH + hh) * SEQ + t0 + 4 * lane) = (v4f){a0 + excl, a1 + excl, a2 + excl, a3 + excl};
          if (lane == 63) CT[(b * NH + hh) * 16 + (chunk & 15)] = run; }
        __syncthreads();
    }
}
__device__ __forceinline__ void phase_fabs(const Params& p, const int tid) {
    const float* FLOC = (const float*)(p.ws + WS_FLOC); const float* CT = (const float*)(p.ws + WS_CT); float* FABS = (float*)(p.ws + WS_FABS);
    for (int i = blockIdx.x * 512 + tid; i < NB * NH * SEQ; i += gridDim.x * 512) {
        const int bh = i >> 12, t = i & 4095, ch = t >> 8; float off = 0.f;
        for (int c2 = 0; c2 < ch; ++c2) off += CT[bh * 16 + c2];
        const float F = FLOC[i] + off; FABS[i] = F;
        const float bq = -F * LOG2E; const unsigned w1 = f2bf(bq); const float r1 = bq - __builtin_bit_cast(float, w1 << 16); const unsigned w2 = f2bf(r1);
        const float r2 = r1 - __builtin_bit_cast(float, w2 << 16); const unsigned w3 = f2bf(r2);
        unsigned char* img = p.ws + WS_KXT + ((size_t)bh * (SEQ / 64) + (t >> 6)) * 1024 + (t & 63) * 8;
        *(v2u*)img = (v2u){0x3f803f80u, 0x3f80u | (w1 << 16)}; *(v2u*)(img + 512) = (v2u){w2 | (w3 << 16), 0u}; }
}
__device__ __forceinline__ void phase_merge(const Params& p, const int tid) {
    const int lane = tid & 63, wave = tid >> 6;
    const bf16raw* OP = (const bf16raw*)(p.ws + WS_OP); const float* LSE = (const float*)(p.ws + WS_LSE); bf16raw* MG = (bf16raw*)(p.ws + WS_MG);
    const int hh = lane >> 3;
    const v4f g0 = *(const v4f*)(p.gn_b + lane * 8), g1 = *(const v4f*)(p.gn_b + lane * 8 + 4);
    for (size_t row = (size_t)blockIdx.x * 8 + wave; row < (size_t)MTOK; row += (size_t)gridDim.x * 8) {
        float ls[3]; v4u w[3];
#pragma unroll
        for (int q = 0; q < 3; ++q) { ls[q] = LSE[((size_t)q * MTOK + row) * NH + hh]; w[q] = *(const v4u*)(OP + ((size_t)q * MTOK + row) * 512 + lane * 8); }
        const float mx = fmaxf(ls[0], fmaxf(ls[1], ls[2]));
        float e[3]; e[0] = __builtin_amdgcn_exp2f(ls[0] - mx); e[1] = __builtin_amdgcn_exp2f(ls[1] - mx); e[2] = __builtin_amdgcn_exp2f(ls[2] - mx);
        const float inv = 1.0f / (e[0] + e[1] + e[2]);
        float o[8];
#pragma unroll
        for (int k = 0; k < 8; ++k) o[k] = 0.f;
#pragma unroll
        for (int q = 0; q < 3; ++q) { const float wq = e[q] * inv;
            o[0] += wq * bflo(w[q].x); o[1] += wq * bfhi(w[q].x); o[2] += wq * bflo(w[q].y); o[3] += wq * bfhi(w[q].y);
            o[4] += wq * bflo(w[q].z); o[5] += wq * bfhi(w[q].z); o[6] += wq * bflo(w[q].w); o[7] += wq * bfhi(w[q].w); }
        float ss = 0.f;
#pragma unroll
        for (int k = 0; k < 8; ++k) ss += o[k] * o[k];
        ss = sum8_dpp(ss);
        const float rs = 1.0f / sqrtf(ss * (1.0f / 64.0f) + RMS_EPS);
        v4u ow; ow.x = pk2(o[0] * rs * g0[0], o[1] * rs * g0[1]); ow.y = pk2(o[2] * rs * g0[2], o[3] * rs * g0[3]);
        ow.z = pk2(o[4] * rs * g1[0], o[5] * rs * g1[1]); ow.w = pk2(o[6] * rs * g1[2], o[7] * rs * g1[3]);
        *(v4u*)(MG + row * DM + 512 + lane * 8) = ow;
    }
}
__device__ __forceinline__ void phase_ln1(const Params& p, const int tid) {
    const int lane = tid & 63, wave = tid >> 6;
    const float* ADA = (const float*)(p.ws + WS_ADA); bf16raw* H = (bf16raw*)(p.ws + WS_H); float* ST = (float*)(p.ws + WS_ST1);
    v4f lg[4], lb[4];
#pragma unroll
    for (int j = 0; j < 4; ++j) { lg[j] = *(const v4f*)(p.ln1_g + 4 * lane + 256 * j); lb[j] = *(const v4f*)(p.ln1_b + 4 * lane + 256 * j); }
    for (size_t row = (size_t)blockIdx.x * 8 + wave; row < (size_t)MTOK; row += (size_t)gridDim.x * 8) {
        const int b = (int)(row >> 12);
        const v4f* yr = (const v4f*)(p.out + row * DM) + lane;
        v4f v[4]; float s = 0.f;
#pragma unroll
        for (int j = 0; j < 4; ++j) { v[j] = yr[64 * j]; s += (v[j][0] + v[j][1]) + (v[j][2] + v[j][3]); }
        const float mean = wave_sum(s) * (1.0f / DM); float s2 = 0.f;
#pragma unroll
        for (int j = 0; j < 4; ++j) { v[j] = v[j] - mean; s2 += (v[j][0] * v[j][0] + v[j][1] * v[j][1]) + (v[j][2] * v[j][2] + v[j][3] * v[j][3]); }
        const float rstd = 1.0f / sqrtf(wave_sum(s2) * (1.0f / DM) + LN_EPS);
        if (lane == 0) *(v2f*)(ST + row * 2) = (v2f){mean, rstd};
        unsigned long long* o8 = (unsigned long long*)(H + row * DM) + lane;
#pragma unroll
        for (int j = 0; j < 4; ++j) { const v4f x1 = v[j] * rstd * lg[j] + lb[j];
            const v4f shf = *(const v4f*)(ADA + (size_t)b * (6 * DM) + 3 * DM + 4 * lane + 256 * j), scf = *(const v4f*)(ADA + (size_t)b * (6 * DM) + 4 * DM + 4 * lane + 256 * j);
            const v4f hv = x1 * (scf + 1.0f) + shf;
            o8[64 * j] = (unsigned long long)pk2(hv[0], hv[1]) | ((unsigned long long)pk2(hv[2], hv[3]) << 32); }
    }
}
__device__ __forceinline__ void phase_conv(const Params& p, int half, const int tid) {
    const bf16raw* U = (const bf16raw*)(p.ws + WS_U); bf16raw* G = (bf16raw*)(p.ws + WS_G) + (size_t)half * (MTOK / 2) * DFF;
    constexpr int CH = DFF / 8;
    for (size_t i = (size_t)blockIdx.x * 512 + tid; i < (size_t)(MTOK / 2) * CH; i += (size_t)gridDim.x * 512) {
        const int tl = (int)(i / CH), ch = (int)(i % CH), j0 = ch * 8, posn = tl & (SEQ - 1);
        float y[2][8];
#pragma unroll
        for (int part = 0; part < 2; ++part) {
            const int col = part * DFF + j0;
            const v4f b0 = *(const v4f*)(p.conv_b + col), b1 = *(const v4f*)(p.conv_b + col + 4);
            y[part][0] = b0[0]; y[part][1] = b0[1]; y[part][2] = b0[2]; y[part][3] = b0[3]; y[part][4] = b1[0]; y[part][5] = b1[1]; y[part][6] = b1[2]; y[part][7] = b1[3];
#pragma unroll
            for (int tap = 0; tap < 3; ++tap) { const int dt = 2 - tap;
                if (posn >= dt) { const v4u uw = *(const v4u*)(U + (size_t)(tl - dt) * NUP + col);
                    const v4f w0 = *(const v4f*)(p.conv_w + tap * NUP + col), w1 = *(const v4f*)(p.conv_w + tap * NUP + col + 4);
                    y[part][0] += w0[0] * bflo(uw.x); y[part][1] += w0[1] * bfhi(uw.x); y[part][2] += w0[2] * bflo(uw.y); y[part][3] += w0[3] * bfhi(uw.y);
                    y[part][4] += w1[0] * bflo(uw.z); y[part][5] += w1[1] * bfhi(uw.z); y[part][6] += w1[2] * bflo(uw.w); y[part][7] += w1[3] * bfhi(uw.w); } }
        }
        float r[8];
#pragma unroll
        for (int k = 0; k < 8; ++k) r[k] = y[0][k] * y[1][k] / (1.0f + __expf(-y[1][k]));
        v4u ow; ow.x = pk2(r[0], r[1]); ow.y = pk2(r[2], r[3]); ow.z = pk2(r[4], r[5]); ow.w = pk2(r[6], r[7]);
        *(v4u*)(G + (size_t)tl * DFF + j0) = ow;
    }
}
__device__ __forceinline__ void phase_ln2(const Params& p, const int tid) {
    const int lane = tid & 63, wave = tid >> 6;
    v4f lg[4], lb[4];
#pragma unroll
    for (int j = 0; j < 4; ++j) { lg[j] = *(const v4f*)(p.ln2_g + 4 * lane + 256 * j); lb[j] = *(const v4f*)(p.ln2_b + 4 * lane + 256 * j); }
    for (size_t row = (size_t)blockIdx.x * 8 + wave; row < (size_t)MTOK; row += (size_t)gridDim.x * 8) {
        v4f* yr = (v4f*)(p.out + row * DM) + lane;
        v4f v[4]; float s = 0.f;
#pragma unroll
        for (int j = 0; j < 4; ++j) { v[j] = yr[64 * j]; s += (v[j][0] + v[j][1]) + (v[j][2] + v[j][3]); }
        const float mean = wave_sum(s) * (1.0f / DM); float s2 = 0.f;
#pragma unroll
        for (int j = 0; j < 4; ++j) { v[j] = v[j] - mean; s2 += (v[j][0] * v[j][0] + v[j][1] * v[j][1]) + (v[j][2] * v[j][2] + v[j][3] * v[j][3]); }
        const float rstd = 1.0f / sqrtf(wave_sum(s2) * (1.0f / DM) + LN_EPS);
#pragma unroll
        for (int j = 0; j < 4; ++j) yr[64 * j] = v[j] * rstd * lg[j] + lb[j];
    }
}

#ifndef REP_FOX
#define REP_FOX 1
#endif
#ifndef REP_DIL
#define REP_DIL 1
#endif
#ifndef REPMASK
#define REPMASK 0
#endif
constexpr size_t WS_CTL = 0, CTL_ZERO_BYTES = 65536;
constexpr int LDSCTL_OFF = RING_BYTES;

constexpr int N_PHASES = 14;
__global__ void __launch_bounds__(512, 2) fwd_megakernel(Params p) {
    extern __shared__ __attribute__((aligned(16))) unsigned char lds_raw[];
    LAS unsigned char* lds = (LAS unsigned char*)lds_raw;
    cg::grid_group grid = cg::this_grid();
    const int wid_k = __builtin_amdgcn_readfirstlane(threadIdx.x >> 6);
#define MK_TID() (wid_k * 64 + lane_id())
    const int lo = p.ph_lo, hi = p.ph_hi;
    XcdBarrier bar;
    { const int t0 = MK_TID();
      for (int u = t0; u < (LDS_BYTES - LDSCTL_OFF) / 4; u += 512) ((LAS unsigned*)(lds + LDSCTL_OFF))[u] = 0u;
      __syncthreads();
      bar = xcd_barrier_post((unsigned*)(p.ws + WS_CTL), (volatile LAS unsigned*)(lds + LDSCTL_OFF) + 8, t0); }
#define IN(k) (lo <= (k) && (k) < hi)
#define SEAM(k) do { if (IN(k) && IN((k) + 1)) { if ((k) == 0) grid.sync(); else xcd_barrier(bar, MK_TID()); } } while (0)
    bf16raw* H = (bf16raw*)(p.ws + WS_H); bf16raw* Z = (bf16raw*)(p.ws + WS_Z); bf16raw* MG = (bf16raw*)(p.ws + WS_MG);
    const float* ADA = (const float*)(p.ws + WS_ADA);
    if (IN(0)) for (int rp = 0; rp <= ((REPMASK >> (0)) & 1); ++rp) { phase_prologue(p, lds, MK_TID()); } SEAM(0);
    if (IN(1)) for (int rp = 0; rp <= ((REPMASK >> (1)) & 1); ++rp) { phase_pre1(p, lds, MK_TID()); } SEAM(1);
    if (IN(2)) for (int rp = 0; rp <= ((REPMASK >> (2)) & 1); ++rp) {
        phase_fabs(p, MK_TID());
        pg8::Gemm g{H, (const bf16raw*)(p.ws + WS_WIN), MTOK, NZ, DM}; pg8::StaticOrder S; S.init(MTOK, NZ, gridDim.x, (int)blockIdx.x);
        pg8::EpiIn E{Z, (const float*)(p.ws + WS_CS)};
        pg8::gemm_phase<pg8::EpiIn, pg8::StaticOrder, true, true>(lds, g, S, E, MK_TID());
    } SEAM(2);
    if (IN(3)) for (int rp = 0; rp <= ((REPMASK >> (3)) & 1); ++rp) {
        { const int G = gridDim.x, bx = blockIdx.x, vcu = (G % 8 == 0) ? (bx % 8) * (G / 8) + bx / 8 : bx, per = (1024 + G - 1) / G;
          const int ftid = MK_TID();
          for (int rep = 0; rep < REP_FOX; ++rep)
          for (int u = vcu * per; u < (vcu + 1) * per && u < 1024; ++u) { const int bh = u >> 3, j = u & 7;
              fox::fox_unit<8>(bh >> 3, bh & 7, 15 - j, Z, (const float*)(p.ws + WS_FABS), p.ws + WS_KXT, MG, p.gn_a, lds, ftid);
              fox::fox_unit<8>(bh >> 3, bh & 7, j, Z, (const float*)(p.ws + WS_FABS), p.ws + WS_KXT, MG, p.gn_a, lds, ftid); } }
        const int atid = MK_TID();
        for (int rep = 0; rep < REP_DIL; ++rep)
        for (int u = att::N_FOX_UNITS + blockIdx.x; u < att::N_UNITS; u += gridDim.x) {
            const att::AUnit U = att::decode_unit(u);
            att::attn_unit_simple(U, Z, (const float*)(p.ws + WS_FABS), MG, p.gn_a, (bf16raw*)(p.ws + WS_OP), (float*)(p.ws + WS_LSE), lds, atid);
            __syncthreads();
        }
    } SEAM(3);
    if (IN(4)) for (int rp = 0; rp <= ((REPMASK >> (4)) & 1); ++rp) { phase_merge(p, MK_TID()); } SEAM(4);
    if (IN(5)) for (int rp = 0; rp <= ((REPMASK >> (5)) & 1); ++rp) {
        pg8::Gemm g{MG, (const bf16raw*)(p.ws + WS_WOUT), MTOK, DM, DM}; pg8::StaticOrder S; S.init(MTOK, DM, gridDim.x, (int)blockIdx.x);
        pg8::EpiOut E{p.x, p.out, ADA};
        pg8::gemm_phase<pg8::EpiOut, pg8::StaticOrder, true, true>(lds, g, S, E, MK_TID());
    } SEAM(5);
    if (IN(6)) for (int rp = 0; rp <= ((REPMASK >> (6)) & 1); ++rp) { phase_ln1(p, MK_TID()); } SEAM(6);
#pragma unroll 1
    for (int half = 0; half < 2; ++half) {
        if (IN(7 + 2 * half)) for (int rp = 0; rp <= ((REPMASK >> (7 + 2 * half)) & 1); ++rp) {
            pg8::Gemm g{H + (size_t)half * (MTOK / 2) * DM, (const bf16raw*)(p.ws + WS_WUP), MTOK / 2, NUP, DM}; pg8::StaticOrder S; S.init(MTOK / 2, NUP, gridDim.x, (int)blockIdx.x);
            pg8::EpiRaw E{(bf16raw*)(p.ws + WS_U), NUP};
            pg8::gemm_phase<pg8::EpiRaw, pg8::StaticOrder, true, true>(lds, g, S, E, MK_TID());
        } SEAM(7 + 2 * half);
        if (IN(8 + 2 * half)) for (int rp = 0; rp <= ((REPMASK >> (8 + 2 * half)) & 1); ++rp) { phase_conv(p, half, MK_TID()); } SEAM(8 + 2 * half);
    }
    if (IN(11)) for (int rp = 0; rp <= ((REPMASK >> (11)) & 1); ++rp) {
        pg8::Gemm g{(const bf16raw*)(p.ws + WS_G), (const bf16raw*)(p.ws + WS_WDN), MTOK, DM, DFF}; pg8::StaticOrder S; S.init(MTOK, DM, gridDim.x, (int)blockIdx.x);
        pg8::EpiDown E{p.out, (const float*)(p.ws + WS_ST1), ADA, p.ln1_g, p.ln1_b};
        pg8::gemm_phase<pg8::EpiDown, pg8::StaticOrder, true, true>(lds, g, S, E, MK_TID());
    } SEAM(11);
    if (IN(12)) for (int rp = 0; rp <= ((REPMASK >> (12)) & 1); ++rp) { phase_ln2(p, MK_TID()); }
#undef IN
#undef SEAM
}

extern "C" void kernel_launch(void* const* d_in, const int* in_sizes, int n_in, void* d_out, int out_size, void* d_ws, size_t ws_size, hipStream_t stream) {
    static int grid = 0;
    if (grid == 0) {
        if (n_in != 18 || out_size != MTOK * DM || ws_size < WS_END) { fprintf(stderr, "kernel_launch: unexpected problem (n_in %d out %d ws %zu)\n", n_in, out_size, ws_size); grid = -1; return; }
        int dev = 0, cus = 0, per_cu = 0;
        hipGetDevice(&dev); hipDeviceGetAttribute(&cus, hipDeviceAttributeMultiprocessorCount, dev);
        if (hipFuncSetAttribute((const void*)fwd_megakernel, hipFuncAttributeMaxDynamicSharedMemorySize, LDS_BYTES) != hipSuccess) { fprintf(stderr, "kernel_launch: hipFuncSetAttribute failed\n"); grid = -1; return; }
        if (hipOccupancyMaxActiveBlocksPerMultiprocessor(&per_cu, (const void*)fwd_megakernel, 512, LDS_BYTES) != hipSuccess || per_cu < 1) { fprintf(stderr, "kernel_launch: occupancy query says %d\n", per_cu); per_cu = 1; }
        (void)hipGetLastError();
        if (per_cu > 1) per_cu = 1;
        grid = cus * per_cu;
    }
    if (grid < 0) return;
    Params p{};
    p.x = (const float*)d_in[0]; p.c = (const float*)d_in[1]; p.pos = (const int*)d_in[2]; p.w_ada = (const float*)d_in[3]; p.b_ada = (const float*)d_in[4];
    p.w_in = (const float*)d_in[5]; p.b_fgate = (const float*)d_in[6]; p.gn_a = (const float*)d_in[7]; p.gn_b = (const float*)d_in[8]; p.w_out = (const float*)d_in[9];
    p.ln1_g = (const float*)d_in[10]; p.ln1_b = (const float*)d_in[11]; p.w_up = (const float*)d_in[12]; p.conv_w = (const float*)d_in[13]; p.conv_b = (const float*)d_in[14];
    p.w_down = (const float*)d_in[15]; p.ln2_g = (const float*)d_in[16]; p.ln2_b = (const float*)d_in[17];
    p.out = (float*)d_out; p.ws = (unsigned char*)d_ws;
#if MK_SPLIT
    for (int ph = 0; ph < N_PHASES - 1; ++ph) { p.ph_lo = ph; p.ph_hi = ph + 1; hipLaunchKernelGGL(fwd_megakernel, dim3(grid), dim3(512), LDS_BYTES, stream, p); }
#else
    p.ph_lo = 0; p.ph_hi = N_PHASES;
    if (hipMemsetAsync((char*)d_ws + WS_CTL, 0, CTL_ZERO_BYTES, stream) != hipSuccess) { fprintf(stderr, "kernel_launch: memset failed\n"); return; }
    void* args[] = {&p};
    hipError_t e = hipLaunchCooperativeKernel((const void*)fwd_megakernel, dim3(grid), dim3(512), args, LDS_BYTES, stream);
    if (e != hipSuccess) fprintf(stderr, "cooperative launch failed: %s (grid %d)\n", hipGetErrorString(e), grid);
#endif
}
```

```cpp
#include <hip/hip_runtime.h>
#include <hip/hip_cooperative_groups.h>
#include <cstdio>
#include <cstdint>
namespace cg = cooperative_groups;

#ifndef MK_SPLIT
#define MK_SPLIT 0
#endif

constexpr int NB = 16, SEQ = 4096, DM = 1024, MTOK = NB * SEQ;
constexpr int DIN = 3080, NZ = 3072;
constexpr int DFF = 2816, NUP = 5632;
constexpr int NH = 8, HD = 64;
constexpr float ALPHA = 1.189207115002721f;
constexpr float LOG2E = 1.4426950408889634f;
constexpr float QSCALE = 0.125f * LOG2E;
constexpr float LN_EPS = 1e-5f, RMS_EPS = 1e-6f;
constexpr int ZQA = 0, ZKA = 512, ZVA = 1024, ZQB = 1536, ZKB = 2048, ZVB = 2560;

#define LAS __attribute__((address_space(3)))
typedef unsigned short bf16raw;
typedef unsigned v4u __attribute__((ext_vector_type(4)));
typedef unsigned v2u __attribute__((ext_vector_type(2)));
typedef float v4f __attribute__((ext_vector_type(4)));
typedef float v2f __attribute__((ext_vector_type(2)));

__device__ __forceinline__ unsigned f2bf(float f) { unsigned u = __builtin_bit_cast(unsigned, f); return (u + 0x7fffu + ((u >> 16) & 1u)) >> 16; }
__device__ __forceinline__ unsigned pk2(float lo, float hi) { return f2bf(lo) | (f2bf(hi) << 16); }
__device__ __forceinline__ float bflo(unsigned w) { return __builtin_bit_cast(float, w << 16); }
__device__ __forceinline__ float bfhi(unsigned w) { return __builtin_bit_cast(float, w & 0xffff0000u); }
__device__ __forceinline__ int lane_id() { int l; asm volatile("v_mbcnt_lo_u32_b32 %0, -1, 0\n\tv_mbcnt_hi_u32_b32 %0, -1, %0" : "=v"(l)); return l; }
__device__ __forceinline__ float sum8_dpp(float v) {
    v += __builtin_bit_cast(float, __builtin_amdgcn_mov_dpp(__builtin_bit_cast(int, v), 0xB1, 0xF, 0xF, true));
    v += __builtin_bit_cast(float, __builtin_amdgcn_mov_dpp(__builtin_bit_cast(int, v), 0x4E, 0xF, 0xF, true));
    v += __builtin_bit_cast(float, __builtin_amdgcn_mov_dpp(__builtin_bit_cast(int, v), 0x141, 0xF, 0xF, true));
    return v;
}
__device__ __forceinline__ float wave_sum(float v) {
#pragma unroll
    for (int o = 1; o < 64; o <<= 1) v += __shfl_xor(v, o);
    return v;
}

namespace pg8 {
#define PG8_LAS __attribute__((address_space(3)))
typedef unsigned short bf16_t;
typedef short bf16x8 __attribute__((ext_vector_type(8)));
typedef float f32x4 __attribute__((ext_vector_type(4)));
typedef unsigned u32x4 __attribute__((ext_vector_type(4)));
constexpr int BM = 256, BK = 64, HALF = 128, HTB = HALF * BK * 2  , STAGE_BYTES = 8 * HTB, NXCD = 8, WGM = 8;

__host__ __device__ __forceinline__ int lds_byte(int r, int c) { const int st = (r >> 4) * 2 + (c >> 5), rr = r & 15, cc = c & 31, ob = rr * 64 + cc * 2; return st * 1024 + (ob ^ (((ob >> 9) & 1) << 5)); }
__host__ __device__ __forceinline__ void stage_rc(int b, int& R, int& C) { const int st = b / 1024, sb = b % 1024, swz = sb ^ (((sb >> 9) & 1) << 5); R = (st >> 1) * 16 + swz / 64; C = (st & 1) * 32 + (swz % 64) / 2; }
__host__ __device__ __forceinline__ int perm32(int rho) { const int n = rho >> 4, i = rho & 15; return 8 * (i >> 2) + 4 * n + (i & 3); }

struct Unit { int pm, pn; };
struct Gemm { const bf16_t* A; const bf16_t* Bt; int M, N, K; };

struct StaticOrder {
    int nM, nN, nwg, G, c;
    __host__ __device__ void init(int M, int N, int G_, int c_) { nM = M / BM; nN = N / BM; nwg = nM * nN; G = G_; c = c_; }
    __host__ __device__ bool next(int i, Unit& u) const {
        const long L = (long)i * G + c; if (L >= nwg) return false;
        int wgid = (int)L; { const int q = nwg / NXCD, r = nwg % NXCD, xcd = wgid % NXCD, off = wgid / NXCD; wgid = (xcd < r ? xcd * (q + 1) : r * (q + 1) + (xcd - r) * q) + off; }
        const int nig = WGM * nN, gid = wgid / nig, fm = gid * WGM, gsz = (nM - fm) < WGM ? (nM - fm) : WGM;
        u.pm = fm + ((wgid % nig) % gsz); u.pn = (wgid % nig) / gsz; return true;
    }
    __device__ __forceinline__ void a_ready(const Unit&) const {}
    __device__ __forceinline__ void done(const Unit&) const {}
};

__device__ __forceinline__ unsigned cvt_pk_bf16(float lo, float hi) { unsigned r; asm volatile("v_cvt_pk_bf16_f32 %0, %1, %2" : "=v"(r) : "v"(lo), "v"(hi)); return r; }
typedef float f32x2 __attribute__((ext_vector_type(2)));

struct EpiIn {
    static constexpr bool PERM = true, AFTER_DRAIN = false;
    bf16_t* Z; const float* CS;
    __device__ __forceinline__ void operator()(const f32x4 (&acc)[2][2][4][2], const Unit& u, int wr, int wc, int fr, int fq) const {
        const int row0 = u.pm * BM + wr * 64 + fr, col0 = u.pn * BM + wc * 32 + 8 * fq;
        const bool isq = (u.pn < 2) || (u.pn == 6) || (u.pn == 7);
        const float sc = isq ? QSCALE : 1.0f;
        const bool rot = (u.pn >= 6) && (u.pn < 10) && ((wc & 1) == 0) && (fq < 2);
#pragma unroll
        for (int ai = 0; ai < 2; ++ai)
#pragma unroll
            for (int m = 0; m < 4; ++m) {
                const int row = row0 + ai * HALF + m * 16;
                f32x4 cs = (f32x4){1.f, 1.f, 1.f, 1.f}, sn = (f32x4){0.f, 0.f, 0.f, 0.f};
                if (rot) { cs = *(const f32x4*)(CS + (size_t)row * 16 + 4 * fq); sn = *(const f32x4*)(CS + (size_t)row * 16 + 8 + 4 * fq); }
                bf16_t* rowp = Z + (size_t)row * NZ + col0;
#pragma unroll
                for (int bj = 0; bj < 2; ++bj) {
                    f32x4 v0 = acc[ai][bj][m][0], v1 = acc[ai][bj][m][1];
                    const f32x4 t1 = v0 * cs - v1 * sn, t2 = v1 * cs + v0 * sn;
                    v0 = t1 * sc; v1 = t2 * sc;
                    u32x4 w; w.x = cvt_pk_bf16(v0[0], v0[1]); w.y = cvt_pk_bf16(v0[2], v0[3]); w.z = cvt_pk_bf16(v1[0], v1[1]); w.w = cvt_pk_bf16(v1[2], v1[3]);
                    *(u32x4*)(rowp + bj * HALF) = w;
                }
            }
    }
};
struct EpiOut {
    static constexpr bool PERM = false, AFTER_DRAIN = false;
    const float* x; float* y; const float* ada;
    __device__ __forceinline__ void operator()(const f32x4 (&acc)[2][2][4][2], const Unit& u, int wr, int wc, int fr, int fq) const {
        const int row0 = u.pm * BM + wr * 64 + fr, col0 = u.pn * BM + wc * 32 + 4 * fq;
        const float* ga = ada + (size_t)(u.pm >> 4) * (6 * DM) + 2 * DM + col0;
#pragma unroll
        for (int bj = 0; bj < 2; ++bj)
#pragma unroll
            for (int n = 0; n < 2; ++n) {
                const f32x4 g = *(const f32x4*)(ga + bj * HALF + n * 16);
#pragma unroll
                for (int ai = 0; ai < 2; ++ai)
#pragma unroll
                    for (int m = 0; m < 4; ++m) {
                        const size_t off = (size_t)(row0 + ai * HALF + m * 16) * DM + col0 + bj * HALF + n * 16;
                        const f32x4 xv = *(const f32x4*)(x + off);
                        *(f32x4*)(y + off) = xv * ALPHA + g * acc[ai][bj][m][n];
                    }
                asm volatile("" ::: "memory");
            }
    }
};
struct EpiRaw {
    static constexpr bool PERM = true, AFTER_DRAIN = false;
    bf16_t* O; int ldc;
    __device__ __forceinline__ void operator()(const f32x4 (&acc)[2][2][4][2], const Unit& u, int wr, int wc, int fr, int fq) const {
        const int row0 = u.pm * BM + wr * 64 + fr, col0 = u.pn * BM + wc * 32 + 8 * fq;
#pragma unroll
        for (int ai = 0; ai < 2; ++ai)
#pragma unroll
            for (int m = 0; m < 4; ++m) { bf16_t* rowp = O + (size_t)(row0 + ai * HALF + m * 16) * ldc + col0;
#pragma unroll
                for (int bj = 0; bj < 2; ++bj) { const f32x4 v0 = acc[ai][bj][m][0], v1 = acc[ai][bj][m][1];
                    u32x4 w; w.x = cvt_pk_bf16(v0[0], v0[1]); w.y = cvt_pk_bf16(v0[2], v0[3]); w.z = cvt_pk_bf16(v1[0], v1[1]); w.w = cvt_pk_bf16(v1[2], v1[3]);
                    *(u32x4*)(rowp + bj * HALF) = w; } }
    }
};
struct EpiDown {
    static constexpr bool PERM = false, AFTER_DRAIN = false;
    float* y; const float* st; const float* ada; const float* lng; const float* lnb;
    __device__ __forceinline__ void operator()(const f32x4 (&acc)[2][2][4][2], const Unit& u, int wr, int wc, int fr, int fq) const {
        const int row0 = u.pm * BM + wr * 64 + fr, col0 = u.pn * BM + wc * 32 + 4 * fq;
        const float* gf = ada + (size_t)(u.pm >> 4) * (6 * DM) + 5 * DM + col0;
        f32x2 sr[2][4];
#pragma unroll
        for (int ai = 0; ai < 2; ++ai)
#pragma unroll
            for (int m = 0; m < 4; ++m) sr[ai][m] = *(const f32x2*)(st + (size_t)(row0 + ai * HALF + m * 16) * 2);
#pragma unroll
        for (int bj = 0; bj < 2; ++bj)
#pragma unroll
            for (int n = 0; n < 2; ++n) {
                const int co = bj * HALF + n * 16;
                const f32x4 g = *(const f32x4*)(gf + co), lg = *(const f32x4*)(lng + col0 + co), lb = *(const f32x4*)(lnb + col0 + co);
#pragma unroll
                for (int ai = 0; ai < 2; ++ai)
#pragma unroll
                    for (int m = 0; m < 4; ++m) {
                        const size_t off = (size_t)(row0 + ai * HALF + m * 16) * DM + col0 + co;
                        const f32x4 yv = *(const f32x4*)(y + off);
                        const f32x4 x1 = (yv - sr[ai][m].x) * sr[ai][m].y * lg + lb;
                        *(f32x4*)(y + off) = x1 * ALPHA + g * acc[ai][bj][m][n];
                    }
                asm volatile("" ::: "memory");
            }
    }
};


__device__ __forceinline__ f32x4 dpp_shr1(const f32x4 v) { f32x4 r;
#pragma unroll
    for (int e = 0; e < 4; ++e) { float t; asm("s_nop 1\n\tv_mov_b32_dpp %0, %1 row_shr:1 row_mask:0xf bank_mask:0xf bound_ctrl:1" : "=v"(t) : "v"(v[e])); r[e] = t; }
    return r; }
struct EpiUpConv {
    static constexpr bool PERM = true, AFTER_DRAIN = false;
    bf16_t* G; float* ULAST; float* YFIRST; const float* cw; const float* cb;
    __device__ __forceinline__ void operator()(f32x4 (&acc)[2][2][4][2], const Unit& u, int wr, int wc, int fr, int fq) const {
        const int strip = 2 * u.pm + wr, ca = 128 * u.pn + 32 * wc + 8 * fq;
#define ACCJ(j, bj, n) acc[(j) >> 2][bj][(j) & 3][n]
#pragma unroll
        for (int bj = 0; bj < 2; ++bj)
#pragma unroll
            for (int n = 0; n < 2; ++n) {
                const int col = bj * DFF + ca + 4 * n;
                const f32x4 w0 = *(const f32x4*)(cw + col), w1 = *(const f32x4*)(cw + NUP + col), w2 = *(const f32x4*)(cw + 2 * NUP + col), b = *(const f32x4*)(cb + col);
                const f32x4 u6 = ACCJ(6, bj, n), u7 = ACCJ(7, bj, n);
                if (fr == 15) { *(f32x4*)(ULAST + ((size_t)strip * 2 + 0) * NUP + col) = u6; *(f32x4*)(ULAST + ((size_t)strip * 2 + 1) * NUP + col) = u7; }
                const f32x4 p6 = dpp_shr1(u6), p7 = dpp_shr1(u7);
#pragma unroll
                for (int j = 7; j >= 2; --j) ACCJ(j, bj, n) = b + w0 * ACCJ(j - 2, bj, n) + w1 * ACCJ(j - 1, bj, n) + w2 * ACCJ(j, bj, n);
                const f32x4 y1 = b + w0 * p7 + w1 * ACCJ(0, bj, n) + w2 * ACCJ(1, bj, n), y0 = b + w0 * p6 + w1 * p7 + w2 * ACCJ(0, bj, n);
                ACCJ(1, bj, n) = y1; ACCJ(0, bj, n) = y0;
                if (fr == 0) { *(f32x4*)(YFIRST + ((size_t)strip * 2 + 0) * NUP + col) = y0; *(f32x4*)(YFIRST + ((size_t)strip * 2 + 1) * NUP + col) = y1; }
            }
        bf16_t* gp = G + ((size_t)strip * 128 + 8 * fr) * DFF + ca;
#pragma unroll
        for (int j = 0; j < 8; ++j) {
            f32x4 r0, r1;
#pragma unroll
            for (int e = 0; e < 4; ++e) { const float g0 = ACCJ(j, 1, 0)[e], g1 = ACCJ(j, 1, 1)[e];
                r0[e] = ACCJ(j, 0, 0)[e] * g0 * __builtin_amdgcn_rcpf(1.0f + __expf(-g0)); r1[e] = ACCJ(j, 0, 1)[e] * g1 * __builtin_amdgcn_rcpf(1.0f + __expf(-g1)); }
            u32x4 w; w.x = cvt_pk_bf16(r0[0], r0[1]); w.y = cvt_pk_bf16(r0[2], r0[3]); w.z = cvt_pk_bf16(r1[0], r1[1]); w.w = cvt_pk_bf16(r1[2], r1[3]);
            *(u32x4*)(gp + (size_t)j * DFF) = w;
        }
#undef ACCJ
    }
};
template <class Epi, class Sched, bool ALIGN_EPI = false, bool SP2 = false, int AMAP = 0>
__device__ __forceinline__ void gemm_phase(PG8_LAS unsigned char* lds, const Gemm g, const Sched& S, const Epi& E, const int tid) {
    const int wid = __builtin_amdgcn_readfirstlane(tid >> 6), lane = tid & 63, wr = wid >> 2, wc = wid & 3, fr = lane & 15, fq = lane >> 4;
    const int K = g.K, nt = K / BK;
    unsigned voffA[2], voffB[2];
#pragma unroll
    for (int i = 0; i < 2; ++i) { int R, C; stage_rc(tid * 16 + i * 8192, R, C); const int Rb = Epi::PERM ? ((R & ~31) + perm32(R & 31)) : R;
        const int Ra = AMAP ? ((R >> 6) * 128 + (R & 15) * 8 + ((R >> 4) & 3)) : R;
        voffA[i] = (unsigned)(Ra * K + C) * 2u; voffB[i] = (unsigned)(Rb * K + C) * 2u; }
    const size_t kstep = (size_t)(BK * 2);
    const size_t hstep = (size_t)HALF * K * 2;
    const size_t hstepA = AMAP ? (size_t)4 * K * 2 : hstep;
    const size_t tstep = 2 * hstep;
    const unsigned ldsw = (unsigned)wid * 1024u;
    const int aoff = lds_byte(wr * 64 + fr, fq * 8), boff = lds_byte(wc * 32 + fr, fq * 8);
#define PG8_SA(b, h) (((b) * 2 + (h)) * HTB)
#define PG8_SB(b, h) ((4 + (b) * 2 + (h)) * HTB)
#define PG8_STAGE(bufoff, gbase, voff) do { _Pragma("unroll") for (int _i = 0; _i < 2; ++_i) \
        __builtin_amdgcn_global_load_lds((const unsigned*)((const char*)(gbase) + (voff)[_i]), (PG8_LAS unsigned*)(lds + (bufoff) + ldsw + _i * 8192), 16, 0, 0); } while (0)
#define PG8_LDA(dst, b, h) do { _Pragma("unroll") for (int m = 0; m < 4; ++m) _Pragma("unroll") for (int k = 0; k < 2; ++k) dst[m][k] = *(const PG8_LAS bf16x8*)(lds + PG8_SA(b, h) + aoff + m * 2048 + k * 1024); } while (0)
#define PG8_LDB(dst, b, h) do { _Pragma("unroll") for (int n = 0; n < 2; ++n) _Pragma("unroll") for (int k = 0; k < 2; ++k) dst[n][k] = *(const PG8_LAS bf16x8*)(lds + PG8_SB(b, h) + boff + n * 2048 + k * 1024); } while (0)
#define PG8_MMA(ai, bj, At, Bt) do { __builtin_amdgcn_s_setprio(1); _Pragma("unroll") for (int m = 0; m < 4; ++m) _Pragma("unroll") for (int n = 0; n < 2; ++n) _Pragma("unroll") for (int k = 0; k < 2; ++k) \
        acc[ai][bj][m][n] = __builtin_amdgcn_mfma_f32_16x16x32_bf16(Bt[n][k], At[m][k], acc[ai][bj][m][n], 0, 0, 0); __builtin_amdgcn_s_setprio(0); } while (0)
#define PG8_WAIT_V(n) asm volatile("s_waitcnt vmcnt(" #n ")" ::: "memory")
#define PG8_WAIT_L(n) asm volatile("s_waitcnt lgkmcnt(" #n ")" ::: "memory")
#define PG8_BAR __builtin_amdgcn_s_barrier()
#define PG8_SCHED __builtin_amdgcn_sched_barrier(0)
    Unit cur, nxt; int ui = 0;
    if (!S.next(0, cur)) return;
    f32x4 acc[2][2][4][2];
#pragma unroll
    for (int a = 0; a < 2; ++a)
#pragma unroll
        for (int b = 0; b < 2; ++b)
#pragma unroll
            for (int m = 0; m < 4; ++m)
#pragma unroll
                for (int n = 0; n < 2; ++n) acc[a][b][m][n] = (f32x4){0.f, 0.f, 0.f, 0.f};
    bf16x8 At[4][2], B0[2][2], B1[2][2];
    const char* cA = (const char*)g.A + (size_t)cur.pm * tstep; const char* cB = (const char*)g.Bt + (size_t)cur.pn * tstep;
    S.a_ready(cur);
    if constexpr (SP2) {
        PG8_STAGE(PG8_SB(0, 0), cB, voffB); PG8_STAGE(PG8_SB(0, 1), cB + hstep, voffB); PG8_STAGE(PG8_SA(0, 0), cA, voffA); PG8_STAGE(PG8_SA(0, 1), cA + hstepA, voffA);
        if (wr == 1) PG8_BAR;
        PG8_WAIT_V(2); PG8_BAR;
        PG8_STAGE(PG8_SB(1, 0), cB + kstep, voffB); PG8_STAGE(PG8_SA(1, 0), cA + kstep, voffA); PG8_STAGE(PG8_SB(1, 1), cB + hstep + kstep, voffB);
        PG8_WAIT_V(6); PG8_BAR;
    } else {
        PG8_STAGE(PG8_SB(0, 0), cB, voffB); PG8_STAGE(PG8_SA(0, 0), cA, voffA); PG8_STAGE(PG8_SB(0, 1), cB + hstep, voffB); PG8_STAGE(PG8_SA(0, 1), cA + hstepA, voffA);
        if (wr == 1) PG8_BAR;
        PG8_WAIT_V(4); PG8_BAR;
        PG8_STAGE(PG8_SB(1, 0), cB + kstep, voffB); PG8_STAGE(PG8_SA(1, 0), cA + kstep, voffA); PG8_STAGE(PG8_SB(1, 1), cB + hstep + kstep, voffB);
        PG8_WAIT_V(6); PG8_BAR;
    }
    for (;;) {
        const bool has_next = S.next(ui + 1, nxt);
        const char* nA = has_next ? (const char*)g.A + (size_t)nxt.pm * tstep : cA; const char* nB = has_next ? (const char*)g.Bt + (size_t)nxt.pn * tstep : cB;
        for (int t = 0; t < nt; t += 2) {
            const bool last = (t == nt - 2);
            const char* a1 = cA + (size_t)(t + 1) * kstep;
            const char* a2 = last ? nA : cA + (size_t)(t + 2) * kstep; const char* b2 = last ? nB : cB + (size_t)(t + 2) * kstep;
            const char* a3 = a2 + kstep; const char* b3 = b2 + kstep;
            if (last && has_next) S.a_ready(nxt);
            if constexpr (SP2) {
            PG8_LDB(B0, 0, 0); PG8_LDB(B1, 0, 1); PG8_SCHED; PG8_LDA(At, 0, 0); PG8_STAGE(PG8_SA(1, 1), a1 + hstepA, voffA);
            PG8_WAIT_V(8); PG8_WAIT_L(0); PG8_BAR; PG8_MMA(0, 0, At, B0); PG8_MMA(0, 1, At, B1); PG8_BAR; PG8_SCHED;
            PG8_LDA(At, 0, 1); PG8_STAGE(PG8_SB(0, 0), b2, voffB); PG8_STAGE(PG8_SB(0, 1), b2 + hstep, voffB); PG8_STAGE(PG8_SA(0, 0), a2, voffA);
            PG8_WAIT_V(8); PG8_WAIT_L(0); PG8_BAR; PG8_MMA(1, 0, At, B0); PG8_MMA(1, 1, At, B1); PG8_BAR; PG8_SCHED;
            PG8_LDB(B0, 1, 0); PG8_LDB(B1, 1, 1); PG8_SCHED; PG8_LDA(At, 1, 0); PG8_STAGE(PG8_SA(0, 1), a2 + hstepA, voffA);
            PG8_WAIT_V(8); PG8_WAIT_L(0); PG8_BAR; PG8_MMA(0, 0, At, B0); PG8_MMA(0, 1, At, B1); PG8_BAR; PG8_SCHED;
            PG8_LDA(At, 1, 1); PG8_STAGE(PG8_SB(1, 0), b3, voffB); PG8_STAGE(PG8_SB(1, 1), b3 + hstep, voffB); PG8_STAGE(PG8_SA(1, 0), a3, voffA);
            PG8_WAIT_V(8); PG8_WAIT_L(0); PG8_BAR; PG8_MMA(1, 0, At, B0); PG8_MMA(1, 1, At, B1); PG8_BAR; PG8_SCHED;
            } else {
            PG8_LDB(B0, 0, 0); PG8_SCHED; PG8_LDA(At, 0, 0); PG8_STAGE(PG8_SA(1, 1), a1 + hstepA, voffA);
            PG8_WAIT_L(8); PG8_BAR; PG8_WAIT_L(0); PG8_MMA(0, 0, At, B0); PG8_BAR; PG8_SCHED;
            PG8_LDB(B1, 0, 1); PG8_STAGE(PG8_SB(0, 0), b2, voffB);
            PG8_BAR; PG8_WAIT_L(0); PG8_MMA(0, 1, At, B1); PG8_BAR;
            PG8_LDA(At, 0, 1); PG8_STAGE(PG8_SA(0, 0), a2, voffA);
            PG8_BAR; PG8_WAIT_L(0); PG8_MMA(1, 0, At, B0); PG8_BAR; PG8_SCHED;
            PG8_STAGE(PG8_SB(0, 1), b2 + hstep, voffB);
            PG8_WAIT_V(6); PG8_BAR; PG8_MMA(1, 1, At, B1); PG8_BAR;
            PG8_LDB(B0, 1, 0); PG8_SCHED; PG8_LDA(At, 1, 0); PG8_STAGE(PG8_SA(0, 1), a2 + hstepA, voffA);
            PG8_WAIT_L(8); PG8_BAR; PG8_WAIT_L(0); PG8_MMA(0, 0, At, B0); PG8_BAR; PG8_SCHED;
            PG8_LDB(B1, 1, 1); PG8_STAGE(PG8_SB(1, 0), b3, voffB);
            PG8_BAR; PG8_WAIT_L(0); PG8_MMA(0, 1, At, B1); PG8_BAR;
            PG8_LDA(At, 1, 1); PG8_STAGE(PG8_SA(1, 0), a3, voffA);
            PG8_BAR; PG8_WAIT_L(0); PG8_MMA(1, 0, At, B0); PG8_BAR; PG8_SCHED;
            PG8_STAGE(PG8_SB(1, 1), b3 + hstep, voffB);
            PG8_WAIT_V(6); PG8_BAR; PG8_MMA(1, 1, At, B1); PG8_BAR;
            }
        }
        if constexpr (ALIGN_EPI) { if (wr == 0) PG8_BAR; }
        if constexpr (!Epi::AFTER_DRAIN) { E(acc, cur, wr, wc, fr, fq); S.done(cur); }
        if (!has_next) break;
#pragma unroll
        for (int a = 0; a < 2; ++a)
#pragma unroll
            for (int b = 0; b < 2; ++b)
#pragma unroll
                for (int m = 0; m < 4; ++m)
#pragma unroll
                    for (int n = 0; n < 2; ++n) acc[a][b][m][n] = (f32x4){0.f, 0.f, 0.f, 0.f};
        cur = nxt; cA = nA; cB = nB; ++ui;
        if constexpr (ALIGN_EPI) { if (wr == 1) PG8_BAR; }
    }
    PG8_WAIT_V(0);
    if constexpr (!ALIGN_EPI) { if (wr == 0) PG8_BAR; }
    PG8_BAR;
    if constexpr (Epi::AFTER_DRAIN) { E.fused(acc, cur, wr, wc, fr, fq, lds, wid, lane); S.done(cur); }
#undef PG8_SA
#undef PG8_SB
#undef PG8_STAGE
#undef PG8_LDA
#undef PG8_LDB
#undef PG8_MMA
#undef PG8_WAIT_V
#undef PG8_WAIT_L
#undef PG8_BAR
#undef PG8_SCHED
}
}

namespace att {
typedef short bf16x8 __attribute__((ext_vector_type(8)));
typedef short s16x4 __attribute__((ext_vector_type(4)));
typedef float f32x16 __attribute__((ext_vector_type(16)));
constexpr int LDS_K = 0, LDS_V = 8192, LDS_FB = 16384, LDS_WS = 16384 + 256, LDS_OST = 20480, OST_STRIDE = 68, OST_BYTES = 32 * OST_STRIDE * 4;
constexpr int LDS_TOTAL = LDS_OST + 8 * OST_BYTES;
constexpr float NEG = -1.0e30f;
__device__ __forceinline__ int crow(int r, int hi) { return (r & 3) + 8 * (r >> 2) + 4 * hi; }
__device__ __forceinline__ void glds16(const void* gsrc, unsigned lds_dst) { unsigned keep;
    asm volatile("s_mov_b32 %0, m0\n\ts_mov_b32 m0, %2\n\ts_nop 0\n\tglobal_load_lds_dwordx4 %1, off\n\ts_mov_b32 m0, %0" : "=&s"(keep) : "v"(gsrc), "s"(lds_dst) : "memory"); }
typedef float f32x2_t __attribute__((ext_vector_type(2))); typedef __bf16 bf16x2_t __attribute__((ext_vector_type(2)));
__device__ __forceinline__ unsigned cvtpk_s(float lo, float hi) { f32x2_t v = {lo, hi}; bf16x2_t b = __builtin_convertvector(v, bf16x2_t); return __builtin_bit_cast(unsigned, b); }
__device__ __forceinline__ void pv(f32x16* o, int vb, bf16x8 pa0, bf16x8 pa1, bf16x8 pa2, bf16x8 pa3) {
#pragma unroll
    for (int d0 = 0; d0 < 2; ++d0) { s16x4 lo[4], hi[4];
#pragma unroll
        for (int ks = 0; ks < 4; ++ks) {
            asm volatile("ds_read_b64_tr_b16 %0,%1 offset:%c2" : "=&v"(lo[ks]) : "v"(vb), "i"(d0 * 4096 + ks * 1024) : "memory");
            asm volatile("ds_read_b64_tr_b16 %0,%1 offset:%c2" : "=&v"(hi[ks]) : "v"(vb), "i"(d0 * 4096 + ks * 1024 + 512) : "memory"); }
        asm volatile("s_waitcnt lgkmcnt(0)" ::: "memory"); __builtin_amdgcn_sched_barrier(0);
#define ATT_PK(k) (bf16x8){lo[k][0], lo[k][1], lo[k][2], lo[k][3], hi[k][0], hi[k][1], hi[k][2], hi[k][3]}
        o[d0] = __builtin_amdgcn_mfma_f32_32x32x16_bf16(pa0, ATT_PK(0), o[d0], 0, 0, 0);
        o[d0] = __builtin_amdgcn_mfma_f32_32x32x16_bf16(pa1, ATT_PK(1), o[d0], 0, 0, 0);
        o[d0] = __builtin_amdgcn_mfma_f32_32x32x16_bf16(pa2, ATT_PK(2), o[d0], 0, 0, 0);
        o[d0] = __builtin_amdgcn_mfma_f32_32x32x16_bf16(pa3, ATT_PK(3), o[d0], 0, 0, 0);
#undef ATT_PK
    }
}
struct AUnit { int b, h, mode, pat, d, cls, i0, kt0, nt; };
constexpr int N_FOX_UNITS = NB * NH * (SEQ / 256), N_DIL_UNITS = NB * NH * 48, N_UNITS = N_FOX_UNITS + N_DIL_UNITS;
__device__ __forceinline__ AUnit decode_unit(int idx) {
    AUnit u;
    if (idx < N_FOX_UNITS) { const int qb = 15 - (idx >> 7), bh = idx & 127; u.b = bh >> 3; u.h = bh & 7; u.mode = 0; u.pat = 0; u.d = 1; u.cls = 0; u.i0 = 256 * qb; u.kt0 = 0; u.nt = 4 * (qb + 1); }
    else { const int j = idx - N_FOX_UNITS, bh = j / 48, r = j % 48; u.b = bh >> 3; u.h = bh & 7; u.mode = 1; u.nt = 6;
        if (r < 16) { u.pat = 0; u.d = 1; u.cls = 0; u.i0 = 256 * r; }
        else if (r < 32) { u.pat = 1; u.d = 4; u.cls = (r - 16) >> 2; u.i0 = 256 * ((r - 16) & 3); }
        else { u.pat = 2; u.d = 16; u.cls = r - 32; u.i0 = 0; }
        u.kt0 = u.i0 - 128; }
    return u;
}
__device__ __forceinline__ void attn_unit_simple(const AUnit U, const bf16raw* __restrict__ Z, const float* __restrict__ FABS, bf16raw* MG, const float* __restrict__ gn_a,
                                                 bf16raw* OP, float* LSE, LAS unsigned char* shm, const int tid) {
    const int lane = tid & 63, r32 = lane & 31, hi = lane >> 5; const int wid = __builtin_amdgcn_readfirstlane(tid >> 6);
    const long rowbase = (long)U.b * SEQ + U.cls;
    const int qcol = (U.mode == 0 ? ZQA : ZQB) + U.h * HD, kcol = qcol + 512, vcol = qcol + 1024;
    const int qi = U.i0 + wid * 32 + r32;
    const long qrow = rowbase + (long)qi * U.d;
    const unsigned lds0 = (unsigned)(uintptr_t)shm;
    LAS float* fb = (LAS float*)(shm + LDS_FB);
    LAS float* wsf = (LAS float*)(shm + LDS_WS) + wid * 64;
    LAS float* stg = (LAS float*)(shm + LDS_OST + wid * OST_BYTES);
    bf16x8 qr[4];
#pragma unroll
    for (int d0 = 0; d0 < 4; ++d0) qr[d0] = *(const bf16x8*)(Z + qrow * NZ + qcol + d0 * 16 + hi * 8);
    const float* Fh = FABS + (size_t)(U.b * NH + U.h) * SEQ;
    const float aq = (U.mode == 0) ? Fh[qi] * LOG2E : 0.f;
    float m = NEG, l = 0.f; f32x16 o[2];
#pragma unroll
    for (int r = 0; r < 16; ++r) { o[0][r] = 0.f; o[1][r] = 0.f; }
    const int vb0 = (int)(lds0 + LDS_V) + ((lane >> 4) & 1) * 32 + (lane & 3) * 8 + (4 * hi + ((lane & 15) >> 2)) * 64;
    const LAS unsigned char* kp = shm + LDS_K + hi * 1024 + r32 * 16;
    for (int t = 0; t < U.nt; ++t) {
        const int kb0 = U.kt0 + 64 * t;
        __syncthreads();
        { int ks = kb0 + lane; ks = ks < 0 ? 0 : ks;
          glds16(Z + (rowbase + (long)ks * U.d) * NZ + kcol + wid * 8, (unsigned)__builtin_amdgcn_readfirstlane(lds0 + LDS_K + wid * 1024));
          int vs = kb0 + 16 * (wid & 3) + (lane >> 2); vs = vs < 0 ? 0 : vs;
          glds16(Z + (rowbase + (long)vs * U.d) * NZ + vcol + (wid >> 2) * 32 + (lane & 3) * 8, (unsigned)__builtin_amdgcn_readfirstlane(lds0 + LDS_V + wid * 1024));
          if (U.mode == 0 && wid == 0) fb[lane] = -Fh[kb0 + lane] * LOG2E; }
        asm volatile("s_waitcnt vmcnt(0) lgkmcnt(0)" ::: "memory");
        __syncthreads();
        f32x16 p0, p1;
#pragma unroll
        for (int r = 0; r < 16; ++r) { p0[r] = 0.f; p1[r] = 0.f; }
#pragma unroll
        for (int d0 = 0; d0 < 4; ++d0) {
            const bf16x8 b0 = *(const LAS bf16x8*)(kp + d0 * 2048), b1 = *(const LAS bf16x8*)(kp + d0 * 2048 + 512);
            p0 = __builtin_amdgcn_mfma_f32_32x32x16_bf16(b0, qr[d0], p0, 0, 0, 0);
            p1 = __builtin_amdgcn_mfma_f32_32x32x16_bf16(b1, qr[d0], p1, 0, 0, 0);
        }
        if (U.mode == 0) {
#pragma unroll
            for (int g = 0; g < 4; ++g) { const v4f f0 = *(const LAS v4f*)(fb + 8 * g + 4 * hi), f1 = *(const LAS v4f*)(fb + 32 + 8 * g + 4 * hi);
#pragma unroll
                for (int e = 0; e < 4; ++e) { p0[4 * g + e] += aq + f0[e]; p1[4 * g + e] += aq + f1[e]; } }
        }
#pragma unroll
        for (int r = 0; r < 16; ++r) { const int kv = kb0 + crow(r, hi), kv1 = kv + 32;
            const bool ok0 = (U.mode == 0) ? (kv <= qi) : (kv <= qi && kv >= qi - 128 && kv >= 0);
            const bool ok1 = (U.mode == 0) ? (kv1 <= qi) : (kv1 <= qi && kv1 >= qi - 128 && kv1 >= 0);
            p0[r] = ok0 ? p0[r] : NEG; p1[r] = ok1 ? p1[r] : NEG; }
        float rm = NEG;
#pragma unroll
        for (int r = 0; r < 16; ++r) rm = fmaxf(rm, fmaxf(p0[r], p1[r]));
        rm = fmaxf(rm, __shfl_xor(rm, 32));
        const float mn = fmaxf(m, rm), alpha = __builtin_amdgcn_exp2f(m - mn); m = mn;
        if (hi == 0) wsf[r32] = alpha;
        float sacc = 0.f;
#pragma unroll
        for (int r = 0; r < 16; ++r) { p0[r] = __builtin_amdgcn_exp2f(p0[r] - m); p1[r] = __builtin_amdgcn_exp2f(p1[r] - m); sacc += p0[r] + p1[r]; }
        l = l * alpha + sacc;
        asm volatile("s_waitcnt lgkmcnt(0)" ::: "memory");
#pragma unroll
        for (int g = 0; g < 4; ++g) { const v4f a4 = *(const LAS v4f*)(wsf + 8 * g + 4 * hi);
#pragma unroll
            for (int e = 0; e < 4; ++e) { o[0][4 * g + e] *= a4[e]; o[1][4 * g + e] *= a4[e]; } }
        v4u pw0, pw1, pw2, pw3;
        pw0 = (v4u){cvtpk_s(p0[0], p0[1]), cvtpk_s(p0[2], p0[3]), cvtpk_s(p0[4], p0[5]), cvtpk_s(p0[6], p0[7])};
        pw1 = (v4u){cvtpk_s(p0[8], p0[9]), cvtpk_s(p0[10], p0[11]), cvtpk_s(p0[12], p0[13]), cvtpk_s(p0[14], p0[15])};
        pw2 = (v4u){cvtpk_s(p1[0], p1[1]), cvtpk_s(p1[2], p1[3]), cvtpk_s(p1[4], p1[5]), cvtpk_s(p1[6], p1[7])};
        pw3 = (v4u){cvtpk_s(p1[8], p1[9]), cvtpk_s(p1[10], p1[11]), cvtpk_s(p1[12], p1[13]), cvtpk_s(p1[14], p1[15])};
        pv(o, vb0, __builtin_bit_cast(bf16x8, pw0), __builtin_bit_cast(bf16x8, pw1), __builtin_bit_cast(bf16x8, pw2), __builtin_bit_cast(bf16x8, pw3));
    }
    l += __shfl_xor(l, 32);
    if (hi == 0) { wsf[r32] = 1.0f / l; wsf[32 + r32] = m + __builtin_amdgcn_logf(l); }
    asm volatile("s_waitcnt lgkmcnt(0)" ::: "memory");
#pragma unroll
    for (int g = 0; g < 4; ++g) { const v4f a4 = *(const LAS v4f*)(wsf + 8 * g + 4 * hi);
#pragma unroll
        for (int e = 0; e < 4; ++e) { const int r = 4 * g + e, q = crow(r, hi);
            stg[q * OST_STRIDE + r32] = o[0][r] * a4[e]; stg[q * OST_STRIDE + 32 + r32] = o[1][r] * a4[e]; } }
    asm volatile("s_waitcnt lgkmcnt(0)" ::: "memory");
#pragma unroll
    for (int i = 0; i < 4; ++i) {
        const int row = i * 8 + (lane >> 3), c8 = (lane & 7) * 8;
        const v4f a = *(const LAS v4f*)(stg + row * OST_STRIDE + c8), c = *(const LAS v4f*)(stg + row * OST_STRIDE + c8 + 4);
        const long grow = rowbase + (long)(U.i0 + wid * 32 + row) * U.d;
        if (U.mode == 0) {
            float ss = (a[0] * a[0] + a[1] * a[1]) + (a[2] * a[2] + a[3] * a[3]) + (c[0] * c[0] + c[1] * c[1]) + (c[2] * c[2] + c[3] * c[3]);
            ss = sum8_dpp(ss);
            const float rs = 1.0f / sqrtf(ss * (1.0f / 64.0f) + RMS_EPS);
            const v4f g0 = *(const v4f*)(gn_a + U.h * HD + c8), g1 = *(const v4f*)(gn_a + U.h * HD + c8 + 4);
            v4u w; w.x = pk2(a[0] * rs * g0[0], a[1] * rs * g0[1]); w.y = pk2(a[2] * rs * g0[2], a[3] * rs * g0[3]);
            w.z = pk2(c[0] * rs * g1[0], c[1] * rs * g1[1]); w.w = pk2(c[2] * rs * g1[2], c[3] * rs * g1[3]);
            *(v4u*)(MG + grow * DM + U.h * HD + c8) = w;
        } else {
            v4u w; w.x = pk2(a[0], a[1]); w.y = pk2(a[2], a[3]); w.z = pk2(c[0], c[1]); w.w = pk2(c[2], c[3]);
            *(v4u*)(OP + ((size_t)U.pat * MTOK + grow) * 512 + U.h * HD + c8) = w;
            if ((lane & 7) == 0) LSE[((size_t)U.pat * MTOK + grow) * NH + U.h] = wsf[32 + row];
        }
    }
}
}

namespace fox {
typedef short bf16x8 __attribute__((ext_vector_type(8)));
typedef short s16x4 __attribute__((ext_vector_type(4)));
typedef float f32x16 __attribute__((ext_vector_type(16)));
typedef unsigned u32x4 __attribute__((ext_vector_type(4)));
constexpr int NW = 8, QBLK = 32, QB = QBLK * NW, KVBLK = 64;
__device__ __forceinline__ int crow(int r, int hi) { return (r & 3) + 8 * (r >> 2) + 4 * hi; }
#define SBAR() __builtin_amdgcn_sched_barrier(0)
__device__ __forceinline__ void cmask(f32x16& p0, f32x16& p1, int jb, int qrel, int hi) {
    const float NEGI = -INFINITY; int kb = 64 * jb + 4 * hi;
#pragma unroll
    for (int r = 0; r < 16; ++r) { int kv = kb + (r & 3) + 8 * (r >> 2); if (kv > qrel) p0[r] = NEGI; if (kv + 32 > qrel) p1[r] = NEGI; }
}
constexpr int NSLOT = 3, SLOTB = 9216, XOFF = 8192;
constexpr int LDS_K = 0, LDS_V = NSLOT * SLOTB, LDS_WS = 2 * NSLOT * SLOTB, LDS_OST = LDS_WS + NW * 64 * 4, OST_STRIDE = 68, OST_BYTES = 32 * OST_STRIDE * 4, LDS_BYTES = LDS_OST + NW * OST_BYTES;
__device__ __forceinline__ void glds16(const void* sbase, unsigned voff, unsigned lds_dst) { unsigned keep;
    asm volatile("s_mov_b32 %0, m0\n\ts_mov_b32 m0, %3\n\ts_nop 0\n\tglobal_load_lds_dwordx4 %1, %2\n\ts_mov_b32 m0, %0" : "=&s"(keep) : "v"(voff), "s"(sbase), "s"(lds_dst) : "memory"); }
__device__ __forceinline__ void glds4(const void* sbase, unsigned voff, unsigned lds_dst) { unsigned keep;
    asm volatile("s_mov_b32 %0, m0\n\ts_mov_b32 m0, %3\n\ts_nop 0\n\tglobal_load_lds_dword %1, %2\n\ts_mov_b32 m0, %0" : "=&s"(keep) : "v"(voff), "s"(sbase), "s"(lds_dst) : "memory"); }
__device__ __forceinline__ float max3f(float a, float b, float c) { float r; asm("v_max3_f32 %0, %1, %2, %3" : "=v"(r) : "v"(a), "v"(b), "v"(c)); return r; }
__device__ __forceinline__ float max2f(float a, float b) { float r; asm("v_max_f32_e32 %0, %1, %2" : "=v"(r) : "v"(a), "v"(b)); return r; }
__device__ __forceinline__ float fadd_s(float a, float b) { float r; asm("v_add_f32_e32 %0, %1, %2" : "=v"(r) : "v"(a), "v"(b)); return r; }
__device__ __forceinline__ float fsub_s(float a, float b) { float r; asm("v_sub_f32_e32 %0, %1, %2" : "=v"(r) : "v"(a), "v"(b)); return r; }
typedef float f32x2_t __attribute__((ext_vector_type(2))); typedef __bf16 bf16x2_t __attribute__((ext_vector_type(2)));
__device__ __forceinline__ unsigned cvtpk_s(float lo, float hi) { f32x2_t v = {lo, hi}; bf16x2_t b = __builtin_convertvector(v, bf16x2_t); return __builtin_bit_cast(unsigned, b); }
#define WAIT_BAR(N) asm volatile("s_waitcnt vmcnt(" #N ") lgkmcnt(0)\n\ts_barrier" ::: "memory")
__device__ __forceinline__ s16x4 make_qx(float a, int hi) {
    const unsigned w1 = cvtpk_s(a, 0.f); const float h = __builtin_bit_cast(float, w1 << 16);
    const float r1 = a - h; const unsigned w2 = cvtpk_s(r1, 0.f); const float m = __builtin_bit_cast(float, w2 << 16);
    const float r2 = r1 - m; const unsigned w3 = cvtpk_s(r2, 1.0f);
    unsigned x = (w1 & 0xffffu) | (w2 << 16), y = w3;
    if (hi) { x = 0x3f803f80u; y = 0u; }
    typedef unsigned u32x2 __attribute__((ext_vector_type(2)));
    return __builtin_bit_cast(s16x4, (u32x2){x, y});
}
typedef __attribute__((address_space(3))) const char* lds_cptr;
typedef short v4i16_t __attribute__((ext_vector_type(4)));
__device__ __forceinline__ void kload8(bf16x8* kf, lds_cptr kp) {
    kf[0] = *(const __attribute__((address_space(3))) bf16x8*)(kp);        kf[1] = *(const __attribute__((address_space(3))) bf16x8*)(kp + 512);
    kf[2] = *(const __attribute__((address_space(3))) bf16x8*)(kp + 2048); kf[3] = *(const __attribute__((address_space(3))) bf16x8*)(kp + 2560);
    kf[4] = *(const __attribute__((address_space(3))) bf16x8*)(kp + 4096); kf[5] = *(const __attribute__((address_space(3))) bf16x8*)(kp + 4608);
    kf[6] = *(const __attribute__((address_space(3))) bf16x8*)(kp + 6144); kf[7] = *(const __attribute__((address_space(3))) bf16x8*)(kp + 6656);
}
__device__ __forceinline__ void kload2(bf16x8* kf, lds_cptr kp, int j) { kf[2 * j] = *(const __attribute__((address_space(3))) bf16x8*)(kp + j * 2048); kf[2 * j + 1] = *(const __attribute__((address_space(3))) bf16x8*)(kp + j * 2048 + 512); }
__device__ __forceinline__ void xload2(s16x4* kx, lds_cptr xp) { kx[0] = *(const __attribute__((address_space(3))) s16x4*)(xp); kx[1] = *(const __attribute__((address_space(3))) s16x4*)(xp + 256); }
__device__ __forceinline__ s16x4 vtr(lds_cptr p) { return __builtin_bit_cast(s16x4, __builtin_amdgcn_ds_read_tr16_b64_v4i16((__attribute__((address_space(3))) v4i16_t*)p)); }
__device__ __forceinline__ float rowmax(const f32x16& p0, const f32x16& p1) {
    float a = max3f(p0[0], p0[1], p1[0]), b = max3f(p0[2], p0[3], p1[1]); a = max3f(a, p1[2], p1[3]);
#pragma unroll
    for (int r = 4; r < 16; r += 4) { a = max3f(a, p0[r], p0[r + 1]); b = max3f(b, p0[r + 2], p0[r + 3]); a = max3f(a, p1[r], p1[r + 1]); b = max3f(b, p1[r + 2], p1[r + 3]); }
    const float m = max2f(a, b);
    auto rr = __builtin_amdgcn_permlane32_swap(__float_as_uint(m), __float_as_uint(m), false, false);
    return max2f(__uint_as_float(rr[0]), __uint_as_float(rr[1]));
}
__device__ __forceinline__ void pv(f32x16* o, int vb, bf16x8 pa0, bf16x8 pa1, bf16x8 pa2, bf16x8 pa3) {
#pragma unroll
    for (int d0 = 0; d0 < 2; ++d0) { s16x4 lo[4], hi[4];
#pragma unroll
        for (int ks = 0; ks < 4; ++ks) {
            asm volatile("ds_read_b64_tr_b16 %0,%1 offset:%c2" : "=&v"(lo[ks]) : "v"(vb), "i"(d0 * 4096 + ks * 1024) : "memory");
            asm volatile("ds_read_b64_tr_b16 %0,%1 offset:%c2" : "=&v"(hi[ks]) : "v"(vb), "i"(d0 * 4096 + ks * 1024 + 512) : "memory"); }
        asm volatile("s_waitcnt lgkmcnt(0)" ::: "memory"); SBAR();
#define PK(k) (bf16x8){lo[k][0], lo[k][1], lo[k][2], lo[k][3], hi[k][0], hi[k][1], hi[k][2], hi[k][3]}
        o[d0] = __builtin_amdgcn_mfma_f32_32x32x16_bf16(pa0, PK(0), o[d0], 0, 0, 0);
        o[d0] = __builtin_amdgcn_mfma_f32_32x32x16_bf16(pa1, PK(1), o[d0], 0, 0, 0);
        o[d0] = __builtin_amdgcn_mfma_f32_32x32x16_bf16(pa2, PK(2), o[d0], 0, 0, 0);
        o[d0] = __builtin_amdgcn_mfma_f32_32x32x16_bf16(pa3, PK(3), o[d0], 0, 0, 0);
#undef PK
    }
}
#define MF16(a, b, c) __builtin_amdgcn_mfma_f32_32x32x16_bf16(a, b, c, 0, 0, 0)
#define MF8(a, b, c) __builtin_amdgcn_mfma_f32_32x32x8bf16_1k(a, b, c, 0, 0, 0)

template <int THRL> __device__ __forceinline__ void fox_unit(int b, int h, int qb, const bf16raw* __restrict__ Z, const float* __restrict__ FABS, const unsigned char* __restrict__ KXT,
                                                             bf16raw* MG, const float* __restrict__ gn_a, LAS unsigned char* shm, const int tid) {
    const int lane = tid & 63, r32 = lane & 31, hi = lane >> 5; const int wid = __builtin_amdgcn_readfirstlane(tid >> 6);
    const long rowbase = (long)b * SEQ; const int q0 = qb * QB;
    const bf16raw* Qw = Z + (rowbase + q0 + wid * QBLK) * NZ + ZQA + h * HD;
    const bf16raw* Kh = Z + rowbase * NZ + ZKA + h * HD, *Vh = Z + rowbase * NZ + ZVA + h * HD;
    const unsigned char* Xh = KXT + (size_t)(b * NH + h) * (SEQ / 64) * 1024;
    const unsigned lds0 = (unsigned)(uintptr_t)shm;
    LAS float* wsf = (LAS float*)(shm + LDS_WS) + wid * 64;
    const unsigned kvo = (unsigned)(lane * NZ + wid * 8) * 2u, vvo = (unsigned)((16 * (wid & 3) + (lane >> 2)) * NZ + (wid >> 2) * 32 + (lane & 3) * 8) * 2u, xvo = (unsigned)((wid & 3) * 256 + lane * 4);
    const unsigned kdst = lds0 + LDS_K + wid * 1024, vdst = lds0 + LDS_V + wid * 1024, xdst = lds0 + LDS_K + XOFF + (wid & 3) * 256;
#define DMA_K(t, slot) do { glds16(Kh + (long)(t) * KVBLK * NZ, kvo, (unsigned)__builtin_amdgcn_readfirstlane(kdst + (slot))); glds4(Xh + (size_t)(t) * 1024, xvo, (unsigned)__builtin_amdgcn_readfirstlane(xdst + (slot))); } while (0)
#define DMA_V(t, slot) glds16(Vh + (long)(t) * KVBLK * NZ, vvo, (unsigned)__builtin_amdgcn_readfirstlane(vdst + (slot)))
    const int vb0 = (int)(lds0 + LDS_V) + ((lane >> 4) & 1) * 32 + (lane & 3) * 8 + (4 * hi + ((lane & 15) >> 2)) * 64;
    bf16x8 kf[8]; s16x4 kx[2];
    const lds_cptr shm3 = (lds_cptr)shm; const lds_cptr kp0 = shm3 + LDS_K + hi * 1024 + r32 * 16; const lds_cptr xp0 = shm3 + LDS_K + XOFF + hi * 512 + r32 * 8;
    const lds_cptr vp0 = shm3 + LDS_V + ((lane >> 4) & 1) * 32 + (lane & 3) * 8 + (4 * hi + ((lane & 15) >> 2)) * 64;
    const int NT = (q0 + QB) / KVBLK;
    DMA_K(0, 0); DMA_V(0, 0); DMA_K(1, SLOTB);
    bf16x8 qr[4];
#pragma unroll
    for (int d0 = 0; d0 < 4; ++d0) qr[d0] = *reinterpret_cast<const bf16x8*>(&Qw[(long)r32 * NZ + d0 * 16 + hi * 8]);
    const float fq2 = FABS[(size_t)(b * NH + h) * SEQ + q0 + wid * QBLK + r32] * LOG2E;
    float mhat = 0.f, l_reg = 0.f; f32x16 o[2]; o[0] = f32x16{}; o[1] = f32x16{};
    s16x4 qx = make_qx(fq2, hi);
    const f32x16 zero16 = f32x16{};
    const int qrel = wid * QBLK + r32;
#define CMASK(P0, P1, t) do { int jb_ = (t) - (NT - 4); if (jb_ >= 0) cmask(P0, P1, jb_, qrel, hi); } while (0)
    bool resc = false;
#define START(P0, P1) do { const float rm = rowmax(P0, P1); resc = false; \
    { const float dl = rm; mhat = fadd_s(mhat, dl); \
      _Pragma("unroll") for (int r = 0; r < 16; ++r) { P0[r] = fsub_s(P0[r], dl); P1[r] = fsub_s(P1[r], dl); } \
      qx = make_qx(fq2 - mhat, hi); asm volatile("" : "+v"(qx)); } \
    _Pragma("unroll") for (int r = 0; r < 16; ++r) P0[r] = __builtin_amdgcn_exp2f(P0[r]); } while (0)
#define RESC() do { if (resc) { asm volatile("s_waitcnt lgkmcnt(0)" ::: "memory"); \
      _Pragma("unroll") for (int d_ = 0; d_ < 2; ++d_) _Pragma("unroll") for (int r = 0; r < 16; ++r) o[d_][r] *= wsf[crow(r, hi)]; } } while (0)
    f32x16 pA0, pA1, pB0, pB1;
    int sl_prev = 0, sl_cur = 0, sl_next = SLOTB;
#define ROT() do { sl_prev = sl_cur; sl_cur = sl_next; sl_next = (sl_next == (NSLOT - 1) * SLOTB) ? 0 : sl_next + SLOTB; } while (0)
    DMA_K(2, 2 * SLOTB);
    WAIT_BAR(5);
    kload8(kf, kp0); xload2(kx, xp0);
    pA0 = MF8(kx[0], qx, zero16); pA1 = MF8(kx[1], qx, zero16);
#pragma unroll
    for (int d0 = 0; d0 < 4; ++d0) { pA0 = MF16(kf[2 * d0], qr[d0], pA0); pA1 = MF16(kf[2 * d0 + 1], qr[d0], pA1); }
    asm volatile("s_nop 15\n\ts_nop 7" : "+v"(pA0), "+v"(pA1)); CMASK(pA0, pA1, 0);
    START(pA0, pA1);
    _Pragma("unroll") for (int r = 0; r < 16; ++r) pA1[r] = __builtin_amdgcn_exp2f(pA1[r]);
    WAIT_BAR(0);
    DMA_K(3, 0); DMA_V(1, SLOTB);
    ROT();
    kload8(kf, kp0 + sl_cur); xload2(kx, xp0 + sl_cur);
    WAIT_BAR(3);
    s16x4 vlo[8], vhi[8]; u32x4 pw0, pw1, pw2, pw3;
#define PKW(P, B) cvtpk_s(P[B], P[B + 1])
#define PAF(k) __builtin_bit_cast(bf16x8, pw##k)
#define VFR(i) (bf16x8){vlo[i][0], vlo[i][1], vlo[i][2], vlo[i][3], vhi[i][0], vhi[i][1], vhi[i][2], vhi[i][3]}
#define PIN(x) asm volatile("" : "+v"(x))
#define MX3(a, b, c) __builtin_fmaxf(__builtin_fmaxf((a), (b)), (c))
#define GAPA(MF, A0, A1, A2, A3, W0, W1, PW) do { MF; sacc += A0; sacc += A1; sacc += A2; sacc += A3; PIN(sacc); W0; W1; PIN(PW); SBAR(); } while (0)
#define EX(v) __builtin_amdgcn_exp2f(v)
#define GAPB(MF, X, B) do { MF; X[B] = EX(X[B]); X[B + 1] = EX(X[B + 1]); X[B + 2] = EX(X[B + 2]); X[B + 3] = EX(X[B + 3]); PIN(X); SBAR(); } while (0)
#define VRD(i) do { vlo[i] = vtr(vp_ + (((i) >> 2) * 4096 + ((i) & 3) * 1024)); vhi[i] = vtr(vp_ + (((i) >> 2) * 4096 + ((i) & 3) * 1024 + 512)); } while (0)
#define KRD(G, j) do { if (G) { kload2(kf, kp0 + sl_next, j); SBAR(); } } while (0)
#define XRD(G) do { if (G) { xload2(kx, xp0 + sl_next); SBAR(); } } while (0)
#define STEP(C0, C1, P0, P1, t, GK, GV, GL) do { SBAR(); \
    const lds_cptr vp_ = vp0 + sl_prev; \
    C0 = MF8(kx[0], qx, zero16); C1 = MF8(kx[1], qx, zero16); SBAR(); \
    VRD(0); SBAR(); float sacc = (P0[0] + P0[1]); \
    GAPA(C0 = MF16(kf[0], qr[0], C0), P0[2], P0[3], P0[4], P0[5],     pw0[0] = PKW(P0, 0), pw0[1] = PKW(P0, 2), pw0); \
    VRD(4); SBAR(); GAPA(C1 = MF16(kf[1], qr[0], C1), P0[6], P0[7], P0[8], P0[9],     pw0[2] = PKW(P0, 4), pw0[3] = PKW(P0, 6), pw0); \
    VRD(1); SBAR(); GAPA(C0 = MF16(kf[2], qr[1], C0),   P0[10], P0[11], P0[12], P0[13], pw1[0] = PKW(P0, 8), pw1[1] = PKW(P0, 10), pw1); \
    VRD(5); SBAR(); GAPA(C1 = MF16(kf[3], qr[1], C1),   P0[14], P0[15], P1[0], P1[1],   pw1[2] = PKW(P0, 12), pw1[3] = PKW(P0, 14), pw1); \
    VRD(2); SBAR(); GAPA(C0 = MF16(kf[4], qr[2], C0),   P1[2], P1[3], P1[4], P1[5],     pw2[0] = PKW(P1, 0), pw2[1] = PKW(P1, 2), pw2); \
    VRD(6); SBAR(); GAPA(C1 = MF16(kf[5], qr[2], C1),   P1[6], P1[7], P1[8], P1[9],     pw2[2] = PKW(P1, 4), pw2[3] = PKW(P1, 6), pw2); \
    VRD(3); SBAR(); GAPA(C0 = MF16(kf[6], qr[3], C0),   P1[10], P1[11], P1[12], P1[13], pw3[0] = PKW(P1, 8), pw3[1] = PKW(P1, 10), pw3); \
    VRD(7); SBAR(); GAPA(C1 = MF16(kf[7], qr[3], C1),   P1[14], P1[15], 0.f, 0.f,       pw3[2] = PKW(P1, 12), pw3[3] = PKW(P1, 14), pw3); \
    l_reg += sacc; \
    if (GK) { DMA_K((t) + 3, sl_cur); } if (GV) { DMA_V((t) + 1, sl_next); } \
    CMASK(C0, C1, t); \
    { float a = MX3(C0[0], C0[1], C1[0]), b_ = MX3(C0[2], C0[3], C1[1]); a = MX3(a, C1[2], C1[3]); \
      _Pragma("unroll") for (int r = 4; r < 16; r += 4) { a = MX3(a, C0[r], C0[r + 1]); b_ = MX3(b_, C0[r + 2], C0[r + 3]); a = MX3(a, C1[r], C1[r + 1]); b_ = MX3(b_, C1[r + 2], C1[r + 3]); } \
      float rm = __builtin_fmaxf(a, b_); { auto rr = __builtin_amdgcn_permlane32_swap(__float_as_uint(rm), __float_as_uint(rm), false, false); rm = __builtin_fmaxf(__uint_as_float(rr[0]), __uint_as_float(rr[1])); } \
      resc = false; \
      if (__builtin_expect(__any(rm > (float)THRL), 0)) { const float dl = __builtin_fmaxf(rm, 0.f); mhat += dl; \
        _Pragma("unroll") for (int r = 0; r < 16; ++r) { C0[r] -= dl; C1[r] -= dl; } \
        qx = make_qx(fq2 - mhat, hi); asm volatile("" : "+v"(qx)); \
        const float f = __builtin_amdgcn_exp2f(-dl); l_reg *= f; if (hi == 0) wsf[r32] = f; resc = true; } } \
    SBAR(); \
    GAPB(o[0] = MF16(PAF(0), VFR(0), o[0]), C0, 0); \
    GAPB(o[1] = MF16(PAF(0), VFR(4), o[1]), C0, 4); \
    KRD(GL, 0); GAPB(o[0] = MF16(PAF(1), VFR(1), o[0]), C0, 8); \
    KRD(GL, 1); GAPB(o[1] = MF16(PAF(1), VFR(5), o[1]), C0, 12); \
    KRD(GL, 2); GAPB(o[0] = MF16(PAF(2), VFR(2), o[0]), C1, 0); \
    KRD(GL, 3); GAPB(o[1] = MF16(PAF(2), VFR(6), o[1]), C1, 4); \
    XRD(GL); GAPB(o[0] = MF16(PAF(3), VFR(3), o[0]), C1, 8); \
    GAPB(o[1] = MF16(PAF(3), VFR(7), o[1]), C1, 12); \
    } while (0)
    int t = 1;
#undef CMASK
#define CMASK(P0, P1, t) do { } while (0)
    for (; t + 5 < NT; t += 2) {
        STEP(pB0, pB1, pA0, pA1, t, true, true, true);     WAIT_BAR(3); RESC(); ROT();
        STEP(pA0, pA1, pB0, pB1, t + 1, true, true, true); WAIT_BAR(3); RESC(); ROT();
    }
#undef CMASK
#define CMASK(P0, P1, t) do { int jb_ = (t) - (NT - 4); if (jb_ >= 0) cmask(P0, P1, jb_, qrel, hi); } while (0)
#define ENDW(tt) do { if ((tt) + 3 < NT) { WAIT_BAR(3); } else if ((tt) + 2 < NT) { WAIT_BAR(1); } else { WAIT_BAR(0); } } while (0)
    for (; t + 1 < NT; t += 2) {
        STEP(pB0, pB1, pA0, pA1, t, (t + 3 < NT), (t + 1 < NT), (t + 1 < NT));         ENDW(t);     RESC(); ROT();
        STEP(pA0, pA1, pB0, pB1, t + 1, (t + 4 < NT), (t + 2 < NT), (t + 2 < NT));     ENDW(t + 1); RESC(); ROT();
    }
    STEP(pB0, pB1, pA0, pA1, NT - 1, false, false, false); RESC();
    { float sacc = pB0[0] + pB0[1]; _Pragma("unroll") for (int r = 2; r < 16; ++r) sacc += pB0[r]; _Pragma("unroll") for (int r = 0; r < 16; ++r) sacc += pB1[r]; l_reg += sacc;
      pw0 = (u32x4){PKW(pB0, 0), PKW(pB0, 2), PKW(pB0, 4), PKW(pB0, 6)}; pw1 = (u32x4){PKW(pB0, 8), PKW(pB0, 10), PKW(pB0, 12), PKW(pB0, 14)};
      pw2 = (u32x4){PKW(pB1, 0), PKW(pB1, 2), PKW(pB1, 4), PKW(pB1, 6)}; pw3 = (u32x4){PKW(pB1, 8), PKW(pB1, 10), PKW(pB1, 12), PKW(pB1, 14)};
      SBAR(); pv(o, vb0 + sl_cur, PAF(0), PAF(1), PAF(2), PAF(3)); }
#undef PKW
#undef PAF
#undef VFR
#undef PIN
#undef MX3
#undef GAPA
#undef GAPB
#undef EX
#undef VRD
#undef KRD
#undef XRD
#undef STEP
#undef ENDW
    { auto rr = __builtin_amdgcn_permlane32_swap(__float_as_uint(l_reg), __float_as_uint(l_reg), false, false); l_reg = __uint_as_float(rr[0]) + __uint_as_float(rr[1]); }
    if (hi == 0) wsf[32 + r32] = l_reg; asm volatile("s_waitcnt lgkmcnt(0)" ::: "memory");
    float rli[16];
#pragma unroll
    for (int r = 0; r < 16; ++r) rli[r] = __builtin_amdgcn_rcpf(wsf[32 + crow(r, hi)]);
    { LAS float* stg = (LAS float*)(shm + LDS_OST + wid * OST_BYTES);
#pragma unroll
      for (int r = 0; r < 16; ++r) { const int orow = crow(r, hi);
#pragma unroll
          for (int d0 = 0; d0 < 2; ++d0) stg[orow * OST_STRIDE + d0 * 32 + r32] = o[d0][r] * rli[r]; }
      asm volatile("s_waitcnt lgkmcnt(0)" ::: "memory");
      bf16raw* Ow = MG + (rowbase + q0 + wid * QBLK) * DM + h * HD;
#pragma unroll
      for (int i = 0; i < 4; ++i) { const int row = i * 8 + (lane >> 3), c8 = (lane & 7) * 8;
          const v4f a = *(const LAS v4f*)(stg + row * OST_STRIDE + c8), c = *(const LAS v4f*)(stg + row * OST_STRIDE + c8 + 4);
          float ss = (a[0] * a[0] + a[1] * a[1]) + (a[2] * a[2] + a[3] * a[3]) + (c[0] * c[0] + c[1] * c[1]) + (c[2] * c[2] + c[3] * c[3]);
          ss = sum8_dpp(ss);
          const float rs = 1.0f / sqrtf(ss * (1.0f / 64.0f) + RMS_EPS);
          const v4f g0 = *(const v4f*)(gn_a + h * HD + c8), g1 = *(const v4f*)(gn_a + h * HD + c8 + 4);
          u32x4 w; w.x = cvtpk_s(a[0] * rs * g0[0], a[1] * rs * g0[1]); w.y = cvtpk_s(a[2] * rs * g0[2], a[3] * rs * g0[3]);
          w.z = cvtpk_s(c[0] * rs * g1[0], c[1] * rs * g1[1]); w.w = cvtpk_s(c[2] * rs * g1[2], c[3] * rs * g1[3]);
          *(u32x4*)(Ow + (long)row * DM + c8) = w; } }
    asm volatile("s_waitcnt lgkmcnt(0)\n\ts_barrier" ::: "memory");
#undef DMA_K
#undef DMA_V
#undef CMASK
#undef START
#undef RESC
#undef ROT
}
#undef SBAR
#undef WAIT_BAR
#undef MF16
#undef MF8
}
#define XB_TMO      128
#define XB_XCNT(j)  (256  + 64 * (j))
#define XB_XSUB(j)  (1280 + 64 * (j))
#define XB_XGEN(j)  (2304 + 64 * (j))
#define XB_TOP      3328
#define XB_TOPGEN   3392
#define XCD_BAR_WORDS 3456
#define XB_SPIN_CAP (1u << 18)

__device__ __forceinline__ unsigned xb_ld(unsigned* p)              { return __hip_atomic_load(p, __ATOMIC_RELAXED, __HIP_MEMORY_SCOPE_AGENT); }
__device__ __forceinline__ unsigned xb_add(unsigned* p, unsigned v) { return __hip_atomic_fetch_add(p, v, __ATOMIC_RELAXED, __HIP_MEMORY_SCOPE_AGENT); }
__device__ __forceinline__ unsigned xb_xcc_id() { return (unsigned)__builtin_amdgcn_s_getreg((3 << 11) | 20) & 0xFu; }
#define XB_SPIN(cond, bar) do { unsigned _sp = 0; while (cond) { __builtin_amdgcn_s_sleep(1); \
    if ((++_sp & 255u) == 0u) { if (xb_ld(&(bar)[XB_TMO])) break; if (_sp > XB_SPIN_CAP) { atomicAdd(&(bar)[XB_TMO], 1u); break; } } } } while (0)

struct XcdBarrier {
    unsigned* bar; unsigned x;
    volatile LAS unsigned* st;
};

__device__ __forceinline__ XcdBarrier xcd_barrier_post(unsigned* bar, volatile LAS unsigned* st, const int tid) {
    XcdBarrier b; b.bar = bar; b.x = xb_xcc_id(); b.st = st;
    if (tid == 0) (void)xb_add(&bar[XB_XCNT(b.x)], 1u);
    return b;
}
__device__ __forceinline__ void xcd_barrier_complete(unsigned* bar, unsigned x, unsigned& nloc, unsigned& nx) {
    const unsigned G = gridDim.x * gridDim.y * gridDim.z;
    unsigned sum, cnt, mine, sp = 0u;
    for (;;) {
        sum = 0u; cnt = 0u; mine = 0u;
#pragma unroll
        for (unsigned j = 0; j < 16; ++j) { const unsigned c = xb_ld(&bar[XB_XCNT(j)]); sum += c; cnt += (c > 0u) ? 1u : 0u; mine = (j == x) ? c : mine; }
        if (sum == G) break;
        __builtin_amdgcn_s_sleep(1);
        if ((++sp & 255u) == 0u) { if (xb_ld(&bar[XB_TMO])) break; if (sp > XB_SPIN_CAP) { atomicAdd(&bar[XB_TMO], 1u); break; } }
    }
    nloc = mine > 0u ? mine : 1u; nx = cnt > 0u ? cnt : 1u;
}

__device__ __forceinline__ void xcd_barrier(const XcdBarrier& b, const int tid) {
    asm volatile("s_waitcnt vmcnt(0)" ::: "memory");
    __syncthreads();
    if (tid == 0) {
        unsigned* bar = b.bar;
        __builtin_amdgcn_s_waitcnt(0);
        unsigned nloc = b.st[0], nx = b.st[1];
        if (nloc == 0u) { xcd_barrier_complete(bar, b.x, nloc, nx); b.st[0] = nloc; b.st[1] = nx; }
        const unsigned old = xb_add(&bar[XB_XSUB(b.x)], 1u);
        const unsigned gen = old / nloc;
        if (old + 1u == (gen + 1u) * nloc) {
            __builtin_amdgcn_fence(__ATOMIC_RELEASE, "agent");
            asm volatile("s_waitcnt vmcnt(0)" ::: "memory");
            const unsigned og = xb_add(&bar[XB_TOP], 1u);
            const unsigned tg = og / nx;
            if (og + 1u == (tg + 1u) * nx) xb_add(&bar[XB_TOPGEN], 1u);
            else XB_SPIN(xb_ld(&bar[XB_TOPGEN]) == tg, bar);
            __builtin_amdgcn_fence(__ATOMIC_ACQUIRE, "agent");
            xb_add(&bar[XB_XGEN(b.x)], 1u);
            asm volatile("s_waitcnt vmcnt(0)" ::: "memory");
        } else {
            XB_SPIN(xb_ld(&bar[XB_XGEN(b.x)]) == gen, bar);
            __builtin_amdgcn_fence(__ATOMIC_ACQUIRE, "agent");
            asm volatile("s_waitcnt vmcnt(0)" ::: "memory");
        }
    }
    __syncthreads();
}

constexpr size_t MiB = 1u << 20;
#define RLX_AGENT __ATOMIC_RELAXED, __HIP_MEMORY_SCOPE_AGENT
constexpr size_t WS_ADA = 1 * MiB;
constexpr size_t WS_WIN = 2 * MiB, WS_WOUT = 9 * MiB, WS_WUP = 12 * MiB, WS_WDN = 24 * MiB;
constexpr size_t WS_FLOC = 30 * MiB, WS_FABS = 32 * MiB;
constexpr size_t WS_CT = 34 * MiB;
constexpr size_t WS_CS = 36 * MiB;
constexpr size_t WS_LSE = 40 * MiB;
constexpr size_t WS_ST1 = 48 * MiB;
constexpr size_t WS_KXT = 52 * MiB;
constexpr size_t WS_H = 64 * MiB;
constexpr size_t WS_Z = 192 * MiB;
constexpr size_t WS_OP = 576 * MiB;
constexpr size_t WS_MG = 768 * MiB;
constexpr size_t WS_G = 192 * MiB;
constexpr size_t WS_ULAST = 544 * MiB, WS_YFIRST = 576 * MiB;
constexpr size_t WS_END = 896 * MiB;

constexpr int LDS_BYTES = 147456;
constexpr int RING_BYTES = 131072;

struct Params {
    const float *x, *c; const int* pos; const float *w_ada, *b_ada, *w_in, *b_fgate, *gn_a, *gn_b, *w_out, *ln1_g, *ln1_b, *w_up, *conv_w, *conv_b, *w_down, *ln2_g, *ln2_b;
    float* out; unsigned char* ws; int ph_lo, ph_hi;
};

__device__ __forceinline__ int src_in(int n) {
    if (n < 1536) return n;
    const int s = n & 63; int sd = s;
    if (n < 2560 && s < 16) { const int a = s >> 2; sd = ((((a & 1) << 1) | (a >> 1)) << 2) | (s & 3); }
    return n - s + sd + 8;
}
__device__ __forceinline__ int src_up(int n) { return DFF * ((n >> 7) & 1) + 128 * (n >> 8) + (n & 127); }
template <int MAP> __device__ __forceinline__ void transpose_item(const float* W, int ldw, int K, int N, bf16raw* WT, LAS float* scr, int item, int lane) {
    const int nblk = N / 32, kb = item / nblk, nb = item % nblk, k0 = 64 * kb, n0 = 32 * nb;
    const int nsrc = (MAP == 1) ? src_in(n0 + (lane & 31)) : (MAP == 2) ? src_up(n0 + (lane & 31)) : n0 + (lane & 31);
#pragma unroll 8
    for (int i = 0; i < 32; ++i) { const int kk = 2 * i + (lane >> 5); scr[kk * 33 + (lane & 31)] = W[(size_t)(k0 + kk) * ldw + nsrc]; }
    asm volatile("s_waitcnt lgkmcnt(0)" ::: "memory");
    const int c = lane & 7;
#pragma unroll
    for (int j = 0; j < 4; ++j) { const int n = (lane >> 3) + 8 * j; const LAS float* s = scr + (8 * c) * 33 + n;
        v4u o; o.x = pk2(s[0 * 33], s[1 * 33]); o.y = pk2(s[2 * 33], s[3 * 33]); o.z = pk2(s[4 * 33], s[5 * 33]); o.w = pk2(s[6 * 33], s[7 * 33]);
        *(v4u*)(WT + (size_t)(n0 + n) * K + k0 + 8 * c) = o; }
    asm volatile("s_waitcnt lgkmcnt(0)" ::: "memory");
}

__device__ __forceinline__ void phase_prologue(const Params& p, LAS unsigned char* lds, const int tid) {
    const int lane = tid & 63, wave = __builtin_amdgcn_readfirstlane(tid >> 6);
    float* ADA = (float*)(p.ws + WS_ADA);
    for (int task = blockIdx.x; task < 96; task += gridDim.x) {
        LAS float* scT = (LAS float*)lds;
        LAS float* red = (LAS float*)(lds + 65536);
        for (int i = tid; i < NB * DM; i += 512) { const int b = i >> 10, k = i & 1023; const float v = p.c[i]; scT[k * 16 + b] = v / (1.0f + __expf(-v)); }
        __syncthreads();
        const int col = task * 64 + lane;
        float acc[16];
#pragma unroll
        for (int b = 0; b < 16; ++b) acc[b] = 0.f;
#pragma unroll 4
        for (int kk = 0; kk < 128; ++kk) { const int k = wave * 128 + kk; const float wv = p.w_ada[(size_t)k * (6 * DM) + col];
#pragma unroll
            for (int q = 0; q < 4; ++q) { const v4f s4 = *(const LAS v4f*)(scT + k * 16 + 4 * q);
                acc[4 * q + 0] += s4[0] * wv; acc[4 * q + 1] += s4[1] * wv; acc[4 * q + 2] += s4[2] * wv; acc[4 * q + 3] += s4[3] * wv; } }
#pragma unroll
        for (int b = 0; b < 16; ++b) red[(wave * 16 + b) * 64 + lane] = acc[b];
        __syncthreads();
        for (int i = tid; i < 16 * 64; i += 512) { const int b = i >> 6, cl = i & 63; float s = p.b_ada[task * 64 + cl];
#pragma unroll
            for (int w = 0; w < 8; ++w) s += red[(w * 16 + b) * 64 + cl];
            ADA[(size_t)b * (6 * DM) + task * 64 + cl] = s; }
        __syncthreads();
    }
    LAS float* scr = (LAS float*)(lds + wave * 16384);
    const int gw = blockIdx.x * 8 + wave, NGW = gridDim.x * 8;
    constexpr int I_IN = (DM / 64) * (NZ / 32), I_OUT = (DM / 64) * (DM / 32), I_UP = (DM / 64) * (NUP / 32), I_DN = (DFF / 64) * (DM / 32);
    for (int it = gw; it < I_IN + I_OUT + I_UP + I_DN; it += NGW) {
        int r = it;
        if (r < I_IN) { transpose_item<1>(p.w_in, DIN, DM, NZ, (bf16raw*)(p.ws + WS_WIN), scr, r, lane); continue; } r -= I_IN;
        if (r < I_OUT) { transpose_item<0>(p.w_out, DM, DM, DM, (bf16raw*)(p.ws + WS_WOUT), scr, r, lane); continue; } r -= I_OUT;
        if (r < I_UP) { transpose_item<2>(p.w_up, NUP, DM, NUP, (bf16raw*)(p.ws + WS_WUP), scr, r, lane); continue; } r -= I_UP;
        transpose_item<0>(p.w_down, DM, DFF, DM, (bf16raw*)(p.ws + WS_WDN), scr, r, lane);
    }
}

__device__ __forceinline__ void phase_pre1(const Params& p, LAS unsigned char* lds, const int tid) {
    const int lane = tid & 63, wave = __builtin_amdgcn_readfirstlane(tid >> 6);
    const float* ADA = (const float*)(p.ws + WS_ADA);
    bf16raw* H = (bf16raw*)(p.ws + WS_H);
    float* FLOC = (float*)(p.ws + WS_FLOC); float* CT = (float*)(p.ws + WS_CT); float* CS = (float*)(p.ws + WS_CS);
    LAS float* lfs = (LAS float*)lds;
    float wf[4][4][8];
#pragma unroll
    for (int j = 0; j < 4; ++j)
#pragma unroll
        for (int e = 0; e < 4; ++e) { const float* wp = p.w_in + (size_t)(4 * lane + 256 * j + e) * DIN + 1536;
            const v4f a = *(const v4f*)wp, b = *(const v4f*)(wp + 4);
            wf[j][e][0] = a[0]; wf[j][e][1] = a[1]; wf[j][e][2] = a[2]; wf[j][e][3] = a[3]; wf[j][e][4] = b[0]; wf[j][e][5] = b[1]; wf[j][e][6] = b[2]; wf[j][e][7] = b[3]; }
    for (int chunk = blockIdx.x; chunk < MTOK / 256; chunk += gridDim.x) {
        const int b = chunk >> 4, t0 = (chunk & 15) * 256;
        v4f sc[4], sh[4];
#pragma unroll
        for (int j = 0; j < 4; ++j) { sh[j] = *(const v4f*)(ADA + (size_t)b * (6 * DM) + 4 * lane + 256 * j); sc[j] = *(const v4f*)(ADA + (size_t)b * (6 * DM) + DM + 4 * lane + 256 * j) + 1.0f; }
        for (int i = 0; i < 32; ++i) {
            const int rl = wave * 32 + i; const size_t row = (size_t)b * SEQ + t0 + rl;
            const v4f* xr = (const v4f*)(p.x + row * DM) + lane;
            float s[8];
#pragma unroll
            for (int hh = 0; hh < 8; ++hh) s[hh] = 0.f;
            unsigned long long* o8 = (unsigned long long*)(H + row * DM) + lane;
#pragma unroll
            for (int j = 0; j < 4; ++j) { const v4f hv = xr[64 * j] * sc[j] + sh[j];
                o8[64 * j] = (unsigned long long)pk2(hv[0], hv[1]) | ((unsigned long long)pk2(hv[2], hv[3]) << 32);
#pragma unroll
                for (int e = 0; e < 4; ++e)
#pragma unroll
                    for (int hh = 0; hh < 8; ++hh) s[hh] += hv[e] * wf[j][e][hh]; }
#pragma unroll
            for (int hh = 0; hh < 8; ++hh) s[hh] = wave_sum(s[hh]);
            if (lane < 8) { float v = s[0];
#pragma unroll
                for (int hh = 1; hh < 8; ++hh) v = (lane == hh) ? s[hh] : v;
                v += p.b_fgate[lane];
                lfs[rl * 8 + lane] = fminf(v, 0.f) - log1pf(expf(-fabsf(v))); }
        }
        for (int i = tid; i < 256 * 8; i += 512) { const int rl = i >> 3, fi = i & 7; const size_t row = (size_t)b * SEQ + t0 + rl;
            const float fr = (fi == 0) ? 1.0f : (fi == 1) ? 0.1939227432012558f : (fi == 2) ? 0.03760603070259094f : (fi == 3) ? 0.007292664609849453f : (fi == 4) ? 0.0014142135623842478f
                           : (fi == 5) ? 0.00027424818836152554f : (fi == 6) ? 5.3182957344688475e-05f : 1.0313385246263351e-05f;
            double rev = (double)p.pos[row] * (double)fr * 0.15915494309189535; rev -= __builtin_floor(rev);
            const float rf = (float)rev;
            CS[row * 16 + fi] = __builtin_amdgcn_cosf(rf); CS[row * 16 + 8 + fi] = __builtin_amdgcn_sinf(rf); }
        __syncthreads();
        { const int hh = wave; float a0 = lfs[(4 * lane + 0) * 8 + hh], a1 = lfs[(4 * lane + 1) * 8 + hh], a2 = lfs[(4 * lane + 2) * 8 + hh], a3 = lfs[(4 * lane + 3) * 8 + hh];
          a1 += a0; a2 += a1; a3 += a2; float run = a3;
#pragma unroll
          for (int o = 1; o < 64; o <<= 1) { const float v = __shfl_up(run, o); if (lane >= o) run += v; }
          const float excl = run - a3;
          *(v4f*)(FLOC + (size_t)(b * NH + hh) * SEQ + t0 + 4 * lane) = (v4f){a0 + excl, a1 + excl, a2 + excl, a3 + excl};
          if (lane == 63) CT[(b * NH + hh) * 16 + (chunk & 15)] = run; }
        __syncthreads();
    }
}
__device__ __forceinline__ void phase_fabs(const Params& p, const int tid) {
    const float* FLOC = (const float*)(p.ws + WS_FLOC); const float* CT = (const float*)(p.ws + WS_CT); float* FABS = (float*)(p.ws + WS_FABS);
    for (int i = blockIdx.x * 512 + tid; i < NB * NH * SEQ; i += gridDim.x * 512) {
        const int bh = i >> 12, t = i & 4095, ch = t >> 8; float off = 0.f;
        for (int c2 = 0; c2 < ch; ++c2) off += CT[bh * 16 + c2];
        const float F = FLOC[i] + off; FABS[i] = F;
        const float bq = -F * LOG2E; const unsigned w1 = f2bf(bq); const float r1 = bq - __builtin_bit_cast(float, w1 << 16); const unsigned w2 = f2bf(r1);
        const float r2 = r1 - __builtin_bit_cast(float, w2 << 16); const unsigned w3 = f2bf(r2);
        unsigned char* img = p.ws + WS_KXT + ((size_t)bh * (SEQ / 64) + (t >> 6)) * 1024 + (t & 63) * 8;
        *(v2u*)img = (v2u){0x3f803f80u, 0x3f80u | (w1 << 16)}; *(v2u*)(img + 512) = (v2u){w2 | (w3 << 16), 0u}; }
}
__device__ __forceinline__ void phase_merge(const Params& p, const int tid) {
    const int lane = tid & 63, wave = tid >> 6;
    const bf16raw* OP = (const bf16raw*)(p.ws + WS_OP); const float* LSE = (const float*)(p.ws + WS_LSE); bf16raw* MG = (bf16raw*)(p.ws + WS_MG);
    const int hh = lane >> 3;
    const v4f g0 = *(const v4f*)(p.gn_b + lane * 8), g1 = *(const v4f*)(p.gn_b + lane * 8 + 4);
    for (size_t row = (size_t)blockIdx.x * 8 + wave; row < (size_t)MTOK; row += (size_t)gridDim.x * 8) {
        float ls[3]; v4u w[3];
#pragma unroll
        for (int q = 0; q < 3; ++q) { ls[q] = LSE[((size_t)q * MTOK + row) * NH + hh]; w[q] = *(const v4u*)(OP + ((size_t)q * MTOK + row) * 512 + lane * 8); }
        const float mx = fmaxf(ls[0], fmaxf(ls[1], ls[2]));
        float e[3]; e[0] = __builtin_amdgcn_exp2f(ls[0] - mx); e[1] = __builtin_amdgcn_exp2f(ls[1] - mx); e[2] = __builtin_amdgcn_exp2f(ls[2] - mx);
        const float inv = 1.0f / (e[0] + e[1] + e[2]);
        float o[8];
#pragma unroll
        for (int k = 0; k < 8; ++k) o[k] = 0.f;
#pragma unroll
        for (int q = 0; q < 3; ++q) { const float wq = e[q] * inv;
            o[0] += wq * bflo(w[q].x); o[1] += wq * bfhi(w[q].x); o[2] += wq * bflo(w[q].y); o[3] += wq * bfhi(w[q].y);
            o[4] += wq * bflo(w[q].z); o[5] += wq * bfhi(w[q].z); o[6] += wq * bflo(w[q].w); o[7] += wq * bfhi(w[q].w); }
        float ss = 0.f;
#pragma unroll
        for (int k = 0; k < 8; ++k) ss += o[k] * o[k];
        ss = sum8_dpp(ss);
        const float rs = 1.0f / sqrtf(ss * (1.0f / 64.0f) + RMS_EPS);
        v4u ow; ow.x = pk2(o[0] * rs * g0[0], o[1] * rs * g0[1]); ow.y = pk2(o[2] * rs * g0[2], o[3] * rs * g0[3]);
        ow.z = pk2(o[4] * rs * g1[0], o[5] * rs * g1[1]); ow.w = pk2(o[6] * rs * g1[2], o[7] * rs * g1[3]);
        *(v4u*)(MG + row * DM + 512 + lane * 8) = ow;
    }
}
__device__ __forceinline__ void phase_ln1(const Params& p, const int tid) {
    const int lane = tid & 63, wave = tid >> 6;
    const float* ADA = (const float*)(p.ws + WS_ADA); bf16raw* H = (bf16raw*)(p.ws + WS_H); float* ST = (float*)(p.ws + WS_ST1);
    v4f lg[4], lb[4];
#pragma unroll
    for (int j = 0; j < 4; ++j) { lg[j] = *(const v4f*)(p.ln1_g + 4 * lane + 256 * j); lb[j] = *(const v4f*)(p.ln1_b + 4 * lane + 256 * j); }
    for (size_t row = (size_t)blockIdx.x * 8 + wave; row < (size_t)MTOK; row += (size_t)gridDim.x * 8) {
        const int b = (int)(row >> 12);
        const v4f* yr = (const v4f*)(p.out + row * DM) + lane;
        v4f v[4]; float s = 0.f;
#pragma unroll
        for (int j = 0; j < 4; ++j) { v[j] = yr[64 * j]; s += (v[j][0] + v[j][1]) + (v[j][2] + v[j][3]); }
        const float mean = wave_sum(s) * (1.0f / DM); float s2 = 0.f;
#pragma unroll
        for (int j = 0; j < 4; ++j) { v[j] = v[j] - mean; s2 += (v[j][0] * v[j][0] + v[j][1] * v[j][1]) + (v[j][2] * v[j][2] + v[j][3] * v[j][3]); }
        const float rstd = 1.0f / sqrtf(wave_sum(s2) * (1.0f / DM) + LN_EPS);
        if (lane == 0) *(v2f*)(ST + row * 2) = (v2f){mean, rstd};
        unsigned long long* o8 = (unsigned long long*)(H + row * DM) + lane;
#pragma unroll
        for (int j = 0; j < 4; ++j) { const v4f x1 = v[j] * rstd * lg[j] + lb[j];
            const v4f shf = *(const v4f*)(ADA + (size_t)b * (6 * DM) + 3 * DM + 4 * lane + 256 * j), scf = *(const v4f*)(ADA + (size_t)b * (6 * DM) + 4 * DM + 4 * lane + 256 * j);
            const v4f hv = x1 * (scf + 1.0f) + shf;
            o8[64 * j] = (unsigned long long)pk2(hv[0], hv[1]) | ((unsigned long long)pk2(hv[2], hv[3]) << 32); }
    }
}
__device__ __forceinline__ void phase_convfix(const Params& p, const int tid) {
    const float* ULAST = (const float*)(p.ws + WS_ULAST); const float* YFIRST = (const float*)(p.ws + WS_YFIRST); bf16raw* G = (bf16raw*)(p.ws + WS_G);
    constexpr int CH = DFF / 4;
    for (int i = blockIdx.x * 512 + tid; i < (MTOK / 128) * CH; i += gridDim.x * 512) {
        const int s = i / CH, c4 = (i % CH) * 4; const bool halo = (s & 31) != 0;
        v4f y[2][2];
#pragma unroll
        for (int part = 0; part < 2; ++part) { const int col = part * DFF + c4;
            y[part][0] = *(const v4f*)(YFIRST + ((size_t)s * 2 + 0) * NUP + col); y[part][1] = *(const v4f*)(YFIRST + ((size_t)s * 2 + 1) * NUP + col);
            if (halo) { const v4f u6 = *(const v4f*)(ULAST + ((size_t)(s - 1) * 2 + 0) * NUP + col), u7 = *(const v4f*)(ULAST + ((size_t)(s - 1) * 2 + 1) * NUP + col);
                const v4f w0 = *(const v4f*)(p.conv_w + col), w1 = *(const v4f*)(p.conv_w + NUP + col);
                y[part][0] += w0 * u6 + w1 * u7; y[part][1] += w0 * u7; } }
#pragma unroll
        for (int t = 0; t < 2; ++t) { float r[4];
#pragma unroll
            for (int e = 0; e < 4; ++e) { const float g = y[1][t][e]; r[e] = y[0][t][e] * g / (1.0f + __expf(-g)); }
            *(v2u*)(G + ((size_t)s * 128 + t) * DFF + c4) = (v2u){pk2(r[0], r[1]), pk2(r[2], r[3])}; }
    }
}
__device__ __forceinline__ void phase_ln2(const Params& p, const int tid) {
    const int lane = tid & 63, wave = tid >> 6;
    v4f lg[4], lb[4];
#pragma unroll
    for (int j = 0; j < 4; ++j) { lg[j] = *(const v4f*)(p.ln2_g + 4 * lane + 256 * j); lb[j] = *(const v4f*)(p.ln2_b + 4 * lane + 256 * j); }
    for (size_t row = (size_t)blockIdx.x * 8 + wave; row < (size_t)MTOK; row += (size_t)gridDim.x * 8) {
        v4f* yr = (v4f*)(p.out + row * DM) + lane;
        v4f v[4]; float s = 0.f;
#pragma unroll
        for (int j = 0; j < 4; ++j) { v[j] = yr[64 * j]; s += (v[j][0] + v[j][1]) + (v[j][2] + v[j][3]); }
        const float mean = wave_sum(s) * (1.0f / DM); float s2 = 0.f;
#pragma unroll
        for (int j = 0; j < 4; ++j) { v[j] = v[j] - mean; s2 += (v[j][0] * v[j][0] + v[j][1] * v[j][1]) + (v[j][2] * v[j][2] + v[j][3] * v[j][3]); }
        const float rstd = 1.0f / sqrtf(wave_sum(s2) * (1.0f / DM) + LN_EPS);
#pragma unroll
        for (int j = 0; j < 4; ++j) yr[64 * j] = v[j] * rstd * lg[j] + lb[j];
    }
}

#ifndef REP_FOX
#define REP_FOX 1
#endif
#ifndef REP_DIL
#define REP_DIL 1
#endif
#ifndef REPMASK
#define REPMASK 0
#endif
constexpr size_t WS_CTL = 0, CTL_ZERO_BYTES = 65536;
constexpr int LDSCTL_OFF = RING_BYTES;

constexpr int N_PHASES = 14;
__global__ void __launch_bounds__(512, 2) fwd_megakernel(Params p) {
    extern __shared__ __attribute__((aligned(16))) unsigned char lds_raw[];
    LAS unsigned char* lds = (LAS unsigned char*)lds_raw;
    cg::grid_group grid = cg::this_grid();
    const int wid_k = __builtin_amdgcn_readfirstlane(threadIdx.x >> 6);
#define MK_TID() (wid_k * 64 + lane_id())
    const int lo = p.ph_lo, hi = p.ph_hi;
    XcdBarrier bar;
    { const int t0 = MK_TID();
      for (int u = t0; u < (LDS_BYTES - LDSCTL_OFF) / 4; u += 512) ((LAS unsigned*)(lds + LDSCTL_OFF))[u] = 0u;
      __syncthreads();
      bar = xcd_barrier_post((unsigned*)(p.ws + WS_CTL), (volatile LAS unsigned*)(lds + LDSCTL_OFF) + 8, t0); }
#define IN(k) (lo <= (k) && (k) < hi)
#define SEAM(k) do { if (IN(k) && IN((k) + 1)) { if ((k) == 0) grid.sync(); else xcd_barrier(bar, MK_TID()); } } while (0)
    bf16raw* H = (bf16raw*)(p.ws + WS_H); bf16raw* Z = (bf16raw*)(p.ws + WS_Z); bf16raw* MG = (bf16raw*)(p.ws + WS_MG);
    const float* ADA = (const float*)(p.ws + WS_ADA);
    if (IN(0)) for (int rp = 0; rp <= ((REPMASK >> (0)) & 1); ++rp) { phase_prologue(p, lds, MK_TID()); } SEAM(0);
    if (IN(1)) for (int rp = 0; rp <= ((REPMASK >> (1)) & 1); ++rp) { phase_pre1(p, lds, MK_TID()); } SEAM(1);
    if (IN(2)) for (int rp = 0; rp <= ((REPMASK >> (2)) & 1); ++rp) {
        phase_fabs(p, MK_TID());
        pg8::Gemm g{H, (const bf16raw*)(p.ws + WS_WIN), MTOK, NZ, DM}; pg8::StaticOrder S; S.init(MTOK, NZ, gridDim.x, (int)blockIdx.x);
        pg8::EpiIn E{Z, (const float*)(p.ws + WS_CS)};
        pg8::gemm_phase<pg8::EpiIn, pg8::StaticOrder, true, true>(lds, g, S, E, MK_TID());
    } SEAM(2);
    if (IN(3)) for (int rp = 0; rp <= ((REPMASK >> (3)) & 1); ++rp) {
        { const int G = gridDim.x, bx = blockIdx.x, vcu = (G % 8 == 0) ? (bx % 8) * (G / 8) + bx / 8 : bx, per = (1024 + G - 1) / G;
          const int ftid = MK_TID();
          for (int rep = 0; rep < REP_FOX; ++rep)
          for (int u = vcu * per; u < (vcu + 1) * per && u < 1024; ++u) { const int bh = u >> 3, j = u & 7;
              fox::fox_unit<8>(bh >> 3, bh & 7, 15 - j, Z, (const float*)(p.ws + WS_FABS), p.ws + WS_KXT, MG, p.gn_a, lds, ftid);
              fox::fox_unit<8>(bh >> 3, bh & 7, j, Z, (const float*)(p.ws + WS_FABS), p.ws + WS_KXT, MG, p.gn_a, lds, ftid); } }
        const int atid = MK_TID();
        for (int rep = 0; rep < REP_DIL; ++rep)
        for (int u = att::N_FOX_UNITS + blockIdx.x; u < att::N_UNITS; u += gridDim.x) {
            const att::AUnit U = att::decode_unit(u);
            att::attn_unit_simple(U, Z, (const float*)(p.ws + WS_FABS), MG, p.gn_a, (bf16raw*)(p.ws + WS_OP), (float*)(p.ws + WS_LSE), lds, atid);
            __syncthreads();
        }
    } SEAM(3);
    if (IN(4)) for (int rp = 0; rp <= ((REPMASK >> (4)) & 1); ++rp) { phase_merge(p, MK_TID()); } SEAM(4);
    if (IN(5)) for (int rp = 0; rp <= ((REPMASK >> (5)) & 1); ++rp) {
        pg8::Gemm g{MG, (const bf16raw*)(p.ws + WS_WOUT), MTOK, DM, DM}; pg8::StaticOrder S; S.init(MTOK, DM, gridDim.x, (int)blockIdx.x);
        pg8::EpiOut E{p.x, p.out, ADA};
        pg8::gemm_phase<pg8::EpiOut, pg8::StaticOrder, true, true>(lds, g, S, E, MK_TID());
    } SEAM(5);
    if (IN(6)) for (int rp = 0; rp <= ((REPMASK >> (6)) & 1); ++rp) { phase_ln1(p, MK_TID()); } SEAM(6);
    if (IN(7)) for (int rp = 0; rp <= ((REPMASK >> (7)) & 1); ++rp) {
        pg8::Gemm g{H, (const bf16raw*)(p.ws + WS_WUP), MTOK, NUP, DM}; pg8::StaticOrder S; S.init(MTOK, NUP, gridDim.x, (int)blockIdx.x);
        pg8::EpiUpConv E{(bf16raw*)(p.ws + WS_G), (float*)(p.ws + WS_ULAST), (float*)(p.ws + WS_YFIRST), p.conv_w, p.conv_b};
        pg8::gemm_phase<pg8::EpiUpConv, pg8::StaticOrder, true, true, 1>(lds, g, S, E, MK_TID());
    } SEAM(7);
    if (IN(8)) for (int rp = 0; rp <= ((REPMASK >> (8)) & 1); ++rp) { phase_convfix(p, MK_TID()); } SEAM(8);
    if (IN(11)) for (int rp = 0; rp <= ((REPMASK >> (11)) & 1); ++rp) {
        pg8::Gemm g{(const bf16raw*)(p.ws + WS_G), (const bf16raw*)(p.ws + WS_WDN), MTOK, DM, DFF}; pg8::StaticOrder S; S.init(MTOK, DM, gridDim.x, (int)blockIdx.x);
        pg8::EpiDown E{p.out, (const float*)(p.ws + WS_ST1), ADA, p.ln1_g, p.ln1_b};
        pg8::gemm_phase<pg8::EpiDown, pg8::StaticOrder, true, true>(lds, g, S, E, MK_TID());
    } SEAM(11);
    if (IN(12)) for (int rp = 0; rp <= ((REPMASK >> (12)) & 1); ++rp) { phase_ln2(p, MK_TID()); }
#undef IN
#undef SEAM
}

extern "C" void kernel_launch(void* const* d_in, const int* in_sizes, int n_in, void* d_out, int out_size, void* d_ws, size_t ws_size, hipStream_t stream) {
    static int grid = 0;
    if (grid == 0) {
        if (n_in != 18 || out_size != MTOK * DM || ws_size < WS_END) { fprintf(stderr, "kernel_launch: unexpected problem (n_in %d out %d ws %zu)\n", n_in, out_size, ws_size); grid = -1; return; }
        int dev = 0, cus = 0, per_cu = 0;
        hipGetDevice(&dev); hipDeviceGetAttribute(&cus, hipDeviceAttributeMultiprocessorCount, dev);
        if (hipFuncSetAttribute((const void*)fwd_megakernel, hipFuncAttributeMaxDynamicSharedMemorySize, LDS_BYTES) != hipSuccess) { fprintf(stderr, "kernel_launch: hipFuncSetAttribute failed\n"); grid = -1; return; }
        if (hipOccupancyMaxActiveBlocksPerMultiprocessor(&per_cu, (const void*)fwd_megakernel, 512, LDS_BYTES) != hipSuccess || per_cu < 1) { fprintf(stderr, "kernel_launch: occupancy query says %d\n", per_cu); per_cu = 1; }
        (void)hipGetLastError();
        if (per_cu > 1) per_cu = 1;
        grid = cus * per_cu;
    }
    if (grid < 0) return;
    Params p{};
    p.x = (const float*)d_in[0]; p.c = (const float*)d_in[1]; p.pos = (const int*)d_in[2]; p.w_ada = (const float*)d_in[3]; p.b_ada = (const float*)d_in[4];
    p.w_in = (const float*)d_in[5]; p.b_fgate = (const float*)d_in[6]; p.gn_a = (const float*)d_in[7]; p.gn_b = (const float*)d_in[8]; p.w_out = (const float*)d_in[9];
    p.ln1_g = (const float*)d_in[10]; p.ln1_b = (const float*)d_in[11]; p.w_up = (const float*)d_in[12]; p.conv_w = (const float*)d_in[13]; p.conv_b = (const float*)d_in[14];
    p.w_down = (const float*)d_in[15]; p.ln2_g = (const float*)d_in[16]; p.ln2_b = (const float*)d_in[17];
    p.out = (float*)d_out; p.ws = (unsigned char*)d_ws;
#if MK_SPLIT
    for (int ph = 0; ph < N_PHASES - 1; ++ph) { p.ph_lo = ph; p.ph_hi = ph + 1; hipLaunchKernelGGL(fwd_megakernel, dim3(grid), dim3(512), LDS_BYTES, stream, p); }
#else
    p.ph_lo = 0; p.ph_hi = N_PHASES;
    if (hipMemsetAsync((char*)d_ws + WS_CTL, 0, CTL_ZERO_BYTES, stream) != hipSuccess) { fprintf(stderr, "kernel_launch: memset failed\n"); return; }
    void* args[] = {&p};
    hipError_t e = hipLaunchCooperativeKernel((const void*)fwd_megakernel, dim3(grid), dim3(512), args, LDS_BYTES, stream);
    if (e != hipSuccess) fprintf(stderr, "cooperative launch failed: %s (grid %d)\n", hipGetErrorString(e), grid);
#endif
}
```

```cpp
#include <hip/hip_runtime.h>
#include <hip/hip_cooperative_groups.h>
#include <cstdio>
#include <cstdint>
namespace cg = cooperative_groups;

#ifndef MK_SPLIT
#define MK_SPLIT 0
#endif

constexpr int NB = 16, SEQ = 4096, DM = 1024, MTOK = NB * SEQ;
constexpr int DIN = 3080, NZ = 3072;
constexpr int DFF = 2816, NUP = 5632;
constexpr int NH = 8, HD = 64;
constexpr float ALPHA = 1.189207115002721f;
constexpr float LOG2E = 1.4426950408889634f;
constexpr float QSCALE = 0.125f * LOG2E;
constexpr float LN_EPS = 1e-5f, RMS_EPS = 1e-6f;
constexpr int ZQA = 0, ZKA = 512, ZVA = 1024, ZQB = 1536, ZKB = 2048, ZVB = 2560;

#define LAS __attribute__((address_space(3)))
typedef unsigned short bf16raw;
typedef unsigned v4u __attribute__((ext_vector_type(4)));
typedef unsigned v2u __attribute__((ext_vector_type(2)));
typedef float v4f __attribute__((ext_vector_type(4)));
typedef float v2f __attribute__((ext_vector_type(2)));

__device__ __forceinline__ unsigned f2bf(float f) { unsigned u = __builtin_bit_cast(unsigned, f); return (u + 0x7fffu + ((u >> 16) & 1u)) >> 16; }
__device__ __forceinline__ unsigned pk2(float lo, float hi) { return f2bf(lo) | (f2bf(hi) << 16); }
__device__ __forceinline__ float bflo(unsigned w) { return __builtin_bit_cast(float, w << 16); }
__device__ __forceinline__ float bfhi(unsigned w) { return __builtin_bit_cast(float, w & 0xffff0000u); }
__device__ __forceinline__ int lane_id() { int l; asm volatile("v_mbcnt_lo_u32_b32 %0, -1, 0\n\tv_mbcnt_hi_u32_b32 %0, -1, %0" : "=v"(l)); return l; }
__device__ __forceinline__ float sum8_dpp(float v) {
    v += __builtin_bit_cast(float, __builtin_amdgcn_mov_dpp(__builtin_bit_cast(int, v), 0xB1, 0xF, 0xF, true));
    v += __builtin_bit_cast(float, __builtin_amdgcn_mov_dpp(__builtin_bit_cast(int, v), 0x4E, 0xF, 0xF, true));
    v += __builtin_bit_cast(float, __builtin_amdgcn_mov_dpp(__builtin_bit_cast(int, v), 0x141, 0xF, 0xF, true));
    return v;
}
__device__ __forceinline__ float wave_sum(float v) {
#pragma unroll
    for (int o = 1; o < 64; o <<= 1) v += __shfl_xor(v, o);
    return v;
}

namespace pg8 {
#define PG8_LAS __attribute__((address_space(3)))
typedef unsigned short bf16_t;
typedef short bf16x8 __attribute__((ext_vector_type(8)));
typedef float f32x4 __attribute__((ext_vector_type(4)));
typedef unsigned u32x4 __attribute__((ext_vector_type(4)));
constexpr int BM = 256, BK = 64, HALF = 128, HTB = HALF * BK * 2  , STAGE_BYTES = 8 * HTB, NXCD = 8, WGM = 8;

__host__ __device__ __forceinline__ int lds_byte(int r, int c) { const int st = (r >> 4) * 2 + (c >> 5), rr = r & 15, cc = c & 31, ob = rr * 64 + cc * 2; return st * 1024 + (ob ^ (((ob >> 9) & 1) << 5)); }
__host__ __device__ __forceinline__ void stage_rc(int b, int& R, int& C) { const int st = b / 1024, sb = b % 1024, swz = sb ^ (((sb >> 9) & 1) << 5); R = (st >> 1) * 16 + swz / 64; C = (st & 1) * 32 + (swz % 64) / 2; }
__host__ __device__ __forceinline__ int perm32(int rho) { const int n = rho >> 4, i = rho & 15; return 8 * (i >> 2) + 4 * n + (i & 3); }

struct Unit { int pm, pn; };
struct Gemm { const bf16_t* A; const bf16_t* Bt; int M, N, K; };

struct StaticOrder {
    int nM, nN, nwg, G, c;
    __host__ __device__ void init(int M, int N, int G_, int c_) { nM = M / BM; nN = N / BM; nwg = nM * nN; G = G_; c = c_; }
    __host__ __device__ bool next(int i, Unit& u) const {
        const long L = (long)i * G + c; if (L >= nwg) return false;
        int wgid = (int)L; { const int q = nwg / NXCD, r = nwg % NXCD, xcd = wgid % NXCD, off = wgid / NXCD; wgid = (xcd < r ? xcd * (q + 1) : r * (q + 1) + (xcd - r) * q) + off; }
        const int nig = WGM * nN, gid = wgid / nig, fm = gid * WGM, gsz = (nM - fm) < WGM ? (nM - fm) : WGM;
        u.pm = fm + ((wgid % nig) % gsz); u.pn = (wgid % nig) / gsz; return true;
    }
    __device__ __forceinline__ void a_ready(const Unit&) const {}
    __device__ __forceinline__ void done(const Unit&) const {}
};

__device__ __forceinline__ unsigned cvt_pk_bf16(float lo, float hi) { unsigned r; asm volatile("v_cvt_pk_bf16_f32 %0, %1, %2" : "=v"(r) : "v"(lo), "v"(hi)); return r; }
typedef float f32x2 __attribute__((ext_vector_type(2)));

struct EpiIn {
    static constexpr bool PERM = true, AFTER_DRAIN = false;
    bf16_t* Z; const float* CS;
    __device__ __forceinline__ void operator()(const f32x4 (&acc)[2][2][4][2], const Unit& u, int wr, int wc, int fr, int fq) const {
        const int row0 = u.pm * BM + wr * 64 + fr, col0 = u.pn * BM + wc * 32 + 8 * fq;
        const bool isq = (u.pn < 2) || (u.pn == 6) || (u.pn == 7);
        const float sc = isq ? QSCALE : 1.0f;
        const bool rot = (u.pn >= 6) && (u.pn < 10) && ((wc & 1) == 0) && (fq < 2);
#pragma unroll
        for (int ai = 0; ai < 2; ++ai)
#pragma unroll
            for (int m = 0; m < 4; ++m) {
                const int row = row0 + ai * HALF + m * 16;
                f32x4 cs = (f32x4){1.f, 1.f, 1.f, 1.f}, sn = (f32x4){0.f, 0.f, 0.f, 0.f};
                if (rot) { cs = *(const f32x4*)(CS + (size_t)row * 16 + 4 * fq); sn = *(const f32x4*)(CS + (size_t)row * 16 + 8 + 4 * fq); }
                bf16_t* rowp = Z + (size_t)row * NZ + col0;
#pragma unroll
                for (int bj = 0; bj < 2; ++bj) {
                    f32x4 v0 = acc[ai][bj][m][0], v1 = acc[ai][bj][m][1];
                    const f32x4 t1 = v0 * cs - v1 * sn, t2 = v1 * cs + v0 * sn;
                    v0 = t1 * sc; v1 = t2 * sc;
                    u32x4 w; w.x = cvt_pk_bf16(v0[0], v0[1]); w.y = cvt_pk_bf16(v0[2], v0[3]); w.z = cvt_pk_bf16(v1[0], v1[1]); w.w = cvt_pk_bf16(v1[2], v1[3]);
                    *(u32x4*)(rowp + bj * HALF) = w;
                }
            }
    }
};
struct EpiOut {
    static constexpr bool PERM = false, AFTER_DRAIN = false;
    const float* x; float* y; const float* ada;
    __device__ __forceinline__ void operator()(const f32x4 (&acc)[2][2][4][2], const Unit& u, int wr, int wc, int fr, int fq) const {
        const int row0 = u.pm * BM + wr * 64 + fr, col0 = u.pn * BM + wc * 32 + 4 * fq;
        const float* ga = ada + (size_t)(u.pm >> 4) * (6 * DM) + 2 * DM + col0;
#pragma unroll
        for (int bj = 0; bj < 2; ++bj)
#pragma unroll
            for (int n = 0; n < 2; ++n) {
                const f32x4 g = *(const f32x4*)(ga + bj * HALF + n * 16);
#pragma unroll
                for (int ai = 0; ai < 2; ++ai)
#pragma unroll
                    for (int m = 0; m < 4; ++m) {
                        const size_t off = (size_t)(row0 + ai * HALF + m * 16) * DM + col0 + bj * HALF + n * 16;
                        const f32x4 xv = *(const f32x4*)(x + off);
                        *(f32x4*)(y + off) = xv * ALPHA + g * acc[ai][bj][m][n];
                    }
                asm volatile("" ::: "memory");
            }
    }
};
struct EpiRaw {
    static constexpr bool PERM = true, AFTER_DRAIN = false;
    bf16_t* O; int ldc;
    __device__ __forceinline__ void operator()(const f32x4 (&acc)[2][2][4][2], const Unit& u, int wr, int wc, int fr, int fq) const {
        const int row0 = u.pm * BM + wr * 64 + fr, col0 = u.pn * BM + wc * 32 + 8 * fq;
#pragma unroll
        for (int ai = 0; ai < 2; ++ai)
#pragma unroll
            for (int m = 0; m < 4; ++m) { bf16_t* rowp = O + (size_t)(row0 + ai * HALF + m * 16) * ldc + col0;
#pragma unroll
                for (int bj = 0; bj < 2; ++bj) { const f32x4 v0 = acc[ai][bj][m][0], v1 = acc[ai][bj][m][1];
                    u32x4 w; w.x = cvt_pk_bf16(v0[0], v0[1]); w.y = cvt_pk_bf16(v0[2], v0[3]); w.z = cvt_pk_bf16(v1[0], v1[1]); w.w = cvt_pk_bf16(v1[2], v1[3]);
                    *(u32x4*)(rowp + bj * HALF) = w; } }
    }
};
struct EpiDown {
    static constexpr bool PERM = false, AFTER_DRAIN = false;
    float* y; const float* st; const float* ada; const float* lng; const float* lnb;
    __device__ __forceinline__ void operator()(const f32x4 (&acc)[2][2][4][2], const Unit& u, int wr, int wc, int fr, int fq) const {
        const int row0 = u.pm * BM + wr * 64 + fr, col0 = u.pn * BM + wc * 32 + 4 * fq;
        const float* gf = ada + (size_t)(u.pm >> 4) * (6 * DM) + 5 * DM + col0;
        f32x2 sr[2][4];
#pragma unroll
        for (int ai = 0; ai < 2; ++ai)
#pragma unroll
            for (int m = 0; m < 4; ++m) sr[ai][m] = *(const f32x2*)(st + (size_t)(row0 + ai * HALF + m * 16) * 2);
#pragma unroll
        for (int bj = 0; bj < 2; ++bj)
#pragma unroll
            for (int n = 0; n < 2; ++n) {
                const int co = bj * HALF + n * 16;
                const f32x4 g = *(const f32x4*)(gf + co), lg = *(const f32x4*)(lng + col0 + co), lb = *(const f32x4*)(lnb + col0 + co);
#pragma unroll
                for (int ai = 0; ai < 2; ++ai)
#pragma unroll
                    for (int m = 0; m < 4; ++m) {
                        const size_t off = (size_t)(row0 + ai * HALF + m * 16) * DM + col0 + co;
                        const f32x4 yv = *(const f32x4*)(y + off);
                        const f32x4 x1 = (yv - sr[ai][m].x) * sr[ai][m].y * lg + lb;
                        *(f32x4*)(y + off) = x1 * ALPHA + g * acc[ai][bj][m][n];
                    }
                asm volatile("" ::: "memory");
            }
    }
};


__device__ __forceinline__ f32x4 dpp_shr1(const f32x4 v) { f32x4 r;
#pragma unroll
    for (int e = 0; e < 4; ++e) { float t; asm("s_nop 1\n\tv_mov_b32_dpp %0, %1 row_shr:1 row_mask:0xf bank_mask:0xf bound_ctrl:1" : "=v"(t) : "v"(v[e])); r[e] = t; }
    return r; }
struct EpiUpConv {
    static constexpr bool PERM = true, AFTER_DRAIN = false;
    bf16_t* G; float* ULAST; float* YFIRST; const float* cw; const float* cb;
    __device__ __forceinline__ void operator()(f32x4 (&acc)[2][2][4][2], const Unit& u, int wr, int wc, int fr, int fq) const {
        const int strip = 2 * u.pm + wr, ca = 128 * u.pn + 32 * wc + 8 * fq;
#define ACCJ(j, bj, n) acc[(j) >> 2][bj][(j) & 3][n]
#pragma unroll
        for (int bj = 0; bj < 2; ++bj)
#pragma unroll
            for (int n = 0; n < 2; ++n) {
                const int col = bj * DFF + ca + 4 * n;
                const f32x4 w0 = *(const f32x4*)(cw + col), w1 = *(const f32x4*)(cw + NUP + col), w2 = *(const f32x4*)(cw + 2 * NUP + col), b = *(const f32x4*)(cb + col);
                const f32x4 u6 = ACCJ(6, bj, n), u7 = ACCJ(7, bj, n);
                if (fr == 15) { *(f32x4*)(ULAST + ((size_t)strip * 2 + 0) * NUP + col) = u6; *(f32x4*)(ULAST + ((size_t)strip * 2 + 1) * NUP + col) = u7; }
                const f32x4 p6 = dpp_shr1(u6), p7 = dpp_shr1(u7);
#pragma unroll
                for (int j = 7; j >= 2; --j) ACCJ(j, bj, n) = b + w0 * ACCJ(j - 2, bj, n) + w1 * ACCJ(j - 1, bj, n) + w2 * ACCJ(j, bj, n);
                const f32x4 y1 = b + w0 * p7 + w1 * ACCJ(0, bj, n) + w2 * ACCJ(1, bj, n), y0 = b + w0 * p6 + w1 * p7 + w2 * ACCJ(0, bj, n);
                ACCJ(1, bj, n) = y1; ACCJ(0, bj, n) = y0;
                if (fr == 0) { *(f32x4*)(YFIRST + ((size_t)strip * 2 + 0) * NUP + col) = y0; *(f32x4*)(YFIRST + ((size_t)strip * 2 + 1) * NUP + col) = y1; }
            }
        bf16_t* gp = G + ((size_t)strip * 128 + 8 * fr) * DFF + ca;
#pragma unroll
        for (int j = 0; j < 8; ++j) {
            f32x4 r0, r1;
#pragma unroll
            for (int e = 0; e < 4; ++e) { const float g0 = ACCJ(j, 1, 0)[e], g1 = ACCJ(j, 1, 1)[e];
                r0[e] = ACCJ(j, 0, 0)[e] * g0 * __builtin_amdgcn_rcpf(1.0f + __expf(-g0)); r1[e] = ACCJ(j, 0, 1)[e] * g1 * __builtin_amdgcn_rcpf(1.0f + __expf(-g1)); }
            u32x4 w; w.x = cvt_pk_bf16(r0[0], r0[1]); w.y = cvt_pk_bf16(r0[2], r0[3]); w.z = cvt_pk_bf16(r1[0], r1[1]); w.w = cvt_pk_bf16(r1[2], r1[3]);
            *(u32x4*)(gp + (size_t)j * DFF) = w;
        }
#undef ACCJ
    }
};
template <class Epi, class Sched, bool ALIGN_EPI = false, bool SP2 = false, int AMAP = 0>
__device__ __forceinline__ void gemm_phase(PG8_LAS unsigned char* lds, const Gemm g, const Sched& S, const Epi& E, const int tid) {
    const int wid = __builtin_amdgcn_readfirstlane(tid >> 6), lane = tid & 63, wr = wid >> 2, wc = wid & 3, fr = lane & 15, fq = lane >> 4;
    const int K = g.K, nt = K / BK;
    unsigned voffA[2], voffB[2];
#pragma unroll
    for (int i = 0; i < 2; ++i) { int R, C; stage_rc(tid * 16 + i * 8192, R, C); const int Rb = Epi::PERM ? ((R & ~31) + perm32(R & 31)) : R;
        const int Ra = AMAP ? ((R >> 6) * 128 + (R & 15) * 8 + ((R >> 4) & 3)) : R;
        voffA[i] = (unsigned)(Ra * K + C) * 2u; voffB[i] = (unsigned)(Rb * K + C) * 2u; }
    const size_t kstep = (size_t)(BK * 2);
    const size_t hstep = (size_t)HALF * K * 2;
    const size_t hstepA = AMAP ? (size_t)4 * K * 2 : hstep;
    const size_t tstep = 2 * hstep;
    const unsigned ldsw = (unsigned)wid * 1024u;
    const int aoff = lds_byte(wr * 64 + fr, fq * 8), boff = lds_byte(wc * 32 + fr, fq * 8);
#define PG8_SA(b, h) (((b) * 2 + (h)) * HTB)
#define PG8_SB(b, h) ((4 + (b) * 2 + (h)) * HTB)
#define PG8_STAGE(bufoff, gbase, voff) do { _Pragma("unroll") for (int _i = 0; _i < 2; ++_i) \
        __builtin_amdgcn_global_load_lds((const unsigned*)((const char*)(gbase) + (voff)[_i]), (PG8_LAS unsigned*)(lds + (bufoff) + ldsw + _i * 8192), 16, 0, 0); } while (0)
#define PG8_LDA(dst, b, h) do { _Pragma("unroll") for (int m = 0; m < 4; ++m) _Pragma("unroll") for (int k = 0; k < 2; ++k) dst[m][k] = *(const PG8_LAS bf16x8*)(lds + PG8_SA(b, h) + aoff + m * 2048 + k * 1024); } while (0)
#define PG8_LDB(dst, b, h) do { _Pragma("unroll") for (int n = 0; n < 2; ++n) _Pragma("unroll") for (int k = 0; k < 2; ++k) dst[n][k] = *(const PG8_LAS bf16x8*)(lds + PG8_SB(b, h) + boff + n * 2048 + k * 1024); } while (0)
#define PG8_MMA(ai, bj, At, Bt) do { __builtin_amdgcn_s_setprio(1); _Pragma("unroll") for (int m = 0; m < 4; ++m) _Pragma("unroll") for (int n = 0; n < 2; ++n) _Pragma("unroll") for (int k = 0; k < 2; ++k) \
        acc[ai][bj][m][n] = __builtin_amdgcn_mfma_f32_16x16x32_bf16(Bt[n][k], At[m][k], acc[ai][bj][m][n], 0, 0, 0); __builtin_amdgcn_s_setprio(0); } while (0)
#define PG8_WAIT_V(n) asm volatile("s_waitcnt vmcnt(" #n ")" ::: "memory")
#define PG8_WAIT_L(n) asm volatile("s_waitcnt lgkmcnt(" #n ")" ::: "memory")
#define PG8_BAR __builtin_amdgcn_s_barrier()
#define PG8_SCHED __builtin_amdgcn_sched_barrier(0)
    Unit cur, nxt; int ui = 0;
    if (!S.next(0, cur)) return;
    f32x4 acc[2][2][4][2];
#pragma unroll
    for (int a = 0; a < 2; ++a)
#pragma unroll
        for (int b = 0; b < 2; ++b)
#pragma unroll
            for (int m = 0; m < 4; ++m)
#pragma unroll
                for (int n = 0; n < 2; ++n) acc[a][b][m][n] = (f32x4){0.f, 0.f, 0.f, 0.f};
    bf16x8 At[4][2], B0[2][2], B1[2][2];
    const char* cA = (const char*)g.A + (size_t)cur.pm * tstep; const char* cB = (const char*)g.Bt + (size_t)cur.pn * tstep;
    S.a_ready(cur);
    if constexpr (SP2) {
        PG8_STAGE(PG8_SB(0, 0), cB, voffB); PG8_STAGE(PG8_SB(0, 1), cB + hstep, voffB); PG8_STAGE(PG8_SA(0, 0), cA, voffA); PG8_STAGE(PG8_SA(0, 1), cA + hstepA, voffA);
        if (wr == 1) PG8_BAR;
        PG8_WAIT_V(2); PG8_BAR;
        PG8_STAGE(PG8_SB(1, 0), cB + kstep, voffB); PG8_STAGE(PG8_SA(1, 0), cA + kstep, voffA); PG8_STAGE(PG8_SB(1, 1), cB + hstep + kstep, voffB);
        PG8_WAIT_V(6); PG8_BAR;
    } else {
        PG8_STAGE(PG8_SB(0, 0), cB, voffB); PG8_STAGE(PG8_SA(0, 0), cA, voffA); PG8_STAGE(PG8_SB(0, 1), cB + hstep, voffB); PG8_STAGE(PG8_SA(0, 1), cA + hstepA, voffA);
        if (wr == 1) PG8_BAR;
        PG8_WAIT_V(4); PG8_BAR;
        PG8_STAGE(PG8_SB(1, 0), cB + kstep, voffB); PG8_STAGE(PG8_SA(1, 0), cA + kstep, voffA); PG8_STAGE(PG8_SB(1, 1), cB + hstep + kstep, voffB);
        PG8_WAIT_V(6); PG8_BAR;
    }
    for (;;) {
        const bool has_next = S.next(ui + 1, nxt);
        const char* nA = has_next ? (const char*)g.A + (size_t)nxt.pm * tstep : cA; const char* nB = has_next ? (const char*)g.Bt + (size_t)nxt.pn * tstep : cB;
        for (int t = 0; t < nt; t += 2) {
            const bool last = (t == nt - 2);
            const char* a1 = cA + (size_t)(t + 1) * kstep;
            const char* a2 = last ? nA : cA + (size_t)(t + 2) * kstep; const char* b2 = last ? nB : cB + (size_t)(t + 2) * kstep;
            const char* a3 = a2 + kstep; const char* b3 = b2 + kstep;
            if (last && has_next) S.a_ready(nxt);
            if constexpr (SP2) {
            PG8_LDB(B0, 0, 0); PG8_LDB(B1, 0, 1); PG8_SCHED; PG8_LDA(At, 0, 0); PG8_STAGE(PG8_SA(1, 1), a1 + hstepA, voffA);
            PG8_WAIT_V(8); PG8_WAIT_L(0); PG8_BAR; PG8_MMA(0, 0, At, B0); PG8_MMA(0, 1, At, B1); PG8_BAR; PG8_SCHED;
            PG8_LDA(At, 0, 1); PG8_STAGE(PG8_SB(0, 0), b2, voffB); PG8_STAGE(PG8_SB(0, 1), b2 + hstep, voffB); PG8_STAGE(PG8_SA(0, 0), a2, voffA);
            PG8_WAIT_V(8); PG8_WAIT_L(0); PG8_BAR; PG8_MMA(1, 0, At, B0); PG8_MMA(1, 1, At, B1); PG8_BAR; PG8_SCHED;
            PG8_LDB(B0, 1, 0); PG8_LDB(B1, 1, 1); PG8_SCHED; PG8_LDA(At, 1, 0); PG8_STAGE(PG8_SA(0, 1), a2 + hstepA, voffA);
            PG8_WAIT_V(8); PG8_WAIT_L(0); PG8_BAR; PG8_MMA(0, 0, At, B0); PG8_MMA(0, 1, At, B1); PG8_BAR; PG8_SCHED;
            PG8_LDA(At, 1, 1); PG8_STAGE(PG8_SB(1, 0), b3, voffB); PG8_STAGE(PG8_SB(1, 1), b3 + hstep, voffB); PG8_STAGE(PG8_SA(1, 0), a3, voffA);
            PG8_WAIT_V(8); PG8_WAIT_L(0); PG8_BAR; PG8_MMA(1, 0, At, B0); PG8_MMA(1, 1, At, B1); PG8_BAR; PG8_SCHED;
            } else {
            PG8_LDB(B0, 0, 0); PG8_SCHED; PG8_LDA(At, 0, 0); PG8_STAGE(PG8_SA(1, 1), a1 + hstepA, voffA);
            PG8_WAIT_L(8); PG8_BAR; PG8_WAIT_L(0); PG8_MMA(0, 0, At, B0); PG8_BAR; PG8_SCHED;
            PG8_LDB(B1, 0, 1); PG8_STAGE(PG8_SB(0, 0), b2, voffB);
            PG8_BAR; PG8_WAIT_L(0); PG8_MMA(0, 1, At, B1); PG8_BAR;
            PG8_LDA(At, 0, 1); PG8_STAGE(PG8_SA(0, 0), a2, voffA);
            PG8_BAR; PG8_WAIT_L(0); PG8_MMA(1, 0, At, B0); PG8_BAR; PG8_SCHED;
            PG8_STAGE(PG8_SB(0, 1), b2 + hstep, voffB);
            PG8_WAIT_V(6); PG8_BAR; PG8_MMA(1, 1, At, B1); PG8_BAR;
            PG8_LDB(B0, 1, 0); PG8_SCHED; PG8_LDA(At, 1, 0); PG8_STAGE(PG8_SA(0, 1), a2 + hstepA, voffA);
            PG8_WAIT_L(8); PG8_BAR; PG8_WAIT_L(0); PG8_MMA(0, 0, At, B0); PG8_BAR; PG8_SCHED;
            PG8_LDB(B1, 1, 1); PG8_STAGE(PG8_SB(1, 0), b3, voffB);
            PG8_BAR; PG8_WAIT_L(0); PG8_MMA(0, 1, At, B1); PG8_BAR;
            PG8_LDA(At, 1, 1); PG8_STAGE(PG8_SA(1, 0), a3, voffA);
            PG8_BAR; PG8_WAIT_L(0); PG8_MMA(1, 0, At, B0); PG8_BAR; PG8_SCHED;
            PG8_STAGE(PG8_SB(1, 1), b3 + hstep, voffB);
            PG8_WAIT_V(6); PG8_BAR; PG8_MMA(1, 1, At, B1); PG8_BAR;
            }
        }
        if constexpr (ALIGN_EPI) { if (wr == 0) PG8_BAR; }
        if constexpr (!Epi::AFTER_DRAIN) { E(acc, cur, wr, wc, fr, fq); S.done(cur); }
        if (!has_next) break;
#pragma unroll
        for (int a = 0; a < 2; ++a)
#pragma unroll
            for (int b = 0; b < 2; ++b)
#pragma unroll
                for (int m = 0; m < 4; ++m)
#pragma unroll
                    for (int n = 0; n < 2; ++n) acc[a][b][m][n] = (f32x4){0.f, 0.f, 0.f, 0.f};
        cur = nxt; cA = nA; cB = nB; ++ui;
        if constexpr (ALIGN_EPI) { if (wr == 1) PG8_BAR; }
    }
    PG8_WAIT_V(0);
    if constexpr (!ALIGN_EPI) { if (wr == 0) PG8_BAR; }
    PG8_BAR;
    if constexpr (Epi::AFTER_DRAIN) { E.fused(acc, cur, wr, wc, fr, fq, lds, wid, lane); S.done(cur); }
#undef PG8_SA
#undef PG8_SB
#undef PG8_STAGE
#undef PG8_LDA
#undef PG8_LDB
#undef PG8_MMA
#undef PG8_WAIT_V
#undef PG8_WAIT_L
#undef PG8_BAR
#undef PG8_SCHED
}
}

namespace fox {
typedef short bf16x8 __attribute__((ext_vector_type(8)));
typedef short s16x4 __attribute__((ext_vector_type(4)));
typedef float f32x16 __attribute__((ext_vector_type(16)));
typedef unsigned u32x4 __attribute__((ext_vector_type(4)));
constexpr int NW = 8, QBLK = 32, QB = QBLK * NW, KVBLK = 64;
__device__ __forceinline__ int crow(int r, int hi) { return (r & 3) + 8 * (r >> 2) + 4 * hi; }
#define SBAR() __builtin_amdgcn_sched_barrier(0)
__device__ __forceinline__ void cmask(f32x16& p0, f32x16& p1, int jb, int qrel, int hi) {
    const float NEGI = -INFINITY; int kb = 64 * jb + 4 * hi;
#pragma unroll
    for (int r = 0; r < 16; ++r) { int kv = kb + (r & 3) + 8 * (r >> 2); if (kv > qrel) p0[r] = NEGI; if (kv + 32 > qrel) p1[r] = NEGI; }
}
constexpr int NSLOT = 3, SLOTB = 9216, XOFF = 8192;
constexpr int LDS_K = 0, LDS_V = NSLOT * SLOTB, LDS_WS = 2 * NSLOT * SLOTB, LDS_OST = LDS_WS + NW * 64 * 4, OST_STRIDE = 68, OST_BYTES = 32 * OST_STRIDE * 4, LDS_BYTES = LDS_OST + NW * OST_BYTES;
__device__ __forceinline__ void glds16(const void* sbase, unsigned voff, unsigned lds_dst) { unsigned keep;
    asm volatile("s_mov_b32 %0, m0\n\ts_mov_b32 m0, %3\n\ts_nop 0\n\tglobal_load_lds_dwordx4 %1, %2\n\ts_mov_b32 m0, %0" : "=&s"(keep) : "v"(voff), "s"(sbase), "s"(lds_dst) : "memory"); }
__device__ __forceinline__ void glds4(const void* sbase, unsigned voff, unsigned lds_dst) { unsigned keep;
    asm volatile("s_mov_b32 %0, m0\n\ts_mov_b32 m0, %3\n\ts_nop 0\n\tglobal_load_lds_dword %1, %2\n\ts_mov_b32 m0, %0" : "=&s"(keep) : "v"(voff), "s"(sbase), "s"(lds_dst) : "memory"); }
__device__ __forceinline__ float max3f(float a, float b, float c) { float r; asm("v_max3_f32 %0, %1, %2, %3" : "=v"(r) : "v"(a), "v"(b), "v"(c)); return r; }
__device__ __forceinline__ float max2f(float a, float b) { float r; asm("v_max_f32_e32 %0, %1, %2" : "=v"(r) : "v"(a), "v"(b)); return r; }
__device__ __forceinline__ float fadd_s(float a, float b) { float r; asm("v_add_f32_e32 %0, %1, %2" : "=v"(r) : "v"(a), "v"(b)); return r; }
__device__ __forceinline__ float fsub_s(float a, float b) { float r; asm("v_sub_f32_e32 %0, %1, %2" : "=v"(r) : "v"(a), "v"(b)); return r; }
typedef float f32x2_t __attribute__((ext_vector_type(2))); typedef __bf16 bf16x2_t __attribute__((ext_vector_type(2)));
__device__ __forceinline__ unsigned cvtpk_s(float lo, float hi) { f32x2_t v = {lo, hi}; bf16x2_t b = __builtin_convertvector(v, bf16x2_t); return __builtin_bit_cast(unsigned, b); }
#define WAIT_BAR(N) asm volatile("s_waitcnt vmcnt(" #N ") lgkmcnt(0)\n\ts_barrier" ::: "memory")
__device__ __forceinline__ s16x4 make_qx(float a, int hi) {
    const unsigned w1 = cvtpk_s(a, 0.f); const float h = __builtin_bit_cast(float, w1 << 16);
    const float r1 = a - h; const unsigned w2 = cvtpk_s(r1, 0.f); const float m = __builtin_bit_cast(float, w2 << 16);
    const float r2 = r1 - m; const unsigned w3 = cvtpk_s(r2, 1.0f);
    unsigned x = (w1 & 0xffffu) | (w2 << 16), y = w3;
    if (hi) { x = 0x3f803f80u; y = 0u; }
    typedef unsigned u32x2 __attribute__((ext_vector_type(2)));
    return __builtin_bit_cast(s16x4, (u32x2){x, y});
}
typedef __attribute__((address_space(3))) const char* lds_cptr;
typedef short v4i16_t __attribute__((ext_vector_type(4)));
__device__ __forceinline__ void kload8(bf16x8* kf, lds_cptr kp) {
    kf[0] = *(const __attribute__((address_space(3))) bf16x8*)(kp);        kf[1] = *(const __attribute__((address_space(3))) bf16x8*)(kp + 512);
    kf[2] = *(const __attribute__((address_space(3))) bf16x8*)(kp + 2048); kf[3] = *(const __attribute__((address_space(3))) bf16x8*)(kp + 2560);
    kf[4] = *(const __attribute__((address_space(3))) bf16x8*)(kp + 4096); kf[5] = *(const __attribute__((address_space(3))) bf16x8*)(kp + 4608);
    kf[6] = *(const __attribute__((address_space(3))) bf16x8*)(kp + 6144); kf[7] = *(const __attribute__((address_space(3))) bf16x8*)(kp + 6656);
}
__device__ __forceinline__ void kload2(bf16x8* kf, lds_cptr kp, int j) { kf[2 * j] = *(const __attribute__((address_space(3))) bf16x8*)(kp + j * 2048); kf[2 * j + 1] = *(const __attribute__((address_space(3))) bf16x8*)(kp + j * 2048 + 512); }
__device__ __forceinline__ void xload2(s16x4* kx, lds_cptr xp) { kx[0] = *(const __attribute__((address_space(3))) s16x4*)(xp); kx[1] = *(const __attribute__((address_space(3))) s16x4*)(xp + 256); }
__device__ __forceinline__ s16x4 vtr(lds_cptr p) { return __builtin_bit_cast(s16x4, __builtin_amdgcn_ds_read_tr16_b64_v4i16((__attribute__((address_space(3))) v4i16_t*)p)); }
__device__ __forceinline__ float rowmax(const f32x16& p0, const f32x16& p1) {
    float a = max3f(p0[0], p0[1], p1[0]), b = max3f(p0[2], p0[3], p1[1]); a = max3f(a, p1[2], p1[3]);
#pragma unroll
    for (int r = 4; r < 16; r += 4) { a = max3f(a, p0[r], p0[r + 1]); b = max3f(b, p0[r + 2], p0[r + 3]); a = max3f(a, p1[r], p1[r + 1]); b = max3f(b, p1[r + 2], p1[r + 3]); }
    const float m = max2f(a, b);
    auto rr = __builtin_amdgcn_permlane32_swap(__float_as_uint(m), __float_as_uint(m), false, false);
    return max2f(__uint_as_float(rr[0]), __uint_as_float(rr[1]));
}
__device__ __forceinline__ void pv(f32x16* o, int vb, bf16x8 pa0, bf16x8 pa1, bf16x8 pa2, bf16x8 pa3) {
#pragma unroll
    for (int d0 = 0; d0 < 2; ++d0) { s16x4 lo[4], hi[4];
#pragma unroll
        for (int ks = 0; ks < 4; ++ks) {
            asm volatile("ds_read_b64_tr_b16 %0,%1 offset:%c2" : "=&v"(lo[ks]) : "v"(vb), "i"(d0 * 4096 + ks * 1024) : "memory");
            asm volatile("ds_read_b64_tr_b16 %0,%1 offset:%c2" : "=&v"(hi[ks]) : "v"(vb), "i"(d0 * 4096 + ks * 1024 + 512) : "memory"); }
        asm volatile("s_waitcnt lgkmcnt(0)" ::: "memory"); SBAR();
#define PK(k) (bf16x8){lo[k][0], lo[k][1], lo[k][2], lo[k][3], hi[k][0], hi[k][1], hi[k][2], hi[k][3]}
        o[d0] = __builtin_amdgcn_mfma_f32_32x32x16_bf16(pa0, PK(0), o[d0], 0, 0, 0);
        o[d0] = __builtin_amdgcn_mfma_f32_32x32x16_bf16(pa1, PK(1), o[d0], 0, 0, 0);
        o[d0] = __builtin_amdgcn_mfma_f32_32x32x16_bf16(pa2, PK(2), o[d0], 0, 0, 0);
        o[d0] = __builtin_amdgcn_mfma_f32_32x32x16_bf16(pa3, PK(3), o[d0], 0, 0, 0);
#undef PK
    }
}
#define MF16(a, b, c) __builtin_amdgcn_mfma_f32_32x32x16_bf16(a, b, c, 0, 0, 0)
#define MF8(a, b, c) __builtin_amdgcn_mfma_f32_32x32x8bf16_1k(a, b, c, 0, 0, 0)

template <int THRL> __device__ __forceinline__ void fox_unit(int b, int h, int qb, const bf16raw* __restrict__ Z, const float* __restrict__ FABS, const unsigned char* __restrict__ KXT,
                                                             bf16raw* MG, const float* __restrict__ gn_a, LAS unsigned char* shm, const int tid) {
    const int lane = tid & 63, r32 = lane & 31, hi = lane >> 5; const int wid = __builtin_amdgcn_readfirstlane(tid >> 6);
    const long rowbase = (long)b * SEQ; const int q0 = qb * QB;
    const bf16raw* Qw = Z + (rowbase + q0 + wid * QBLK) * NZ + ZQA + h * HD;
    const bf16raw* Kh = Z + rowbase * NZ + ZKA + h * HD, *Vh = Z + rowbase * NZ + ZVA + h * HD;
    const unsigned char* Xh = KXT + (size_t)(b * NH + h) * (SEQ / 64) * 1024;
    const unsigned lds0 = (unsigned)(uintptr_t)shm;
    LAS float* wsf = (LAS float*)(shm + LDS_WS) + wid * 64;
    const unsigned kvo = (unsigned)(lane * NZ + wid * 8) * 2u, vvo = (unsigned)((16 * (wid & 3) + (lane >> 2)) * NZ + (wid >> 2) * 32 + (lane & 3) * 8) * 2u, xvo = (unsigned)((wid & 3) * 256 + lane * 4);
    const unsigned kdst = lds0 + LDS_K + wid * 1024, vdst = lds0 + LDS_V + wid * 1024, xdst = lds0 + LDS_K + XOFF + (wid & 3) * 256;
#define DMA_K(t, slot) do { glds16(Kh + (long)(t) * KVBLK * NZ, kvo, (unsigned)__builtin_amdgcn_readfirstlane(kdst + (slot))); glds4(Xh + (size_t)(t) * 1024, xvo, (unsigned)__builtin_amdgcn_readfirstlane(xdst + (slot))); } while (0)
#define DMA_V(t, slot) glds16(Vh + (long)(t) * KVBLK * NZ, vvo, (unsigned)__builtin_amdgcn_readfirstlane(vdst + (slot)))
    const int vb0 = (int)(lds0 + LDS_V) + ((lane >> 4) & 1) * 32 + (lane & 3) * 8 + (4 * hi + ((lane & 15) >> 2)) * 64;
    bf16x8 kf[8]; s16x4 kx[2];
    const lds_cptr shm3 = (lds_cptr)shm; const lds_cptr kp0 = shm3 + LDS_K + hi * 1024 + r32 * 16; const lds_cptr xp0 = shm3 + LDS_K + XOFF + hi * 512 + r32 * 8;
    const lds_cptr vp0 = shm3 + LDS_V + ((lane >> 4) & 1) * 32 + (lane & 3) * 8 + (4 * hi + ((lane & 15) >> 2)) * 64;
    const int NT = (q0 + QB) / KVBLK;
    DMA_K(0, 0); DMA_V(0, 0); DMA_K(1, SLOTB);
    bf16x8 qr[4];
#pragma unroll
    for (int d0 = 0; d0 < 4; ++d0) qr[d0] = *reinterpret_cast<const bf16x8*>(&Qw[(long)r32 * NZ + d0 * 16 + hi * 8]);
    const float fq2 = FABS[(size_t)(b * NH + h) * SEQ + q0 + wid * QBLK + r32] * LOG2E;
    float mhat = 0.f, l_reg = 0.f; f32x16 o[2]; o[0] = f32x16{}; o[1] = f32x16{};
    s16x4 qx = make_qx(fq2, hi);
    const f32x16 zero16 = f32x16{};
    const int qrel = wid * QBLK + r32;
#define CMASK(P0, P1, t) do { int jb_ = (t) - (NT - 4); if (jb_ >= 0) cmask(P0, P1, jb_, qrel, hi); } while (0)
    bool resc = false;
#define START(P0, P1) do { const float rm = rowmax(P0, P1); resc = false; \
    { const float dl = rm; mhat = fadd_s(mhat, dl); \
      _Pragma("unroll") for (int r = 0; r < 16; ++r) { P0[r] = fsub_s(P0[r], dl); P1[r] = fsub_s(P1[r], dl); } \
      qx = make_qx(fq2 - mhat, hi); asm volatile("" : "+v"(qx)); } \
    _Pragma("unroll") for (int r = 0; r < 16; ++r) P0[r] = __builtin_amdgcn_exp2f(P0[r]); } while (0)
#define RESC() do { if (resc) { asm volatile("s_waitcnt lgkmcnt(0)" ::: "memory"); \
      _Pragma("unroll") for (int d_ = 0; d_ < 2; ++d_) _Pragma("unroll") for (int r = 0; r < 16; ++r) o[d_][r] *= wsf[crow(r, hi)]; } } while (0)
    f32x16 pA0, pA1, pB0, pB1;
    int sl_prev = 0, sl_cur = 0, sl_next = SLOTB;
#define ROT() do { sl_prev = sl_cur; sl_cur = sl_next; sl_next = (sl_next == (NSLOT - 1) * SLOTB) ? 0 : sl_next + SLOTB; } while (0)
    DMA_K(2, 2 * SLOTB);
    WAIT_BAR(5);
    kload8(kf, kp0); xload2(kx, xp0);
    pA0 = MF8(kx[0], qx, zero16); pA1 = MF8(kx[1], qx, zero16);
#pragma unroll
    for (int d0 = 0; d0 < 4; ++d0) { pA0 = MF16(kf[2 * d0], qr[d0], pA0); pA1 = MF16(kf[2 * d0 + 1], qr[d0], pA1); }
    asm volatile("s_nop 15\n\ts_nop 7" : "+v"(pA0), "+v"(pA1)); CMASK(pA0, pA1, 0);
    START(pA0, pA1);
    _Pragma("unroll") for (int r = 0; r < 16; ++r) pA1[r] = __builtin_amdgcn_exp2f(pA1[r]);
    WAIT_BAR(0);
    DMA_K(3, 0); DMA_V(1, SLOTB);
    ROT();
    kload8(kf, kp0 + sl_cur); xload2(kx, xp0 + sl_cur);
    WAIT_BAR(3);
    s16x4 vlo[8], vhi[8]; u32x4 pw0, pw1, pw2, pw3;
#define PKW(P, B) cvtpk_s(P[B], P[B + 1])
#define PAF(k) __builtin_bit_cast(bf16x8, pw##k)
#define VFR(i) (bf16x8){vlo[i][0], vlo[i][1], vlo[i][2], vlo[i][3], vhi[i][0], vhi[i][1], vhi[i][2], vhi[i][3]}
#define PIN(x) asm volatile("" : "+v"(x))
#define MX3(a, b, c) __builtin_fmaxf(__builtin_fmaxf((a), (b)), (c))
#define GAPA(MF, A0, A1, A2, A3, W0, W1, PW) do { MF; sacc += A0; sacc += A1; sacc += A2; sacc += A3; PIN(sacc); W0; W1; PIN(PW); SBAR(); } while (0)
#define EX(v) __builtin_amdgcn_exp2f(v)
#define GAPB(MF, X, B) do { MF; X[B] = EX(X[B]); X[B + 1] = EX(X[B + 1]); X[B + 2] = EX(X[B + 2]); X[B + 3] = EX(X[B + 3]); PIN(X); SBAR(); } while (0)
#define VRD(i) do { vlo[i] = vtr(vp_ + (((i) >> 2) * 4096 + ((i) & 3) * 1024)); vhi[i] = vtr(vp_ + (((i) >> 2) * 4096 + ((i) & 3) * 1024 + 512)); } while (0)
#define KRD(G, j) do { if (G) { kload2(kf, kp0 + sl_next, j); SBAR(); } } while (0)
#define XRD(G) do { if (G) { xload2(kx, xp0 + sl_next); SBAR(); } } while (0)
#define STEP(C0, C1, P0, P1, t, GK, GV, GL) do { SBAR(); \
    const lds_cptr vp_ = vp0 + sl_prev; \
    C0 = MF8(kx[0], qx, zero16); C1 = MF8(kx[1], qx, zero16); SBAR(); \
    VRD(0); SBAR(); float sacc = (P0[0] + P0[1]); \
    GAPA(C0 = MF16(kf[0], qr[0], C0), P0[2], P0[3], P0[4], P0[5],     pw0[0] = PKW(P0, 0), pw0[1] = PKW(P0, 2), pw0); \
    VRD(4); SBAR(); GAPA(C1 = MF16(kf[1], qr[0], C1), P0[6], P0[7], P0[8], P0[9],     pw0[2] = PKW(P0, 4), pw0[3] = PKW(P0, 6), pw0); \
    VRD(1); SBAR(); GAPA(C0 = MF16(kf[2], qr[1], C0),   P0[10], P0[11], P0[12], P0[13], pw1[0] = PKW(P0, 8), pw1[1] = PKW(P0, 10), pw1); \
    VRD(5); SBAR(); GAPA(C1 = MF16(kf[3], qr[1], C1),   P0[14], P0[15], P1[0], P1[1],   pw1[2] = PKW(P0, 12), pw1[3] = PKW(P0, 14), pw1); \
    VRD(2); SBAR(); GAPA(C0 = MF16(kf[4], qr[2], C0),   P1[2], P1[3], P1[4], P1[5],     pw2[0] = PKW(P1, 0), pw2[1] = PKW(P1, 2), pw2); \
    VRD(6); SBAR(); GAPA(C1 = MF16(kf[5], qr[2], C1),   P1[6], P1[7], P1[8], P1[9],     pw2[2] = PKW(P1, 4), pw2[3] = PKW(P1, 6), pw2); \
    VRD(3); SBAR(); GAPA(C0 = MF16(kf[6], qr[3], C0),   P1[10], P1[11], P1[12], P1[13], pw3[0] = PKW(P1, 8), pw3[1] = PKW(P1, 10), pw3); \
    VRD(7); SBAR(); GAPA(C1 = MF16(kf[7], qr[3], C1),   P1[14], P1[15], 0.f, 0.f,       pw3[2] = PKW(P1, 12), pw3[3] = PKW(P1, 14), pw3); \
    l_reg += sacc; \
    if (GK) { DMA_K((t) + 3, sl_cur); } if (GV) { DMA_V((t) + 1, sl_next); } \
    CMASK(C0, C1, t); \
    { float a = MX3(C0[0], C0[1], C1[0]), b_ = MX3(C0[2], C0[3], C1[1]); a = MX3(a, C1[2], C1[3]); \
      _Pragma("unroll") for (int r = 4; r < 16; r += 4) { a = MX3(a, C0[r], C0[r + 1]); b_ = MX3(b_, C0[r + 2], C0[r + 3]); a = MX3(a, C1[r], C1[r + 1]); b_ = MX3(b_, C1[r + 2], C1[r + 3]); } \
      float rm = __builtin_fmaxf(a, b_); { auto rr = __builtin_amdgcn_permlane32_swap(__float_as_uint(rm), __float_as_uint(rm), false, false); rm = __builtin_fmaxf(__uint_as_float(rr[0]), __uint_as_float(rr[1])); } \
      resc = false; \
      if (__builtin_expect(__any(rm > (float)THRL), 0)) { const float dl = __builtin_fmaxf(rm, 0.f); mhat += dl; \
        _Pragma("unroll") for (int r = 0; r < 16; ++r) { C0[r] -= dl; C1[r] -= dl; } \
        qx = make_qx(fq2 - mhat, hi); asm volatile("" : "+v"(qx)); \
        const float f = __builtin_amdgcn_exp2f(-dl); l_reg *= f; if (hi == 0) wsf[r32] = f; resc = true; } } \
    SBAR(); \
    GAPB(o[0] = MF16(PAF(0), VFR(0), o[0]), C0, 0); \
    GAPB(o[1] = MF16(PAF(0), VFR(4), o[1]), C0, 4); \
    KRD(GL, 0); GAPB(o[0] = MF16(PAF(1), VFR(1), o[0]), C0, 8); \
    KRD(GL, 1); GAPB(o[1] = MF16(PAF(1), VFR(5), o[1]), C0, 12); \
    KRD(GL, 2); GAPB(o[0] = MF16(PAF(2), VFR(2), o[0]), C1, 0); \
    KRD(GL, 3); GAPB(o[1] = MF16(PAF(2), VFR(6), o[1]), C1, 4); \
    XRD(GL); GAPB(o[0] = MF16(PAF(3), VFR(3), o[0]), C1, 8); \
    GAPB(o[1] = MF16(PAF(3), VFR(7), o[1]), C1, 12); \
    } while (0)
    int t = 1;
#undef CMASK
#define CMASK(P0, P1, t) do { } while (0)
    for (; t + 5 < NT; t += 2) {
        STEP(pB0, pB1, pA0, pA1, t, true, true, true);     WAIT_BAR(3); RESC(); ROT();
        STEP(pA0, pA1, pB0, pB1, t + 1, true, true, true); WAIT_BAR(3); RESC(); ROT();
    }
#undef CMASK
#define CMASK(P0, P1, t) do { int jb_ = (t) - (NT - 4); if (jb_ >= 0) cmask(P0, P1, jb_, qrel, hi); } while (0)
#define ENDW(tt) do { if ((tt) + 3 < NT) { WAIT_BAR(3); } else if ((tt) + 2 < NT) { WAIT_BAR(1); } else { WAIT_BAR(0); } } while (0)
    for (; t + 1 < NT; t += 2) {
        STEP(pB0, pB1, pA0, pA1, t, (t + 3 < NT), (t + 1 < NT), (t + 1 < NT));         ENDW(t);     RESC(); ROT();
        STEP(pA0, pA1, pB0, pB1, t + 1, (t + 4 < NT), (t + 2 < NT), (t + 2 < NT));     ENDW(t + 1); RESC(); ROT();
    }
    STEP(pB0, pB1, pA0, pA1, NT - 1, false, false, false); RESC();
    { float sacc = pB0[0] + pB0[1]; _Pragma("unroll") for (int r = 2; r < 16; ++r) sacc += pB0[r]; _Pragma("unroll") for (int r = 0; r < 16; ++r) sacc += pB1[r]; l_reg += sacc;
      pw0 = (u32x4){PKW(pB0, 0), PKW(pB0, 2), PKW(pB0, 4), PKW(pB0, 6)}; pw1 = (u32x4){PKW(pB0, 8), PKW(pB0, 10), PKW(pB0, 12), PKW(pB0, 14)};
      pw2 = (u32x4){PKW(pB1, 0), PKW(pB1, 2), PKW(pB1, 4), PKW(pB1, 6)}; pw3 = (u32x4){PKW(pB1, 8), PKW(pB1, 10), PKW(pB1, 12), PKW(pB1, 14)};
      SBAR(); pv(o, vb0 + sl_cur, PAF(0), PAF(1), PAF(2), PAF(3)); }
#undef PKW
#undef PAF
#undef VFR
#undef PIN
#undef MX3
#undef GAPA
#undef GAPB
#undef EX
#undef VRD
#undef KRD
#undef XRD
#undef STEP
#undef ENDW
    { auto rr = __builtin_amdgcn_permlane32_swap(__float_as_uint(l_reg), __float_as_uint(l_reg), false, false); l_reg = __uint_as_float(rr[0]) + __uint_as_float(rr[1]); }
    if (hi == 0) wsf[32 + r32] = l_reg; asm volatile("s_waitcnt lgkmcnt(0)" ::: "memory");
    float rli[16];
#pragma unroll
    for (int r = 0; r < 16; ++r) rli[r] = __builtin_amdgcn_rcpf(wsf[32 + crow(r, hi)]);
    { LAS float* stg = (LAS float*)(shm + LDS_OST + wid * OST_BYTES);
#pragma unroll
      for (int r = 0; r < 16; ++r) { const int orow = crow(r, hi);
#pragma unroll
          for (int d0 = 0; d0 < 2; ++d0) stg[orow * OST_STRIDE + d0 * 32 + r32] = o[d0][r] * rli[r]; }
      asm volatile("s_waitcnt lgkmcnt(0)" ::: "memory");
      bf16raw* Ow = MG + (rowbase + q0 + wid * QBLK) * DM + h * HD;
#pragma unroll
      for (int i = 0; i < 4; ++i) { const int row = i * 8 + (lane >> 3), c8 = (lane & 7) * 8;
          const v4f a = *(const LAS v4f*)(stg + row * OST_STRIDE + c8), c = *(const LAS v4f*)(stg + row * OST_STRIDE + c8 + 4);
          float ss = (a[0] * a[0] + a[1] * a[1]) + (a[2] * a[2] + a[3] * a[3]) + (c[0] * c[0] + c[1] * c[1]) + (c[2] * c[2] + c[3] * c[3]);
          ss = sum8_dpp(ss);
          const float rs = 1.0f / sqrtf(ss * (1.0f / 64.0f) + RMS_EPS);
          const v4f g0 = *(const v4f*)(gn_a + h * HD + c8), g1 = *(const v4f*)(gn_a + h * HD + c8 + 4);
          u32x4 w; w.x = cvtpk_s(a[0] * rs * g0[0], a[1] * rs * g0[1]); w.y = cvtpk_s(a[2] * rs * g0[2], a[3] * rs * g0[3]);
          w.z = cvtpk_s(c[0] * rs * g1[0], c[1] * rs * g1[1]); w.w = cvtpk_s(c[2] * rs * g1[2], c[3] * rs * g1[3]);
          *(u32x4*)(Ow + (long)row * DM + c8) = w; } }
    asm volatile("s_waitcnt lgkmcnt(0)\n\ts_barrier" ::: "memory");
#undef DMA_K
#undef DMA_V
#undef CMASK
#undef START
#undef RESC
#undef ROT
}
#undef SBAR
#undef WAIT_BAR
#undef MF16
#undef MF8
}

namespace dil {
typedef short bf16x8 __attribute__((ext_vector_type(8)));
typedef short s16x4 __attribute__((ext_vector_type(4)));
typedef float f32x16 __attribute__((ext_vector_type(16)));
constexpr int LDS_K = 0, LDS_V = 49152, LDS_BYTES = 98304;
constexpr int N_UNITS = NB * NH * 48;
__device__ __forceinline__ int crow(int r, int hi) { return (r & 3) + 8 * (r >> 2) + 4 * hi; }
__device__ __forceinline__ void glds16(const void* sbase, unsigned voff, unsigned lds_dst) { unsigned keep;
    asm volatile("s_mov_b32 %0, m0\n\ts_mov_b32 m0, %3\n\ts_nop 0\n\tglobal_load_lds_dwordx4 %1, %2\n\ts_mov_b32 m0, %0" : "=&s"(keep) : "v"(voff), "s"(sbase), "s"(lds_dst) : "memory"); }
typedef float f32x2_t __attribute__((ext_vector_type(2))); typedef __bf16 bf16x2_t __attribute__((ext_vector_type(2)));
__device__ __forceinline__ unsigned cvtpk_s(float lo, float hi) { f32x2_t v = {lo, hi}; bf16x2_t b = __builtin_convertvector(v, bf16x2_t); return __builtin_bit_cast(unsigned, b); }
typedef __attribute__((address_space(3))) const char* lds_cptr;
typedef short v4i16_t __attribute__((ext_vector_type(4)));
__device__ __forceinline__ s16x4 vtr(lds_cptr p) { return __builtin_bit_cast(s16x4, __builtin_amdgcn_ds_read_tr16_b64_v4i16((__attribute__((address_space(3))) v4i16_t*)p)); }
#define DMF16(a, b, c) __builtin_amdgcn_mfma_f32_32x32x16_bf16(a, b, c, 0, 0, 0)
struct DU { int b, h, pat, d, cls, i0; };
__device__ __forceinline__ DU decode(int u) { DU U; const int bh = u / 48, r = u % 48; U.b = bh >> 3; U.h = bh & 7;
    if (r < 16) { U.pat = 0; U.d = 1; U.cls = 0; U.i0 = 256 * r; }
    else if (r < 32) { U.pat = 1; U.d = 4; U.cls = (r - 16) >> 2; U.i0 = 256 * ((r - 16) & 3); }
    else { U.pat = 2; U.d = 16; U.cls = r - 32; U.i0 = 0; }
    return U; }
__device__ __forceinline__ void issue_K(const DU& U, const bf16raw* Z, unsigned lds0, int wid, int lane) {
    const bf16raw* base = Z + ((long)U.b * SEQ + U.cls) * NZ + ZKB + U.h * HD; const unsigned stride = (unsigned)U.d * NZ * 2u;
#pragma unroll
    for (int t = 0; t < 6; ++t) { int sp = U.i0 - 128 + 64 * t + lane; sp = sp < 0 ? 0 : sp;
        glds16(base, (unsigned)sp * stride + (unsigned)wid * 16u, (unsigned)__builtin_amdgcn_readfirstlane(lds0 + LDS_K + t * 8192 + wid * 1024)); }
}
__device__ __forceinline__ void issue_V(const DU& U, const bf16raw* Z, unsigned lds0, int wid, int lane) {
    const bf16raw* base = Z + ((long)U.b * SEQ + U.cls) * NZ + ZVB + U.h * HD; const unsigned stride = (unsigned)U.d * NZ * 2u;
#pragma unroll
    for (int t = 0; t < 6; ++t) { int sp = U.i0 - 128 + 64 * t + 16 * (wid & 3) + (lane >> 2); sp = sp < 0 ? 0 : sp;
        glds16(base, (unsigned)sp * stride + (unsigned)(((wid >> 2) * 32 + (lane & 3) * 8) * 2), (unsigned)__builtin_amdgcn_readfirstlane(lds0 + LDS_V + t * 8192 + wid * 1024)); }
}
__device__ __forceinline__ void load_q(bf16x8* q, const DU& U, const bf16raw* Z, int wid, int r32, int hi) {
    const bf16raw* qp = Z + ((long)U.b * SEQ + U.cls + (long)(U.i0 + wid * 32 + r32) * U.d) * NZ + ZQB + U.h * HD + hi * 8;
#pragma unroll
    for (int d0 = 0; d0 < 4; ++d0) q[d0] = *(const bf16x8*)(qp + d0 * 16);
}
__device__ __forceinline__ void dil_phase(int u_lo, int u_hi, const bf16raw* __restrict__ Z, bf16raw* OP, float* LSE, LAS unsigned char* shm, const int tid) {
    if (u_lo >= u_hi) return;
    const int lane = tid & 63, r32 = lane & 31, hi = lane >> 5; const int wid = __builtin_amdgcn_readfirstlane(tid >> 6);
    const unsigned lds0 = (unsigned)(uintptr_t)shm; const lds_cptr shm3 = (lds_cptr)shm;
    const int t0 = wid >> 1, lo = 32 * (wid & 1) + r32;
    const lds_cptr kp0 = shm3 + LDS_K + t0 * 8192 + hi * 1024 + r32 * 16;
    const lds_cptr vp0 = shm3 + LDS_V + t0 * 8192 + ((lane >> 4) & 1) * 32 + (lane & 3) * 8 + (4 * hi + ((lane & 15) >> 2)) * 64;
    DU U = decode(u_lo);
    bf16x8 qr[4], qn[4];
    load_q(qr, U, Z, wid, r32, hi);
#pragma unroll
    for (int d0 = 0; d0 < 4; ++d0) asm volatile("" : "+v"(qr[d0]));
    issue_K(U, Z, lds0, wid, lane); issue_V(U, Z, lds0, wid, lane);
    v2u po[8]; float lse_prev = 0.f; long grow_prev = 0; int pat_prev = 0, h_prev = 0; bool have_prev = false;
#pragma unroll
    for (int i = 0; i < 8; ++i) po[i] = (v2u){0u, 0u};
    for (int u = u_lo; u < u_hi; ++u) {
        const bool has_next = (u + 1 < u_hi);
        DU Un = U; if (has_next) Un = decode(u + 1);
        asm volatile("s_waitcnt vmcnt(6)\n\ts_barrier" ::: "memory");
        if (has_next) load_q(qn, Un, Z, wid, r32, hi);
        if (have_prev) {
            bf16raw* op = OP + ((size_t)pat_prev * MTOK + grow_prev) * 512 + h_prev * HD + 4 * hi;
#pragma unroll
            for (int i = 0; i < 8; ++i) *(v2u*)(op + (i >> 2) * 32 + (i & 3) * 8) = po[i];
            if (hi == 0) LSE[((size_t)pat_prev * MTOK + grow_prev) * NH + h_prev] = lse_prev;
        }
        f32x16 s[3][2];
#pragma unroll
        for (int j = 0; j < 3; ++j) {
            bf16x8 kf[8];
#pragma unroll
            for (int c = 0; c < 4; ++c) { kf[2 * c] = *(const __attribute__((address_space(3))) bf16x8*)(kp0 + j * 8192 + c * 2048); kf[2 * c + 1] = *(const __attribute__((address_space(3))) bf16x8*)(kp0 + j * 8192 + c * 2048 + 512); }
            s[j][0] = DMF16(kf[0], qr[0], (f32x16){}); s[j][1] = DMF16(kf[1], qr[0], (f32x16){});
#pragma unroll
            for (int c = 1; c < 4; ++c) { s[j][0] = DMF16(kf[2 * c], qr[c], s[j][0]); s[j][1] = DMF16(kf[2 * c + 1], qr[c], s[j][1]); }
        }
        const float NEGI = -INFINITY;
#pragma unroll
        for (int r = 0; r < 16; ++r) { const int x = crow(r, hi);
            if (x < lo) s[0][0][r] = NEGI; if (x + 32 < lo) s[0][1][r] = NEGI;
            if (x > lo) s[2][0][r] = NEGI; if (x + 32 > lo) s[2][1][r] = NEGI; }
        if (U.i0 == 0 && t0 < 2) {
#pragma unroll
            for (int r = 0; r < 16; ++r) { s[0][0][r] = NEGI; s[0][1][r] = NEGI; if (t0 == 0) { s[1][0][r] = NEGI; s[1][1][r] = NEGI; } } }
        float m = NEGI;
#pragma unroll
        for (int j = 0; j < 3; ++j)
#pragma unroll
            for (int r = 0; r < 16; ++r) m = fmaxf(m, fmaxf(s[j][0][r], s[j][1][r]));
        { auto rr = __builtin_amdgcn_permlane32_swap(__float_as_uint(m), __float_as_uint(m), false, false); m = fmaxf(__uint_as_float(rr[0]), __uint_as_float(rr[1])); }
        float l = 0.f;
#pragma unroll
        for (int j = 0; j < 3; ++j)
#pragma unroll
            for (int r = 0; r < 16; ++r) { s[j][0][r] = __builtin_amdgcn_exp2f(s[j][0][r] - m); s[j][1][r] = __builtin_amdgcn_exp2f(s[j][1][r] - m); l += s[j][0][r] + s[j][1][r]; }
        { auto rr = __builtin_amdgcn_permlane32_swap(__float_as_uint(l), __float_as_uint(l), false, false); l = __uint_as_float(rr[0]) + __uint_as_float(rr[1]); }
        v4u pw[3][4];
#pragma unroll
        for (int j = 0; j < 3; ++j)
#pragma unroll
            for (int k = 0; k < 4; ++k) { const f32x16& ps = s[j][k >> 1]; const int b0 = (k & 1) * 8;
                pw[j][k] = (v4u){cvtpk_s(ps[b0], ps[b0 + 1]), cvtpk_s(ps[b0 + 2], ps[b0 + 3]), cvtpk_s(ps[b0 + 4], ps[b0 + 5]), cvtpk_s(ps[b0 + 6], ps[b0 + 7])}; }
        asm volatile("s_waitcnt vmcnt(0) lgkmcnt(0)\n\ts_barrier" ::: "memory");
        if (has_next) {
#pragma unroll
            for (int d0 = 0; d0 < 4; ++d0) asm volatile("" : "+v"(qn[d0]));
            issue_K(Un, Z, lds0, wid, lane);
        }
        f32x16 o[2]; o[0] = (f32x16){}; o[1] = (f32x16){};
#pragma unroll
        for (int j = 0; j < 3; ++j) {
            const lds_cptr vp = vp0 + j * 8192;
#pragma unroll
            for (int i = 0; i < 8; ++i) { const int d0 = i >> 2, ks = i & 3;
                const s16x4 a = vtr(vp + d0 * 4096 + ks * 1024), b2 = vtr(vp + d0 * 4096 + ks * 1024 + 512);
                const bf16x8 vf = (bf16x8){a[0], a[1], a[2], a[3], b2[0], b2[1], b2[2], b2[3]};
                o[d0] = DMF16(vf, __builtin_bit_cast(bf16x8, pw[j][ks]), o[d0]); }
        }
        asm volatile("s_waitcnt lgkmcnt(0)\n\ts_barrier" ::: "memory");
        if (has_next) issue_V(Un, Z, lds0, wid, lane);
        const float inv = 1.0f / l;
#pragma unroll
        for (int i = 0; i < 8; ++i) { const int d0 = i >> 2, g = i & 3;
            po[i] = (v2u){cvtpk_s(o[d0][4 * g] * inv, o[d0][4 * g + 1] * inv), cvtpk_s(o[d0][4 * g + 2] * inv, o[d0][4 * g + 3] * inv)}; }
        lse_prev = m + __builtin_amdgcn_logf(l);
        grow_prev = (long)U.b * SEQ + U.cls + (long)(U.i0 + wid * 32 + r32) * U.d; pat_prev = U.pat; h_prev = U.h; have_prev = true;
        if (has_next) {
#pragma unroll
            for (int d0 = 0; d0 < 4; ++d0) qr[d0] = qn[d0];
            U = Un; }
    }
    { bf16raw* op = OP + ((size_t)pat_prev * MTOK + grow_prev) * 512 + h_prev * HD + 4 * hi;
#pragma unroll
      for (int i = 0; i < 8; ++i) *(v2u*)(op + (i >> 2) * 32 + (i & 3) * 8) = po[i];
      if (hi == 0) LSE[((size_t)pat_prev * MTOK + grow_prev) * NH + h_prev] = lse_prev; }
    asm volatile("s_waitcnt vmcnt(0) lgkmcnt(0)\n\ts_barrier" ::: "memory");
}
#undef DMF16
}
#define XB_TMO      128
#define XB_XCNT(j)  (256  + 64 * (j))
#define XB_XSUB(j)  (1280 + 64 * (j))
#define XB_XGEN(j)  (2304 + 64 * (j))
#define XB_TOP      3328
#define XB_TOPGEN   3392
#define XCD_BAR_WORDS 3456
#define XB_SPIN_CAP (1u << 18)

__device__ __forceinline__ unsigned xb_ld(unsigned* p)              { return __hip_atomic_load(p, __ATOMIC_RELAXED, __HIP_MEMORY_SCOPE_AGENT); }
__device__ __forceinline__ unsigned xb_add(unsigned* p, unsigned v) { return __hip_atomic_fetch_add(p, v, __ATOMIC_RELAXED, __HIP_MEMORY_SCOPE_AGENT); }
__device__ __forceinline__ unsigned xb_xcc_id() { return (unsigned)__builtin_amdgcn_s_getreg((3 << 11) | 20) & 0xFu; }
#define XB_SPIN(cond, bar) do { unsigned _sp = 0; while (cond) { __builtin_amdgcn_s_sleep(1); \
    if ((++_sp & 255u) == 0u) { if (xb_ld(&(bar)[XB_TMO])) break; if (_sp > XB_SPIN_CAP) { atomicAdd(&(bar)[XB_TMO], 1u); break; } } } } while (0)

struct XcdBarrier {
    unsigned* bar; unsigned x;
    volatile LAS unsigned* st;
};

__device__ __forceinline__ XcdBarrier xcd_barrier_post(unsigned* bar, volatile LAS unsigned* st, const int tid) {
    XcdBarrier b; b.bar = bar; b.x = xb_xcc_id(); b.st = st;
    if (tid == 0) (void)xb_add(&bar[XB_XCNT(b.x)], 1u);
    return b;
}
__device__ __forceinline__ void xcd_barrier_complete(unsigned* bar, unsigned x, unsigned& nloc, unsigned& nx) {
    const unsigned G = gridDim.x * gridDim.y * gridDim.z;
    unsigned sum, cnt, mine, sp = 0u;
    for (;;) {
        sum = 0u; cnt = 0u; mine = 0u;
#pragma unroll
        for (unsigned j = 0; j < 16; ++j) { const unsigned c = xb_ld(&bar[XB_XCNT(j)]); sum += c; cnt += (c > 0u) ? 1u : 0u; mine = (j == x) ? c : mine; }
        if (sum == G) break;
        __builtin_amdgcn_s_sleep(1);
        if ((++sp & 255u) == 0u) { if (xb_ld(&bar[XB_TMO])) break; if (sp > XB_SPIN_CAP) { atomicAdd(&bar[XB_TMO], 1u); break; } }
    }
    nloc = mine > 0u ? mine : 1u; nx = cnt > 0u ? cnt : 1u;
}

__device__ __forceinline__ void xcd_barrier(const XcdBarrier& b, const int tid) {
    asm volatile("s_waitcnt vmcnt(0)" ::: "memory");
    __syncthreads();
    if (tid == 0) {
        unsigned* bar = b.bar;
        __builtin_amdgcn_s_waitcnt(0);
        unsigned nloc = b.st[0], nx = b.st[1];
        if (nloc == 0u) { xcd_barrier_complete(bar, b.x, nloc, nx); b.st[0] = nloc; b.st[1] = nx; }
        const unsigned old = xb_add(&bar[XB_XSUB(b.x)], 1u);
        const unsigned gen = old / nloc;
        if (old + 1u == (gen + 1u) * nloc) {
            __builtin_amdgcn_fence(__ATOMIC_RELEASE, "agent");
            asm volatile("s_waitcnt vmcnt(0)" ::: "memory");
            const unsigned og = xb_add(&bar[XB_TOP], 1u);
            const unsigned tg = og / nx;
            if (og + 1u == (tg + 1u) * nx) xb_add(&bar[XB_TOPGEN], 1u);
            else XB_SPIN(xb_ld(&bar[XB_TOPGEN]) == tg, bar);
            __builtin_amdgcn_fence(__ATOMIC_ACQUIRE, "agent");
            xb_add(&bar[XB_XGEN(b.x)], 1u);
            asm volatile("s_waitcnt vmcnt(0)" ::: "memory");
        } else {
            XB_SPIN(xb_ld(&bar[XB_XGEN(b.x)]) == gen, bar);
            __builtin_amdgcn_fence(__ATOMIC_ACQUIRE, "agent");
            asm volatile("s_waitcnt vmcnt(0)" ::: "memory");
        }
    }
    __syncthreads();
}

constexpr size_t MiB = 1u << 20;
#define RLX_AGENT __ATOMIC_RELAXED, __HIP_MEMORY_SCOPE_AGENT
constexpr size_t WS_ADA = 1 * MiB;
constexpr size_t WS_WIN = 2 * MiB, WS_WOUT = 9 * MiB, WS_WUP = 12 * MiB, WS_WDN = 24 * MiB;
constexpr size_t WS_FLOC = 30 * MiB, WS_FABS = 32 * MiB;
constexpr size_t WS_CT = 34 * MiB;
constexpr size_t WS_CS = 36 * MiB;
constexpr size_t WS_LSE = 40 * MiB;
constexpr size_t WS_ST1 = 48 * MiB;
constexpr size_t WS_KXT = 52 * MiB;
constexpr size_t WS_H = 64 * MiB;
constexpr size_t WS_Z = 192 * MiB;
constexpr size_t WS_OP = 576 * MiB;
constexpr size_t WS_MG = 768 * MiB;
constexpr size_t WS_G = 192 * MiB;
constexpr size_t WS_ULAST = 544 * MiB, WS_YFIRST = 576 * MiB;
constexpr size_t WS_END = 896 * MiB;

constexpr int LDS_BYTES = 147456;
constexpr int RING_BYTES = 131072;

struct Params {
    const float *x, *c; const int* pos; const float *w_ada, *b_ada, *w_in, *b_fgate, *gn_a, *gn_b, *w_out, *ln1_g, *ln1_b, *w_up, *conv_w, *conv_b, *w_down, *ln2_g, *ln2_b;
    float* out; unsigned char* ws; int ph_lo, ph_hi;
};

__device__ __forceinline__ int src_in(int n) {
    if (n < 1536) return n;
    const int s = n & 63; int sd = s;
    if (n < 2560 && s < 16) { const int a = s >> 2; sd = ((((a & 1) << 1) | (a >> 1)) << 2) | (s & 3); }
    return n - s + sd + 8;
}
__device__ __forceinline__ int src_up(int n) { return DFF * ((n >> 7) & 1) + 128 * (n >> 8) + (n & 127); }
template <int MAP> __device__ __forceinline__ void transpose_item(const float* W, int ldw, int K, int N, bf16raw* WT, LAS float* scr, int item, int lane) {
    const int nblk = N / 32, kb = item / nblk, nb = item % nblk, k0 = 64 * kb, n0 = 32 * nb;
    const int nsrc = (MAP == 1) ? src_in(n0 + (lane & 31)) : (MAP == 2) ? src_up(n0 + (lane & 31)) : n0 + (lane & 31);
#pragma unroll 8
    for (int i = 0; i < 32; ++i) { const int kk = 2 * i + (lane >> 5); scr[kk * 33 + (lane & 31)] = W[(size_t)(k0 + kk) * ldw + nsrc]; }
    asm volatile("s_waitcnt lgkmcnt(0)" ::: "memory");
    const int c = lane & 7;
#pragma unroll
    for (int j = 0; j < 4; ++j) { const int n = (lane >> 3) + 8 * j; const LAS float* s = scr + (8 * c) * 33 + n;
        v4u o; o.x = pk2(s[0 * 33], s[1 * 33]); o.y = pk2(s[2 * 33], s[3 * 33]); o.z = pk2(s[4 * 33], s[5 * 33]); o.w = pk2(s[6 * 33], s[7 * 33]);
        *(v4u*)(WT + (size_t)(n0 + n) * K + k0 + 8 * c) = o; }
    asm volatile("s_waitcnt lgkmcnt(0)" ::: "memory");
}

__device__ __forceinline__ void phase_prologue(const Params& p, LAS unsigned char* lds, const int tid) {
    const int lane = tid & 63, wave = __builtin_amdgcn_readfirstlane(tid >> 6);
    float* ADA = (float*)(p.ws + WS_ADA);
    for (int task = blockIdx.x; task < 96; task += gridDim.x) {
        LAS float* scT = (LAS float*)lds;
        LAS float* red = (LAS float*)(lds + 65536);
        for (int i = tid; i < NB * DM; i += 512) { const int b = i >> 10, k = i & 1023; const float v = p.c[i]; scT[k * 16 + b] = v / (1.0f + __expf(-v)); }
        __syncthreads();
        const int col = task * 64 + lane;
        float acc[16];
#pragma unroll
        for (int b = 0; b < 16; ++b) acc[b] = 0.f;
#pragma unroll 4
        for (int kk = 0; kk < 128; ++kk) { const int k = wave * 128 + kk; const float wv = p.w_ada[(size_t)k * (6 * DM) + col];
#pragma unroll
            for (int q = 0; q < 4; ++q) { const v4f s4 = *(const LAS v4f*)(scT + k * 16 + 4 * q);
                acc[4 * q + 0] += s4[0] * wv; acc[4 * q + 1] += s4[1] * wv; acc[4 * q + 2] += s4[2] * wv; acc[4 * q + 3] += s4[3] * wv; } }
#pragma unroll
        for (int b = 0; b < 16; ++b) red[(wave * 16 + b) * 64 + lane] = acc[b];
        __syncthreads();
        for (int i = tid; i < 16 * 64; i += 512) { const int b = i >> 6, cl = i & 63; float s = p.b_ada[task * 64 + cl];
#pragma unroll
            for (int w = 0; w < 8; ++w) s += red[(w * 16 + b) * 64 + cl];
            ADA[(size_t)b * (6 * DM) + task * 64 + cl] = s; }
        __syncthreads();
    }
    LAS float* scr = (LAS float*)(lds + wave * 16384);
    const int gw = blockIdx.x * 8 + wave, NGW = gridDim.x * 8;
    constexpr int I_IN = (DM / 64) * (NZ / 32), I_OUT = (DM / 64) * (DM / 32), I_UP = (DM / 64) * (NUP / 32), I_DN = (DFF / 64) * (DM / 32);
    for (int it = gw; it < I_IN + I_OUT + I_UP + I_DN; it += NGW) {
        int r = it;
        if (r < I_IN) { transpose_item<1>(p.w_in, DIN, DM, NZ, (bf16raw*)(p.ws + WS_WIN), scr, r, lane); continue; } r -= I_IN;
        if (r < I_OUT) { transpose_item<0>(p.w_out, DM, DM, DM, (bf16raw*)(p.ws + WS_WOUT), scr, r, lane); continue; } r -= I_OUT;
        if (r < I_UP) { transpose_item<2>(p.w_up, NUP, DM, NUP, (bf16raw*)(p.ws + WS_WUP), scr, r, lane); continue; } r -= I_UP;
        transpose_item<0>(p.w_down, DM, DFF, DM, (bf16raw*)(p.ws + WS_WDN), scr, r, lane);
    }
}

__device__ __forceinline__ void phase_pre1(const Params& p, LAS unsigned char* lds, const int tid) {
    const int lane = tid & 63, wave = __builtin_amdgcn_readfirstlane(tid >> 6);
    const float* ADA = (const float*)(p.ws + WS_ADA);
    bf16raw* H = (bf16raw*)(p.ws + WS_H);
    float* FLOC = (float*)(p.ws + WS_FLOC); float* CT = (float*)(p.ws + WS_CT); float* CS = (float*)(p.ws + WS_CS);
    LAS float* lfs = (LAS float*)lds;
    float wf[4][4][8];
#pragma unroll
    for (int j = 0; j < 4; ++j)
#pragma unroll
        for (int e = 0; e < 4; ++e) { const float* wp = p.w_in + (size_t)(4 * lane + 256 * j + e) * DIN + 1536;
            const v4f a = *(const v4f*)wp, b = *(const v4f*)(wp + 4);
            wf[j][e][0] = a[0]; wf[j][e][1] = a[1]; wf[j][e][2] = a[2]; wf[j][e][3] = a[3]; wf[j][e][4] = b[0]; wf[j][e][5] = b[1]; wf[j][e][6] = b[2]; wf[j][e][7] = b[3]; }
    for (int chunk = blockIdx.x; chunk < MTOK / 256; chunk += gridDim.x) {
        const int b = chunk >> 4, t0 = (chunk & 15) * 256;
        v4f sc[4], sh[4];
#pragma unroll
        for (int j = 0; j < 4; ++j) { sh[j] = *(const v4f*)(ADA + (size_t)b * (6 * DM) + 4 * lane + 256 * j); sc[j] = *(const v4f*)(ADA + (size_t)b * (6 * DM) + DM + 4 * lane + 256 * j) + 1.0f; }
        for (int i = 0; i < 32; ++i) {
            const int rl = wave * 32 + i; const size_t row = (size_t)b * SEQ + t0 + rl;
            const v4f* xr = (const v4f*)(p.x + row * DM) + lane;
            float s[8];
#pragma unroll
            for (int hh = 0; hh < 8; ++hh) s[hh] = 0.f;
            unsigned long long* o8 = (unsigned long long*)(H + row * DM) + lane;
#pragma unroll
            for (int j = 0; j < 4; ++j) { const v4f hv = xr[64 * j] * sc[j] + sh[j];
                o8[64 * j] = (unsigned long long)pk2(hv[0], hv[1]) | ((unsigned long long)pk2(hv[2], hv[3]) << 32);
#pragma unroll
                for (int e = 0; e < 4; ++e)
#pragma unroll
                    for (int hh = 0; hh < 8; ++hh) s[hh] += hv[e] * wf[j][e][hh]; }
#pragma unroll
            for (int hh = 0; hh < 8; ++hh) s[hh] = wave_sum(s[hh]);
            if (lane < 8) { float v = s[0];
#pragma unroll
                for (int hh = 1; hh < 8; ++hh) v = (lane == hh) ? s[hh] : v;
                v += p.b_fgate[lane];
                lfs[rl * 8 + lane] = fminf(v, 0.f) - log1pf(expf(-fabsf(v))); }
        }
        for (int i = tid; i < 256 * 8; i += 512) { const int rl = i >> 3, fi = i & 7; const size_t row = (size_t)b * SEQ + t0 + rl;
            const float fr = (fi == 0) ? 1.0f : (fi == 1) ? 0.1939227432012558f : (fi == 2) ? 0.03760603070259094f : (fi == 3) ? 0.007292664609849453f : (fi == 4) ? 0.0014142135623842478f
                           : (fi == 5) ? 0.00027424818836152554f : (fi == 6) ? 5.3182957344688475e-05f : 1.0313385246263351e-05f;
            double rev = (double)p.pos[row] * (double)fr * 0.15915494309189535; rev -= __builtin_floor(rev);
            const float rf = (float)rev;
            CS[row * 16 + fi] = __builtin_amdgcn_cosf(rf); CS[row * 16 + 8 + fi] = __builtin_amdgcn_sinf(rf); }
        __syncthreads();
        { const int hh = wave; float a0 = lfs[(4 * lane + 0) * 8 + hh], a1 = lfs[(4 * lane + 1) * 8 + hh], a2 = lfs[(4 * lane + 2) * 8 + hh], a3 = lfs[(4 * lane + 3) * 8 + hh];
          a1 += a0; a2 += a1; a3 += a2; float run = a3;
#pragma unroll
          for (int o = 1; o < 64; o <<= 1) { const float v = __shfl_up(run, o); if (lane >= o) run += v; }
          const float excl = run - a3;
          *(v4f*)(FLOC + (size_t)(b * NH + hh) * SEQ + t0 + 4 * lane) = (v4f){a0 + excl, a1 + excl, a2 + excl, a3 + excl};
          if (lane == 63) CT[(b * NH + hh) * 16 + (chunk & 15)] = run; }
        __syncthreads();
    }
}
__device__ __forceinline__ void phase_fabs(const Params& p, const int tid) {
    const float* FLOC = (const float*)(p.ws + WS_FLOC); const float* CT = (const float*)(p.ws + WS_CT); float* FABS = (float*)(p.ws + WS_FABS);
    for (int i = blockIdx.x * 512 + tid; i < NB * NH * SEQ; i += gridDim.x * 512) {
        const int bh = i >> 12, t = i & 4095, ch = t >> 8; float off = 0.f;
        for (int c2 = 0; c2 < ch; ++c2) off += CT[bh * 16 + c2];
        const float F = FLOC[i] + off; FABS[i] = F;
        const float bq = -F * LOG2E; const unsigned w1 = f2bf(bq); const float r1 = bq - __builtin_bit_cast(float, w1 << 16); const unsigned w2 = f2bf(r1);
        const float r2 = r1 - __builtin_bit_cast(float, w2 << 16); const unsigned w3 = f2bf(r2);
        unsigned char* img = p.ws + WS_KXT + ((size_t)bh * (SEQ / 64) + (t >> 6)) * 1024 + (t & 63) * 8;
        *(v2u*)img = (v2u){0x3f803f80u, 0x3f80u | (w1 << 16)}; *(v2u*)(img + 512) = (v2u){w2 | (w3 << 16), 0u}; }
}
__device__ __forceinline__ void phase_merge(const Params& p, const int tid) {
    const int lane = tid & 63, wave = tid >> 6;
    const bf16raw* OP = (const bf16raw*)(p.ws + WS_OP); const float* LSE = (const float*)(p.ws + WS_LSE); bf16raw* MG = (bf16raw*)(p.ws + WS_MG);
    const int hh = lane >> 3;
    const v4f g0 = *(const v4f*)(p.gn_b + lane * 8), g1 = *(const v4f*)(p.gn_b + lane * 8 + 4);
    for (size_t row = (size_t)blockIdx.x * 8 + wave; row < (size_t)MTOK; row += (size_t)gridDim.x * 8) {
        float ls[3]; v4u w[3];
#pragma unroll
        for (int q = 0; q < 3; ++q) { ls[q] = LSE[((size_t)q * MTOK + row) * NH + hh]; w[q] = *(const v4u*)(OP + ((size_t)q * MTOK + row) * 512 + lane * 8); }
        const float mx = fmaxf(ls[0], fmaxf(ls[1], ls[2]));
        float e[3]; e[0] = __builtin_amdgcn_exp2f(ls[0] - mx); e[1] = __builtin_amdgcn_exp2f(ls[1] - mx); e[2] = __builtin_amdgcn_exp2f(ls[2] - mx);
        const float inv = 1.0f / (e[0] + e[1] + e[2]);
        float o[8];
#pragma unroll
        for (int k = 0; k < 8; ++k) o[k] = 0.f;
#pragma unroll
        for (int q = 0; q < 3; ++q) { const float wq = e[q] * inv;
            o[0] += wq * bflo(w[q].x); o[1] += wq * bfhi(w[q].x); o[2] += wq * bflo(w[q].y); o[3] += wq * bfhi(w[q].y);
            o[4] += wq * bflo(w[q].z); o[5] += wq * bfhi(w[q].z); o[6] += wq * bflo(w[q].w); o[7] += wq * bfhi(w[q].w); }
        float ss = 0.f;
#pragma unroll
        for (int k = 0; k < 8; ++k) ss += o[k] * o[k];
        ss = sum8_dpp(ss);
        const float rs = 1.0f / sqrtf(ss * (1.0f / 64.0f) + RMS_EPS);
        v4u ow; ow.x = pk2(o[0] * rs * g0[0], o[1] * rs * g0[1]); ow.y = pk2(o[2] * rs * g0[2], o[3] * rs * g0[3]);
        ow.z = pk2(o[4] * rs * g1[0], o[5] * rs * g1[1]); ow.w = pk2(o[6] * rs * g1[2], o[7] * rs * g1[3]);
        *(v4u*)(MG + row * DM + 512 + lane * 8) = ow;
    }
}
__device__ __forceinline__ void phase_ln1(const Params& p, const int tid) {
    const int lane = tid & 63, wave = tid >> 6;
    const float* ADA = (const float*)(p.ws + WS_ADA); bf16raw* H = (bf16raw*)(p.ws + WS_H); float* ST = (float*)(p.ws + WS_ST1);
    v4f lg[4], lb[4];
#pragma unroll
    for (int j = 0; j < 4; ++j) { lg[j] = *(const v4f*)(p.ln1_g + 4 * lane + 256 * j); lb[j] = *(const v4f*)(p.ln1_b + 4 * lane + 256 * j); }
    for (size_t row = (size_t)blockIdx.x * 8 + wave; row < (size_t)MTOK; row += (size_t)gridDim.x * 8) {
        const int b = (int)(row >> 12);
        const v4f* yr = (const v4f*)(p.out + row * DM) + lane;
        v4f v[4]; float s = 0.f;
#pragma unroll
        for (int j = 0; j < 4; ++j) { v[j] = yr[64 * j]; s += (v[j][0] + v[j][1]) + (v[j][2] + v[j][3]); }
        const float mean = wave_sum(s) * (1.0f / DM); float s2 = 0.f;
#pragma unroll
        for (int j = 0; j < 4; ++j) { v[j] = v[j] - mean; s2 += (v[j][0] * v[j][0] + v[j][1] * v[j][1]) + (v[j][2] * v[j][2] + v[j][3] * v[j][3]); }
        const float rstd = 1.0f / sqrtf(wave_sum(s2) * (1.0f / DM) + LN_EPS);
        if (lane == 0) *(v2f*)(ST + row * 2) = (v2f){mean, rstd};
        unsigned long long* o8 = (unsigned long long*)(H + row * DM) + lane;
#pragma unroll
        for (int j = 0; j < 4; ++j) { const v4f x1 = v[j] * rstd * lg[j] + lb[j];
            const v4f shf = *(const v4f*)(ADA + (size_t)b * (6 * DM) + 3 * DM + 4 * lane + 256 * j), scf = *(const v4f*)(ADA + (size_t)b * (6 * DM) + 4 * DM + 4 * lane + 256 * j);
            const v4f hv = x1 * (scf + 1.0f) + shf;
            o8[64 * j] = (unsigned long long)pk2(hv[0], hv[1]) | ((unsigned long long)pk2(hv[2], hv[3]) << 32); }
    }
}
__device__ __forceinline__ void phase_convfix(const Params& p, const int tid) {
    const float* ULAST = (const float*)(p.ws + WS_ULAST); const float* YFIRST = (const float*)(p.ws + WS_YFIRST); bf16raw* G = (bf16raw*)(p.ws + WS_G);
    constexpr int CH = DFF / 4;
    for (int i = blockIdx.x * 512 + tid; i < (MTOK / 128) * CH; i += gridDim.x * 512) {
        const int s = i / CH, c4 = (i % CH) * 4; const bool halo = (s & 31) != 0;
        v4f y[2][2];
#pragma unroll
        for (int part = 0; part < 2; ++part) { const int col = part * DFF + c4;
            y[part][0] = *(const v4f*)(YFIRST + ((size_t)s * 2 + 0) * NUP + col); y[part][1] = *(const v4f*)(YFIRST + ((size_t)s * 2 + 1) * NUP + col);
            if (halo) { const v4f u6 = *(const v4f*)(ULAST + ((size_t)(s - 1) * 2 + 0) * NUP + col), u7 = *(const v4f*)(ULAST + ((size_t)(s - 1) * 2 + 1) * NUP + col);
                const v4f w0 = *(const v4f*)(p.conv_w + col), w1 = *(const v4f*)(p.conv_w + NUP + col);
                y[part][0] += w0 * u6 + w1 * u7; y[part][1] += w0 * u7; } }
#pragma unroll
        for (int t = 0; t < 2; ++t) { float r[4];
#pragma unroll
            for (int e = 0; e < 4; ++e) { const float g = y[1][t][e]; r[e] = y[0][t][e] * g / (1.0f + __expf(-g)); }
            *(v2u*)(G + ((size_t)s * 128 + t) * DFF + c4) = (v2u){pk2(r[0], r[1]), pk2(r[2], r[3])}; }
    }
}
__device__ __forceinline__ void phase_ln2(const Params& p, const int tid) {
    const int lane = tid & 63, wave = tid >> 6;
    v4f lg[4], lb[4];
#pragma unroll
    for (int j = 0; j < 4; ++j) { lg[j] = *(const v4f*)(p.ln2_g + 4 * lane + 256 * j); lb[j] = *(const v4f*)(p.ln2_b + 4 * lane + 256 * j); }
    for (size_t row = (size_t)blockIdx.x * 8 + wave; row < (size_t)MTOK; row += (size_t)gridDim.x * 8) {
        v4f* yr = (v4f*)(p.out + row * DM) + lane;
        v4f v[4]; float s = 0.f;
#pragma unroll
        for (int j = 0; j < 4; ++j) { v[j] = yr[64 * j]; s += (v[j][0] + v[j][1]) + (v[j][2] + v[j][3]); }
        const float mean = wave_sum(s) * (1.0f / DM); float s2 = 0.f;
#pragma unroll
        for (int j = 0; j < 4; ++j) { v[j] = v[j] - mean; s2 += (v[j][0] * v[j][0] + v[j][1] * v[j][1]) + (v[j][2] * v[j][2] + v[j][3] * v[j][3]); }
        const float rstd = 1.0f / sqrtf(wave_sum(s2) * (1.0f / DM) + LN_EPS);
#pragma unroll
        for (int j = 0; j < 4; ++j) yr[64 * j] = v[j] * rstd * lg[j] + lb[j];
    }
}

#ifndef REP_FOX
#define REP_FOX 1
#endif
#ifndef REP_DIL
#define REP_DIL 1
#endif
#ifndef REPMASK
#define REPMASK 0
#endif
constexpr size_t WS_CTL = 0, CTL_ZERO_BYTES = 65536;
constexpr int LDSCTL_OFF = RING_BYTES;

constexpr int N_PHASES = 14;
__global__ void __launch_bounds__(512, 2) fwd_megakernel(Params p) {
    extern __shared__ __attribute__((aligned(16))) unsigned char lds_raw[];
    LAS unsigned char* lds = (LAS unsigned char*)lds_raw;
    cg::grid_group grid = cg::this_grid();
    const int wid_k = __builtin_amdgcn_readfirstlane(threadIdx.x >> 6);
#define MK_TID() (wid_k * 64 + lane_id())
    const int lo = p.ph_lo, hi = p.ph_hi;
    XcdBarrier bar;
    { const int t0 = MK_TID();
      for (int u = t0; u < (LDS_BYTES - LDSCTL_OFF) / 4; u += 512) ((LAS unsigned*)(lds + LDSCTL_OFF))[u] = 0u;
      __syncthreads();
      bar = xcd_barrier_post((unsigned*)(p.ws + WS_CTL), (volatile LAS unsigned*)(lds + LDSCTL_OFF) + 8, t0); }
#define IN(k) (lo <= (k) && (k) < hi)
#define SEAM(k) do { if (IN(k) && IN((k) + 1)) { if ((k) == 0) grid.sync(); else xcd_barrier(bar, MK_TID()); } } while (0)
    bf16raw* H = (bf16raw*)(p.ws + WS_H); bf16raw* Z = (bf16raw*)(p.ws + WS_Z); bf16raw* MG = (bf16raw*)(p.ws + WS_MG);
    const float* ADA = (const float*)(p.ws + WS_ADA);
    if (IN(0)) for (int rp = 0; rp <= ((REPMASK >> (0)) & 1); ++rp) { phase_prologue(p, lds, MK_TID()); } SEAM(0);
    if (IN(1)) for (int rp = 0; rp <= ((REPMASK >> (1)) & 1); ++rp) { phase_pre1(p, lds, MK_TID()); } SEAM(1);
    if (IN(2)) for (int rp = 0; rp <= ((REPMASK >> (2)) & 1); ++rp) {
        phase_fabs(p, MK_TID());
        pg8::Gemm g{H, (const bf16raw*)(p.ws + WS_WIN), MTOK, NZ, DM}; pg8::StaticOrder S; S.init(MTOK, NZ, gridDim.x, (int)blockIdx.x);
        pg8::EpiIn E{Z, (const float*)(p.ws + WS_CS)};
        pg8::gemm_phase<pg8::EpiIn, pg8::StaticOrder, true, true>(lds, g, S, E, MK_TID());
    } SEAM(2);
    if (IN(3)) for (int rp = 0; rp <= ((REPMASK >> (3)) & 1); ++rp) {
        { const int G = gridDim.x, bx = blockIdx.x, vcu = (G % 8 == 0) ? (bx % 8) * (G / 8) + bx / 8 : bx, per = (1024 + G - 1) / G;
          const int ftid = MK_TID();
          for (int rep = 0; rep < REP_FOX; ++rep)
          for (int u = vcu * per; u < (vcu + 1) * per && u < 1024; ++u) { const int bh = u >> 3, j = u & 7;
              fox::fox_unit<8>(bh >> 3, bh & 7, 15 - j, Z, (const float*)(p.ws + WS_FABS), p.ws + WS_KXT, MG, p.gn_a, lds, ftid);
              fox::fox_unit<8>(bh >> 3, bh & 7, j, Z, (const float*)(p.ws + WS_FABS), p.ws + WS_KXT, MG, p.gn_a, lds, ftid); } }
        { const int G = gridDim.x, bx = blockIdx.x, vcu = (G % 8 == 0) ? (bx % 8) * (G / 8) + bx / 8 : bx, per = (dil::N_UNITS + G - 1) / G;
          const int ulo = vcu * per, uhi = (vcu + 1) * per < dil::N_UNITS ? (vcu + 1) * per : dil::N_UNITS;
          for (int rep = 0; rep < REP_DIL; ++rep) dil::dil_phase(ulo, uhi, Z, (bf16raw*)(p.ws + WS_OP), (float*)(p.ws + WS_LSE), lds, MK_TID()); }
    } SEAM(3);
    if (IN(4)) for (int rp = 0; rp <= ((REPMASK >> (4)) & 1); ++rp) { phase_merge(p, MK_TID()); } SEAM(4);
    if (IN(5)) for (int rp = 0; rp <= ((REPMASK >> (5)) & 1); ++rp) {
        pg8::Gemm g{MG, (const bf16raw*)(p.ws + WS_WOUT), MTOK, DM, DM}; pg8::StaticOrder S; S.init(MTOK, DM, gridDim.x, (int)blockIdx.x);
        pg8::EpiOut E{p.x, p.out, ADA};
        pg8::gemm_phase<pg8::EpiOut, pg8::StaticOrder, true, true>(lds, g, S, E, MK_TID());
    } SEAM(5);
    if (IN(6)) for (int rp = 0; rp <= ((REPMASK >> (6)) & 1); ++rp) { phase_ln1(p, MK_TID()); } SEAM(6);
    if (IN(7)) for (int rp = 0; rp <= ((REPMASK >> (7)) & 1); ++rp) {
        pg8::Gemm g{H, (const bf16raw*)(p.ws + WS_WUP), MTOK, NUP, DM}; pg8::StaticOrder S; S.init(MTOK, NUP, gridDim.x, (int)blockIdx.x);
        pg8::EpiUpConv E{(bf16raw*)(p.ws + WS_G), (float*)(p.ws + WS_ULAST), (float*)(p.ws + WS_YFIRST), p.conv_w, p.conv_b};
        pg8::gemm_phase<pg8::EpiUpConv, pg8::StaticOrder, true, true, 1>(lds, g, S, E, MK_TID());
    } SEAM(7);
    if (IN(8)) for (int rp = 0; rp <= ((REPMASK >> (8)) & 1); ++rp) { phase_convfix(p, MK_TID()); } SEAM(8);
    if (IN(11)) for (int rp = 0; rp <= ((REPMASK >> (11)) & 1); ++rp) {
        pg8::Gemm g{(const bf16raw*)(p.ws + WS_G), (const bf16raw*)(p.ws + WS_WDN), MTOK, DM, DFF}; pg8::StaticOrder S; S.init(MTOK, DM, gridDim.x, (int)blockIdx.x);
        pg8::EpiDown E{p.out, (const float*)(p.ws + WS_ST1), ADA, p.ln1_g, p.ln1_b};
        pg8::gemm_phase<pg8::EpiDown, pg8::StaticOrder, true, true>(lds, g, S, E, MK_TID());
    } SEAM(11);
    if (IN(12)) for (int rp = 0; rp <= ((REPMASK >> (12)) & 1); ++rp) { phase_ln2(p, MK_TID()); }
#undef IN
#undef SEAM
}

extern "C" void kernel_launch(void* const* d_in, const int* in_sizes, int n_in, void* d_out, int out_size, void* d_ws, size_t ws_size, hipStream_t stream) {
    static int grid = 0;
    if (grid == 0) {
        if (n_in != 18 || out_size != MTOK * DM || ws_size < WS_END) { fprintf(stderr, "kernel_launch: unexpected problem (n_in %d out %d ws %zu)\n", n_in, out_size, ws_size); grid = -1; return; }
        int dev = 0, cus = 0, per_cu = 0;
        hipGetDevice(&dev); hipDeviceGetAttribute(&cus, hipDeviceAttributeMultiprocessorCount, dev);
        if (hipFuncSetAttribute((const void*)fwd_megakernel, hipFuncAttributeMaxDynamicSharedMemorySize, LDS_BYTES) != hipSuccess) { fprintf(stderr, "kernel_launch: hipFuncSetAttribute failed\n"); grid = -1; return; }
        if (hipOccupancyMaxActiveBlocksPerMultiprocessor(&per_cu, (const void*)fwd_megakernel, 512, LDS_BYTES) != hipSuccess || per_cu < 1) { fprintf(stderr, "kernel_launch: occupancy query says %d\n", per_cu); per_cu = 1; }
        (void)hipGetLastError();
        if (per_cu > 1) per_cu = 1;
        grid = cus * per_cu;
    }
    if (grid < 0) return;
    Params p{};
    p.x = (const float*)d_in[0]; p.c = (const float*)d_in[1]; p.pos = (const int*)d_in[2]; p.w_ada = (const float*)d_in[3]; p.b_ada = (const float*)d_in[4];
    p.w_in = (const float*)d_in[5]; p.b_fgate = (const float*)d_in[6]; p.gn_a = (const float*)d_in[7]; p.gn_b = (const float*)d_in[8]; p.w_out = (const float*)d_in[9];
    p.ln1_g = (const float*)d_in[10]; p.ln1_b = (const float*)d_in[11]; p.w_up = (const float*)d_in[12]; p.conv_w = (const float*)d_in[13]; p.conv_b = (const float*)d_in[14];
    p.w_down = (const float*)d_in[15]; p.ln2_g = (const float*)d_in[16]; p.ln2_b = (const float*)d_in[17];
    p.out = (float*)d_out; p.ws = (unsigned char*)d_ws;
#if MK_SPLIT
    for (int ph = 0; ph < N_PHASES - 1; ++ph) { p.ph_lo = ph; p.ph_hi = ph + 1; hipLaunchKernelGGL(fwd_megakernel, dim3(grid), dim3(512), LDS_BYTES, stream, p); }
#else
    p.ph_lo = 0; p.ph_hi = N_PHASES;
    if (hipMemsetAsync((char*)d_ws + WS_CTL, 0, CTL_ZERO_BYTES, stream) != hipSuccess) { fprintf(stderr, "kernel_launch: memset failed\n"); return; }
    void* args[] = {&p};
    hipError_t e = hipLaunchCooperativeKernel((const void*)fwd_megakernel, dim3(grid), dim3(512), args, LDS_BYTES, stream);
    if (e != hipSuccess) fprintf(stderr, "cooperative launch failed: %s (grid %d)\n", hipGetErrorString(e), grid);
#endif
}
```

```cpp
#include <hip/hip_runtime.h>
#include <hip/hip_cooperative_groups.h>
#include <cstdio>
#include <cstdint>
namespace cg = cooperative_groups;

#ifndef MK_SPLIT
#define MK_SPLIT 0
#endif

constexpr int NB = 16, SEQ = 4096, DM = 1024, MTOK = NB * SEQ;
constexpr int DIN = 3080, NZ = 3072;
constexpr int DFF = 2816, NUP = 5632;
constexpr int NH = 8, HD = 64;
constexpr float ALPHA = 1.189207115002721f;
constexpr float LOG2E = 1.4426950408889634f;
constexpr float QSCALE = 0.125f * LOG2E;
constexpr float LN_EPS = 1e-5f, RMS_EPS = 1e-6f;
constexpr size_t ZSEC = (size_t)MTOK * 512;
constexpr int ZQA = 0, ZKA = 1, ZVA = 2, ZQB = 3, ZKB = 4, ZVB = 5;

#define LAS __attribute__((address_space(3)))
typedef unsigned short bf16raw;
typedef unsigned v4u __attribute__((ext_vector_type(4)));
typedef unsigned v2u __attribute__((ext_vector_type(2)));
typedef float v4f __attribute__((ext_vector_type(4)));
typedef float v2f __attribute__((ext_vector_type(2)));

__device__ __forceinline__ unsigned f2bf(float f) { unsigned u = __builtin_bit_cast(unsigned, f); return (u + 0x7fffu + ((u >> 16) & 1u)) >> 16; }
__device__ __forceinline__ unsigned pk2(float lo, float hi) { return f2bf(lo) | (f2bf(hi) << 16); }
__device__ __forceinline__ float bflo(unsigned w) { return __builtin_bit_cast(float, w << 16); }
__device__ __forceinline__ float bfhi(unsigned w) { return __builtin_bit_cast(float, w & 0xffff0000u); }
__device__ __forceinline__ int lane_id() { int l; asm volatile("v_mbcnt_lo_u32_b32 %0, -1, 0\n\tv_mbcnt_hi_u32_b32 %0, -1, %0" : "=v"(l)); return l; }
__device__ __forceinline__ float sum8_dpp(float v) {
    v += __builtin_bit_cast(float, __builtin_amdgcn_mov_dpp(__builtin_bit_cast(int, v), 0xB1, 0xF, 0xF, true));
    v += __builtin_bit_cast(float, __builtin_amdgcn_mov_dpp(__builtin_bit_cast(int, v), 0x4E, 0xF, 0xF, true));
    v += __builtin_bit_cast(float, __builtin_amdgcn_mov_dpp(__builtin_bit_cast(int, v), 0x141, 0xF, 0xF, true));
    return v;
}
__device__ __forceinline__ float wave_sum(float v) {
#pragma unroll
    for (int o = 1; o < 64; o <<= 1) v += __shfl_xor(v, o);
    return v;
}

namespace pg8 {
#define PG8_LAS __attribute__((address_space(3)))
typedef unsigned short bf16_t;
typedef short bf16x8 __attribute__((ext_vector_type(8)));
typedef float f32x4 __attribute__((ext_vector_type(4)));
typedef unsigned u32x4 __attribute__((ext_vector_type(4)));
constexpr int BM = 256, BK = 64, HALF = 128, HTB = HALF * BK * 2  , STAGE_BYTES = 8 * HTB, NXCD = 8, WGM = 8;

__host__ __device__ __forceinline__ int lds_byte(int r, int c) { const int st = (r >> 4) * 2 + (c >> 5), rr = r & 15, cc = c & 31, ob = rr * 64 + cc * 2; return st * 1024 + (ob ^ (((ob >> 9) & 1) << 5)); }
__host__ __device__ __forceinline__ void stage_rc(int b, int& R, int& C) { const int st = b / 1024, sb = b % 1024, swz = sb ^ (((sb >> 9) & 1) << 5); R = (st >> 1) * 16 + swz / 64; C = (st & 1) * 32 + (swz % 64) / 2; }
__host__ __device__ __forceinline__ int perm32(int rho) { const int n = rho >> 4, i = rho & 15; return 8 * (i >> 2) + 4 * n + (i & 3); }

struct Unit { int pm, pn; };
struct Gemm { const bf16_t* A; const bf16_t* Bt; int M, N, K; };

struct StaticOrder {
    int nM, nN, nwg, G, c;
    __host__ __device__ void init(int M, int N, int G_, int c_) { nM = M / BM; nN = N / BM; nwg = nM * nN; G = G_; c = c_; }
    __host__ __device__ bool next(int i, Unit& u) const {
        const long L = (long)i * G + c; if (L >= nwg) return false;
        int wgid = (int)L; { const int q = nwg / NXCD, r = nwg % NXCD, xcd = wgid % NXCD, off = wgid / NXCD; wgid = (xcd < r ? xcd * (q + 1) : r * (q + 1) + (xcd - r) * q) + off; }
        const int nig = WGM * nN, gid = wgid / nig, fm = gid * WGM, gsz = (nM - fm) < WGM ? (nM - fm) : WGM;
        u.pm = fm + ((wgid % nig) % gsz); u.pn = (wgid % nig) / gsz; return true;
    }
    __device__ __forceinline__ void a_ready(const Unit&) const {}
    __device__ __forceinline__ void done(const Unit&) const {}
};

__device__ __forceinline__ unsigned cvt_pk_bf16(float lo, float hi) { unsigned r; asm volatile("v_cvt_pk_bf16_f32 %0, %1, %2" : "=v"(r) : "v"(lo), "v"(hi)); return r; }
typedef float f32x2 __attribute__((ext_vector_type(2)));

struct EpiIn {
    static constexpr bool PERM = true, AFTER_DRAIN = false;
    bf16_t* Z; const float* CS;
    __device__ __forceinline__ void operator()(const f32x4 (&acc)[2][2][4][2], const Unit& u, int wr, int wc, int fr, int fq) const {
        const int row0 = u.pm * BM + wr * 64 + fr, col0 = u.pn * BM + wc * 32 + 8 * fq;
        const bool isq = (u.pn < 2) || (u.pn == 6) || (u.pn == 7);
        const float sc = isq ? QSCALE : 1.0f;
        const bool rot = (u.pn >= 6) && (u.pn < 10) && ((wc & 1) == 0) && (fq < 2);
        const int bb = u.pm >> 4, t0 = (u.pm & 15) * BM + wr * 64 + fr;
        bf16_t* colp[2];
#pragma unroll
        for (int bj = 0; bj < 2; ++bj) { const int col = col0 + bj * HALF; colp[bj] = Z + (size_t)(col >> 9) * ZSEC + ((size_t)(bb * NH + ((col >> 6) & 7)) * SEQ) * HD + (col & 63); }
#pragma unroll
        for (int ai = 0; ai < 2; ++ai)
#pragma unroll
            for (int m = 0; m < 4; ++m) {
                const int row = row0 + ai * HALF + m * 16, tt = t0 + ai * HALF + m * 16;
                f32x4 cs = (f32x4){1.f, 1.f, 1.f, 1.f}, sn = (f32x4){0.f, 0.f, 0.f, 0.f};
                if (rot) { cs = *(const f32x4*)(CS + (size_t)row * 16 + 4 * fq); sn = *(const f32x4*)(CS + (size_t)row * 16 + 8 + 4 * fq); }
#pragma unroll
                for (int bj = 0; bj < 2; ++bj) {
                    f32x4 v0 = acc[ai][bj][m][0], v1 = acc[ai][bj][m][1];
                    const f32x4 t1 = v0 * cs - v1 * sn, t2 = v1 * cs + v0 * sn;
                    v0 = t1 * sc; v1 = t2 * sc;
                    u32x4 w; w.x = cvt_pk_bf16(v0[0], v0[1]); w.y = cvt_pk_bf16(v0[2], v0[3]); w.z = cvt_pk_bf16(v1[0], v1[1]); w.w = cvt_pk_bf16(v1[2], v1[3]);
                    *(u32x4*)(colp[bj] + (size_t)tt * HD) = w;
                }
            }
    }
};
struct EpiOut {
    static constexpr bool PERM = false, AFTER_DRAIN = false;
    const float* x; float* y; const float* ada;
    __device__ __forceinline__ void operator()(const f32x4 (&acc)[2][2][4][2], const Unit& u, int wr, int wc, int fr, int fq) const {
        const int row0 = u.pm * BM + wr * 64 + fr, col0 = u.pn * BM + wc * 32 + 4 * fq;
        const float* ga = ada + (size_t)(u.pm >> 4) * (6 * DM) + 2 * DM + col0;
#pragma unroll
        for (int bj = 0; bj < 2; ++bj)
#pragma unroll
            for (int n = 0; n < 2; ++n) {
                const f32x4 g = *(const f32x4*)(ga + bj * HALF + n * 16);
#pragma unroll
                for (int ai = 0; ai < 2; ++ai)
#pragma unroll
                    for (int m = 0; m < 4; ++m) {
                        const size_t off = (size_t)(row0 + ai * HALF + m * 16) * DM + col0 + bj * HALF + n * 16;
                        const f32x4 xv = *(const f32x4*)(x + off);
                        *(f32x4*)(y + off) = xv * ALPHA + g * acc[ai][bj][m][n];
                    }
                asm volatile("" ::: "memory");
            }
    }
};
struct EpiRaw {
    static constexpr bool PERM = true, AFTER_DRAIN = false;
    bf16_t* O; int ldc;
    __device__ __forceinline__ void operator()(const f32x4 (&acc)[2][2][4][2], const Unit& u, int wr, int wc, int fr, int fq) const {
        const int row0 = u.pm * BM + wr * 64 + fr, col0 = u.pn * BM + wc * 32 + 8 * fq;
#pragma unroll
        for (int ai = 0; ai < 2; ++ai)
#pragma unroll
            for (int m = 0; m < 4; ++m) { bf16_t* rowp = O + (size_t)(row0 + ai * HALF + m * 16) * ldc + col0;
#pragma unroll
                for (int bj = 0; bj < 2; ++bj) { const f32x4 v0 = acc[ai][bj][m][0], v1 = acc[ai][bj][m][1];
                    u32x4 w; w.x = cvt_pk_bf16(v0[0], v0[1]); w.y = cvt_pk_bf16(v0[2], v0[3]); w.z = cvt_pk_bf16(v1[0], v1[1]); w.w = cvt_pk_bf16(v1[2], v1[3]);
                    *(u32x4*)(rowp + bj * HALF) = w; } }
    }
};
struct EpiDown {
    static constexpr bool PERM = false, AFTER_DRAIN = false;
    float* y; const float* st; const float* ada; const float* lng; const float* lnb;
    __device__ __forceinline__ void operator()(const f32x4 (&acc)[2][2][4][2], const Unit& u, int wr, int wc, int fr, int fq) const {
        const int row0 = u.pm * BM + wr * 64 + fr, col0 = u.pn * BM + wc * 32 + 4 * fq;
        const float* gf = ada + (size_t)(u.pm >> 4) * (6 * DM) + 5 * DM + col0;
        f32x2 sr[2][4];
#pragma unroll
        for (int ai = 0; ai < 2; ++ai)
#pragma unroll
            for (int m = 0; m < 4; ++m) sr[ai][m] = *(const f32x2*)(st + (size_t)(row0 + ai * HALF + m * 16) * 2);
#pragma unroll
        for (int bj = 0; bj < 2; ++bj)
#pragma unroll
            for (int n = 0; n < 2; ++n) {
                const int co = bj * HALF + n * 16;
                const f32x4 g = *(const f32x4*)(gf + co), lg = *(const f32x4*)(lng + col0 + co), lb = *(const f32x4*)(lnb + col0 + co);
#pragma unroll
                for (int ai = 0; ai < 2; ++ai)
#pragma unroll
                    for (int m = 0; m < 4; ++m) {
                        const size_t off = (size_t)(row0 + ai * HALF + m * 16) * DM + col0 + co;
                        const f32x4 yv = *(const f32x4*)(y + off);
                        const f32x4 x1 = (yv - sr[ai][m].x) * sr[ai][m].y * lg + lb;
                        *(f32x4*)(y + off) = x1 * ALPHA + g * acc[ai][bj][m][n];
                    }
                asm volatile("" ::: "memory");
            }
    }
};


__device__ __forceinline__ f32x4 dpp_shr1(const f32x4 v) { f32x4 r;
#pragma unroll
    for (int e = 0; e < 4; ++e) { float t; asm("s_nop 1\n\tv_mov_b32_dpp %0, %1 row_shr:1 row_mask:0xf bank_mask:0xf bound_ctrl:1" : "=v"(t) : "v"(v[e])); r[e] = t; }
    return r; }
struct EpiUpConv {
    static constexpr bool PERM = true, AFTER_DRAIN = false;
    bf16_t* G; float* ULAST; float* YFIRST; const float* cw; const float* cb;
    __device__ __forceinline__ void operator()(f32x4 (&acc)[2][2][4][2], const Unit& u, int wr, int wc, int fr, int fq) const {
        const int strip = 2 * u.pm + wr, ca = 128 * u.pn + 32 * wc + 8 * fq;
#define ACCJ(j, bj, n) acc[(j) >> 2][bj][(j) & 3][n]
#pragma unroll
        for (int bj = 0; bj < 2; ++bj)
#pragma unroll
            for (int n = 0; n < 2; ++n) {
                const int col = bj * DFF + ca + 4 * n;
                const f32x4 w0 = *(const f32x4*)(cw + col), w1 = *(const f32x4*)(cw + NUP + col), w2 = *(const f32x4*)(cw + 2 * NUP + col), b = *(const f32x4*)(cb + col);
                const f32x4 u6 = ACCJ(6, bj, n), u7 = ACCJ(7, bj, n);
                if (fr == 15) { *(f32x4*)(ULAST + ((size_t)strip * 2 + 0) * NUP + col) = u6; *(f32x4*)(ULAST + ((size_t)strip * 2 + 1) * NUP + col) = u7; }
                const f32x4 p6 = dpp_shr1(u6), p7 = dpp_shr1(u7);
#pragma unroll
                for (int j = 7; j >= 2; --j) ACCJ(j, bj, n) = b + w0 * ACCJ(j - 2, bj, n) + w1 * ACCJ(j - 1, bj, n) + w2 * ACCJ(j, bj, n);
                const f32x4 y1 = b + w0 * p7 + w1 * ACCJ(0, bj, n) + w2 * ACCJ(1, bj, n), y0 = b + w0 * p6 + w1 * p7 + w2 * ACCJ(0, bj, n);
                ACCJ(1, bj, n) = y1; ACCJ(0, bj, n) = y0;
                if (fr == 0) { *(f32x4*)(YFIRST + ((size_t)strip * 2 + 0) * NUP + col) = y0; *(f32x4*)(YFIRST + ((size_t)strip * 2 + 1) * NUP + col) = y1; }
            }
        bf16_t* gp = G + ((size_t)strip * 128 + 8 * fr) * DFF + ca;
#pragma unroll
        for (int j = 0; j < 8; ++j) {
            f32x4 r0, r1;
#pragma unroll
            for (int e = 0; e < 4; ++e) { const float g0 = ACCJ(j, 1, 0)[e], g1 = ACCJ(j, 1, 1)[e];
                r0[e] = ACCJ(j, 0, 0)[e] * g0 * __builtin_amdgcn_rcpf(1.0f + __expf(-g0)); r1[e] = ACCJ(j, 0, 1)[e] * g1 * __builtin_amdgcn_rcpf(1.0f + __expf(-g1)); }
            u32x4 w; w.x = cvt_pk_bf16(r0[0], r0[1]); w.y = cvt_pk_bf16(r0[2], r0[3]); w.z = cvt_pk_bf16(r1[0], r1[1]); w.w = cvt_pk_bf16(r1[2], r1[3]);
            *(u32x4*)(gp + (size_t)j * DFF) = w;
        }
#undef ACCJ
    }
};
template <class Epi, class Sched, bool ALIGN_EPI = false, bool SP2 = false, int AMAP = 0>
__device__ __forceinline__ void gemm_phase(PG8_LAS unsigned char* lds, const Gemm g, const Sched& S, const Epi& E, const int tid) {
    const int wid = __builtin_amdgcn_readfirstlane(tid >> 6), lane = tid & 63, wr = wid >> 2, wc = wid & 3, fr = lane & 15, fq = lane >> 4;
    const int K = g.K, nt = K / BK;
    unsigned voffA[2], voffB[2];
#pragma unroll
    for (int i = 0; i < 2; ++i) { int R, C; stage_rc(tid * 16 + i * 8192, R, C); const int Rb = Epi::PERM ? ((R & ~31) + perm32(R & 31)) : R;
        const int Ra = AMAP ? ((R >> 6) * 128 + (R & 15) * 8 + ((R >> 4) & 3)) : R;
        voffA[i] = (unsigned)(Ra * K + C) * 2u; voffB[i] = (unsigned)(Rb * K + C) * 2u; }
    const size_t kstep = (size_t)(BK * 2);
    const size_t hstep = (size_t)HALF * K * 2;
    const size_t hstepA = AMAP ? (size_t)4 * K * 2 : hstep;
    const size_t tstep = 2 * hstep;
    const unsigned ldsw = (unsigned)wid * 1024u;
    const int aoff = lds_byte(wr * 64 + fr, fq * 8), boff = lds_byte(wc * 32 + fr, fq * 8);
#define PG8_SA(b, h) (((b) * 2 + (h)) * HTB)
#define PG8_SB(b, h) ((4 + (b) * 2 + (h)) * HTB)
#define PG8_STAGE(bufoff, gbase, voff) do { _Pragma("unroll") for (int _i = 0; _i < 2; ++_i) \
        __builtin_amdgcn_global_load_lds((const unsigned*)((const char*)(gbase) + (voff)[_i]), (PG8_LAS unsigned*)(lds + (bufoff) + ldsw + _i * 8192), 16, 0, 0); } while (0)
#define PG8_LDA(dst, b, h) do { _Pragma("unroll") for (int m = 0; m < 4; ++m) _Pragma("unroll") for (int k = 0; k < 2; ++k) dst[m][k] = *(const PG8_LAS bf16x8*)(lds + PG8_SA(b, h) + aoff + m * 2048 + k * 1024); } while (0)
#define PG8_LDB(dst, b, h) do { _Pragma("unroll") for (int n = 0; n < 2; ++n) _Pragma("unroll") for (int k = 0; k < 2; ++k) dst[n][k] = *(const PG8_LAS bf16x8*)(lds + PG8_SB(b, h) + boff + n * 2048 + k * 1024); } while (0)
#define PG8_MMA(ai, bj, At, Bt) do { __builtin_amdgcn_s_setprio(1); _Pragma("unroll") for (int m = 0; m < 4; ++m) _Pragma("unroll") for (int n = 0; n < 2; ++n) _Pragma("unroll") for (int k = 0; k < 2; ++k) \
        acc[ai][bj][m][n] = __builtin_amdgcn_mfma_f32_16x16x32_bf16(Bt[n][k], At[m][k], acc[ai][bj][m][n], 0, 0, 0); __builtin_amdgcn_s_setprio(0); } while (0)
#define PG8_WAIT_V(n) asm volatile("s_waitcnt vmcnt(" #n ")" ::: "memory")
#define PG8_WAIT_L(n) asm volatile("s_waitcnt lgkmcnt(" #n ")" ::: "memory")
#define PG8_BAR __builtin_amdgcn_s_barrier()
#define PG8_SCHED __builtin_amdgcn_sched_barrier(0)
    Unit cur, nxt; int ui = 0;
    if (!S.next(0, cur)) return;
    f32x4 acc[2][2][4][2];
#pragma unroll
    for (int a = 0; a < 2; ++a)
#pragma unroll
        for (int b = 0; b < 2; ++b)
#pragma unroll
            for (int m = 0; m < 4; ++m)
#pragma unroll
                for (int n = 0; n < 2; ++n) acc[a][b][m][n] = (f32x4){0.f, 0.f, 0.f, 0.f};
    bf16x8 At[4][2], B0[2][2], B1[2][2];
    const char* cA = (const char*)g.A + (size_t)cur.pm * tstep; const char* cB = (const char*)g.Bt + (size_t)cur.pn * tstep;
    S.a_ready(cur);
    if constexpr (SP2) {
        PG8_STAGE(PG8_SB(0, 0), cB, voffB); PG8_STAGE(PG8_SB(0, 1), cB + hstep, voffB); PG8_STAGE(PG8_SA(0, 0), cA, voffA); PG8_STAGE(PG8_SA(0, 1), cA + hstepA, voffA);
        if (wr == 1) PG8_BAR;
        PG8_WAIT_V(2); PG8_BAR;
        PG8_STAGE(PG8_SB(1, 0), cB + kstep, voffB); PG8_STAGE(PG8_SA(1, 0), cA + kstep, voffA); PG8_STAGE(PG8_SB(1, 1), cB + hstep + kstep, voffB);
        PG8_WAIT_V(6); PG8_BAR;
    } else {
        PG8_STAGE(PG8_SB(0, 0), cB, voffB); PG8_STAGE(PG8_SA(0, 0), cA, voffA); PG8_STAGE(PG8_SB(0, 1), cB + hstep, voffB); PG8_STAGE(PG8_SA(0, 1), cA + hstepA, voffA);
        if (wr == 1) PG8_BAR;
        PG8_WAIT_V(4); PG8_BAR;
        PG8_STAGE(PG8_SB(1, 0), cB + kstep, voffB); PG8_STAGE(PG8_SA(1, 0), cA + kstep, voffA); PG8_STAGE(PG8_SB(1, 1), cB + hstep + kstep, voffB);
        PG8_WAIT_V(6); PG8_BAR;
    }
    for (;;) {
        const bool has_next = S.next(ui + 1, nxt);
        const char* nA = has_next ? (const char*)g.A + (size_t)nxt.pm * tstep : cA; const char* nB = has_next ? (const char*)g.Bt + (size_t)nxt.pn * tstep : cB;
        for (int t = 0; t < nt; t += 2) {
            const bool last = (t == nt - 2);
            const char* a1 = cA + (size_t)(t + 1) * kstep;
            const char* a2 = last ? nA : cA + (size_t)(t + 2) * kstep; const char* b2 = last ? nB : cB + (size_t)(t + 2) * kstep;
            const char* a3 = a2 + kstep; const char* b3 = b2 + kstep;
            if (last && has_next) S.a_ready(nxt);
            if constexpr (SP2) {
            PG8_LDB(B0, 0, 0); PG8_LDB(B1, 0, 1); PG8_SCHED; PG8_LDA(At, 0, 0); PG8_STAGE(PG8_SA(1, 1), a1 + hstepA, voffA);
            PG8_WAIT_V(8); PG8_WAIT_L(0); PG8_BAR; PG8_MMA(0, 0, At, B0); PG8_MMA(0, 1, At, B1); PG8_BAR; PG8_SCHED;
            PG8_LDA(At, 0, 1); PG8_STAGE(PG8_SB(0, 0), b2, voffB); PG8_STAGE(PG8_SB(0, 1), b2 + hstep, voffB); PG8_STAGE(PG8_SA(0, 0), a2, voffA);
            PG8_WAIT_V(8); PG8_WAIT_L(0); PG8_BAR; PG8_MMA(1, 0, At, B0); PG8_MMA(1, 1, At, B1); PG8_BAR; PG8_SCHED;
            PG8_LDB(B0, 1, 0); PG8_LDB(B1, 1, 1); PG8_SCHED; PG8_LDA(At, 1, 0); PG8_STAGE(PG8_SA(0, 1), a2 + hstepA, voffA);
            PG8_WAIT_V(8); PG8_WAIT_L(0); PG8_BAR; PG8_MMA(0, 0, At, B0); PG8_MMA(0, 1, At, B1); PG8_BAR; PG8_SCHED;
            PG8_LDA(At, 1, 1); PG8_STAGE(PG8_SB(1, 0), b3, voffB); PG8_STAGE(PG8_SB(1, 1), b3 + hstep, voffB); PG8_STAGE(PG8_SA(1, 0), a3, voffA);
            PG8_WAIT_V(8); PG8_WAIT_L(0); PG8_BAR; PG8_MMA(1, 0, At, B0); PG8_MMA(1, 1, At, B1); PG8_BAR; PG8_SCHED;
            } else {
            PG8_LDB(B0, 0, 0); PG8_SCHED; PG8_LDA(At, 0, 0); PG8_STAGE(PG8_SA(1, 1), a1 + hstepA, voffA);
            PG8_WAIT_L(8); PG8_BAR; PG8_WAIT_L(0); PG8_MMA(0, 0, At, B0); PG8_BAR; PG8_SCHED;
            PG8_LDB(B1, 0, 1); PG8_STAGE(PG8_SB(0, 0), b2, voffB);
            PG8_BAR; PG8_WAIT_L(0); PG8_MMA(0, 1, At, B1); PG8_BAR;
            PG8_LDA(At, 0, 1); PG8_STAGE(PG8_SA(0, 0), a2, voffA);
            PG8_BAR; PG8_WAIT_L(0); PG8_MMA(1, 0, At, B0); PG8_BAR; PG8_SCHED;
            PG8_STAGE(PG8_SB(0, 1), b2 + hstep, voffB);
            PG8_WAIT_V(6); PG8_BAR; PG8_MMA(1, 1, At, B1); PG8_BAR;
            PG8_LDB(B0, 1, 0); PG8_SCHED; PG8_LDA(At, 1, 0); PG8_STAGE(PG8_SA(0, 1), a2 + hstepA, voffA);
            PG8_WAIT_L(8); PG8_BAR; PG8_WAIT_L(0); PG8_MMA(0, 0, At, B0); PG8_BAR; PG8_SCHED;
            PG8_LDB(B1, 1, 1); PG8_STAGE(PG8_SB(1, 0), b3, voffB);
            PG8_BAR; PG8_WAIT_L(0); PG8_MMA(0, 1, At, B1); PG8_BAR;
            PG8_LDA(At, 1, 1); PG8_STAGE(PG8_SA(1, 0), a3, voffA);
            PG8_BAR; PG8_WAIT_L(0); PG8_MMA(1, 0, At, B0); PG8_BAR; PG8_SCHED;
            PG8_STAGE(PG8_SB(1, 1), b3 + hstep, voffB);
            PG8_WAIT_V(6); PG8_BAR; PG8_MMA(1, 1, At, B1); PG8_BAR;
            }
        }
        if constexpr (ALIGN_EPI) { if (wr == 0) PG8_BAR; }
        if constexpr (!Epi::AFTER_DRAIN) { E(acc, cur, wr, wc, fr, fq); S.done(cur); }
        if (!has_next) break;
#pragma unroll
        for (int a = 0; a < 2; ++a)
#pragma unroll
            for (int b = 0; b < 2; ++b)
#pragma unroll
                for (int m = 0; m < 4; ++m)
#pragma unroll
                    for (int n = 0; n < 2; ++n) acc[a][b][m][n] = (f32x4){0.f, 0.f, 0.f, 0.f};
        cur = nxt; cA = nA; cB = nB; ++ui;
        if constexpr (ALIGN_EPI) { if (wr == 1) PG8_BAR; }
    }
    PG8_WAIT_V(0);
    if constexpr (!ALIGN_EPI) { if (wr == 0) PG8_BAR; }
    PG8_BAR;
    if constexpr (Epi::AFTER_DRAIN) { E.fused(acc, cur, wr, wc, fr, fq, lds, wid, lane); S.done(cur); }
#undef PG8_SA
#undef PG8_SB
#undef PG8_STAGE
#undef PG8_LDA
#undef PG8_LDB
#undef PG8_MMA
#undef PG8_WAIT_V
#undef PG8_WAIT_L
#undef PG8_BAR
#undef PG8_SCHED
}
}

namespace fox {
typedef short bf16x8 __attribute__((ext_vector_type(8)));
typedef short s16x4 __attribute__((ext_vector_type(4)));
typedef float f32x16 __attribute__((ext_vector_type(16)));
typedef unsigned u32x4 __attribute__((ext_vector_type(4)));
constexpr int NW = 8, QBLK = 32, QB = QBLK * NW, KVBLK = 64;
__device__ __forceinline__ int crow(int r, int hi) { return (r & 3) + 8 * (r >> 2) + 4 * hi; }
#define SBAR() __builtin_amdgcn_sched_barrier(0)
__device__ __forceinline__ void cmask(f32x16& p0, f32x16& p1, int jb, int qrel, int hi) {
    const float NEGI = -INFINITY; int kb = 64 * jb + 4 * hi;
#pragma unroll
    for (int r = 0; r < 16; ++r) { int kv = kb + (r & 3) + 8 * (r >> 2); if (kv > qrel) p0[r] = NEGI; if (kv + 32 > qrel) p1[r] = NEGI; }
}
constexpr int NSLOT = 3, SLOTB = 9216, XOFF = 8192;
constexpr int LDS_K = 0, LDS_V = NSLOT * SLOTB, LDS_WS = 2 * NSLOT * SLOTB, LDS_OST = LDS_WS + NW * 64 * 4, OST_STRIDE = 68, OST_BYTES = 32 * OST_STRIDE * 4, LDS_BYTES = LDS_OST + NW * OST_BYTES;
__device__ __forceinline__ void glds16(const void* sbase, unsigned voff, unsigned lds_dst) { unsigned keep;
    asm volatile("s_mov_b32 %0, m0\n\ts_mov_b32 m0, %3\n\ts_nop 0\n\tglobal_load_lds_dwordx4 %1, %2\n\ts_mov_b32 m0, %0" : "=&s"(keep) : "v"(voff), "s"(sbase), "s"(lds_dst) : "memory"); }
__device__ __forceinline__ void glds4(const void* sbase, unsigned voff, unsigned lds_dst) { unsigned keep;
    asm volatile("s_mov_b32 %0, m0\n\ts_mov_b32 m0, %3\n\ts_nop 0\n\tglobal_load_lds_dword %1, %2\n\ts_mov_b32 m0, %0" : "=&s"(keep) : "v"(voff), "s"(sbase), "s"(lds_dst) : "memory"); }
__device__ __forceinline__ float max3f(float a, float b, float c) { float r; asm("v_max3_f32 %0, %1, %2, %3" : "=v"(r) : "v"(a), "v"(b), "v"(c)); return r; }
__device__ __forceinline__ float max2f(float a, float b) { float r; asm("v_max_f32_e32 %0, %1, %2" : "=v"(r) : "v"(a), "v"(b)); return r; }
__device__ __forceinline__ float fadd_s(float a, float b) { float r; asm("v_add_f32_e32 %0, %1, %2" : "=v"(r) : "v"(a), "v"(b)); return r; }
__device__ __forceinline__ float fsub_s(float a, float b) { float r; asm("v_sub_f32_e32 %0, %1, %2" : "=v"(r) : "v"(a), "v"(b)); return r; }
typedef float f32x2_t __attribute__((ext_vector_type(2))); typedef __bf16 bf16x2_t __attribute__((ext_vector_type(2)));
__device__ __forceinline__ unsigned cvtpk_s(float lo, float hi) { f32x2_t v = {lo, hi}; bf16x2_t b = __builtin_convertvector(v, bf16x2_t); return __builtin_bit_cast(unsigned, b); }
#define WAIT_BAR(N) asm volatile("s_waitcnt vmcnt(" #N ") lgkmcnt(0)\n\ts_barrier" ::: "memory")
__device__ __forceinline__ s16x4 make_qx(float a, int hi) {
    const unsigned w1 = cvtpk_s(a, 0.f); const float h = __builtin_bit_cast(float, w1 << 16);
    const float r1 = a - h; const unsigned w2 = cvtpk_s(r1, 0.f); const float m = __builtin_bit_cast(float, w2 << 16);
    const float r2 = r1 - m; const unsigned w3 = cvtpk_s(r2, 1.0f);
    unsigned x = (w1 & 0xffffu) | (w2 << 16), y = w3;
    if (hi) { x = 0x3f803f80u; y = 0u; }
    typedef unsigned u32x2 __attribute__((ext_vector_type(2)));
    return __builtin_bit_cast(s16x4, (u32x2){x, y});
}
typedef __attribute__((address_space(3))) const char* lds_cptr;
typedef short v4i16_t __attribute__((ext_vector_type(4)));
__device__ __forceinline__ void kload8(bf16x8* kf, lds_cptr kp) {
    kf[0] = *(const __attribute__((address_space(3))) bf16x8*)(kp);        kf[1] = *(const __attribute__((address_space(3))) bf16x8*)(kp + 512);
    kf[2] = *(const __attribute__((address_space(3))) bf16x8*)(kp + 2048); kf[3] = *(const __attribute__((address_space(3))) bf16x8*)(kp + 2560);
    kf[4] = *(const __attribute__((address_space(3))) bf16x8*)(kp + 4096); kf[5] = *(const __attribute__((address_space(3))) bf16x8*)(kp + 4608);
    kf[6] = *(const __attribute__((address_space(3))) bf16x8*)(kp + 6144); kf[7] = *(const __attribute__((address_space(3))) bf16x8*)(kp + 6656);
}
__device__ __forceinline__ void kload2(bf16x8* kf, lds_cptr kp, int j) { kf[2 * j] = *(const __attribute__((address_space(3))) bf16x8*)(kp + j * 2048); kf[2 * j + 1] = *(const __attribute__((address_space(3))) bf16x8*)(kp + j * 2048 + 512); }
__device__ __forceinline__ void xload2(s16x4* kx, lds_cptr xp) { kx[0] = *(const __attribute__((address_space(3))) s16x4*)(xp); kx[1] = *(const __attribute__((address_space(3))) s16x4*)(xp + 256); }
__device__ __forceinline__ s16x4 vtr(lds_cptr p) { return __builtin_bit_cast(s16x4, __builtin_amdgcn_ds_read_tr16_b64_v4i16((__attribute__((address_space(3))) v4i16_t*)p)); }
__device__ __forceinline__ float rowmax(const f32x16& p0, const f32x16& p1) {
    float a = max3f(p0[0], p0[1], p1[0]), b = max3f(p0[2], p0[3], p1[1]); a = max3f(a, p1[2], p1[3]);
#pragma unroll
    for (int r = 4; r < 16; r += 4) { a = max3f(a, p0[r], p0[r + 1]); b = max3f(b, p0[r + 2], p0[r + 3]); a = max3f(a, p1[r], p1[r + 1]); b = max3f(b, p1[r + 2], p1[r + 3]); }
    const float m = max2f(a, b);
    auto rr = __builtin_amdgcn_permlane32_swap(__float_as_uint(m), __float_as_uint(m), false, false);
    return max2f(__uint_as_float(rr[0]), __uint_as_float(rr[1]));
}
__device__ __forceinline__ void pv(f32x16* o, int vb, bf16x8 pa0, bf16x8 pa1, bf16x8 pa2, bf16x8 pa3) {
#pragma unroll
    for (int d0 = 0; d0 < 2; ++d0) { s16x4 lo[4], hi[4];
#pragma unroll
        for (int ks = 0; ks < 4; ++ks) {
            asm volatile("ds_read_b64_tr_b16 %0,%1 offset:%c2" : "=&v"(lo[ks]) : "v"(vb), "i"(d0 * 4096 + ks * 1024) : "memory");
            asm volatile("ds_read_b64_tr_b16 %0,%1 offset:%c2" : "=&v"(hi[ks]) : "v"(vb), "i"(d0 * 4096 + ks * 1024 + 512) : "memory"); }
        asm volatile("s_waitcnt lgkmcnt(0)" ::: "memory"); SBAR();
#define PK(k) (bf16x8){lo[k][0], lo[k][1], lo[k][2], lo[k][3], hi[k][0], hi[k][1], hi[k][2], hi[k][3]}
        o[d0] = __builtin_amdgcn_mfma_f32_32x32x16_bf16(pa0, PK(0), o[d0], 0, 0, 0);
        o[d0] = __builtin_amdgcn_mfma_f32_32x32x16_bf16(pa1, PK(1), o[d0], 0, 0, 0);
        o[d0] = __builtin_amdgcn_mfma_f32_32x32x16_bf16(pa2, PK(2), o[d0], 0, 0, 0);
        o[d0] = __builtin_amdgcn_mfma_f32_32x32x16_bf16(pa3, PK(3), o[d0], 0, 0, 0);
#undef PK
    }
}
#define MF16(a, b, c) __builtin_amdgcn_mfma_f32_32x32x16_bf16(a, b, c, 0, 0, 0)
#define MF8(a, b, c) __builtin_amdgcn_mfma_f32_32x32x8bf16_1k(a, b, c, 0, 0, 0)

template <int THRL> __device__ __forceinline__ void fox_unit(int b, int h, int qb, const bf16raw* __restrict__ Z, const float* __restrict__ FABS, const unsigned char* __restrict__ KXT,
                                                             bf16raw* MG, const float* __restrict__ gn_a, LAS unsigned char* shm, const int tid) {
    const int lane = tid & 63, r32 = lane & 31, hi = lane >> 5; const int wid = __builtin_amdgcn_readfirstlane(tid >> 6);
    const long rowbase = (long)b * SEQ; const int q0 = qb * QB;
    const size_t hrow = (size_t)(b * NH + h) * SEQ;
    const bf16raw* Qw = Z + ZQA * ZSEC + (hrow + q0 + wid * QBLK) * HD;
    const bf16raw* Kh = Z + ZKA * ZSEC + hrow * HD, *Vh = Z + ZVA * ZSEC + hrow * HD;
    const unsigned char* Xh = KXT + (size_t)(b * NH + h) * (SEQ / 64) * 1024;
    const unsigned lds0 = (unsigned)(uintptr_t)shm;
    LAS float* wsf = (LAS float*)(shm + LDS_WS) + wid * 64;
    const unsigned kvo = (unsigned)(lane * HD + wid * 8) * 2u, vvo = (unsigned)((16 * (wid & 3) + (lane >> 2)) * HD + (wid >> 2) * 32 + (lane & 3) * 8) * 2u, xvo = (unsigned)((wid & 3) * 256 + lane * 4);
    const unsigned kdst = lds0 + LDS_K + wid * 1024, vdst = lds0 + LDS_V + wid * 1024, xdst = lds0 + LDS_K + XOFF + (wid & 3) * 256;
#define DMA_K(t, slot) do { glds16(Kh + (long)(t) * KVBLK * HD, kvo, (unsigned)__builtin_amdgcn_readfirstlane(kdst + (slot))); glds4(Xh + (size_t)(t) * 1024, xvo, (unsigned)__builtin_amdgcn_readfirstlane(xdst + (slot))); } while (0)
#define DMA_V(t, slot) glds16(Vh + (long)(t) * KVBLK * HD, vvo, (unsigned)__builtin_amdgcn_readfirstlane(vdst + (slot)))
    const int vb0 = (int)(lds0 + LDS_V) + ((lane >> 4) & 1) * 32 + (lane & 3) * 8 + (4 * hi + ((lane & 15) >> 2)) * 64;
    bf16x8 kf[8]; s16x4 kx[2];
    const lds_cptr shm3 = (lds_cptr)shm; const lds_cptr kp0 = shm3 + LDS_K + hi * 1024 + r32 * 16; const lds_cptr xp0 = shm3 + LDS_K + XOFF + hi * 512 + r32 * 8;
    const lds_cptr vp0 = shm3 + LDS_V + ((lane >> 4) & 1) * 32 + (lane & 3) * 8 + (4 * hi + ((lane & 15) >> 2)) * 64;
    const int NT = (q0 + QB) / KVBLK;
    DMA_K(0, 0); DMA_V(0, 0); DMA_K(1, SLOTB);
    bf16x8 qr[4];
#pragma unroll
    for (int d0 = 0; d0 < 4; ++d0) qr[d0] = *reinterpret_cast<const bf16x8*>(&Qw[(long)r32 * HD + d0 * 16 + hi * 8]);
    const float fq2 = FABS[(size_t)(b * NH + h) * SEQ + q0 + wid * QBLK + r32] * LOG2E;
    float mhat = 0.f, l_reg = 0.f; f32x16 o[2]; o[0] = f32x16{}; o[1] = f32x16{};
    s16x4 qx = make_qx(fq2, hi);
    const f32x16 zero16 = f32x16{};
    const int qrel = wid * QBLK + r32;
#define CMASK(P0, P1, t) do { int jb_ = (t) - (NT - 4); if (jb_ >= 0) cmask(P0, P1, jb_, qrel, hi); } while (0)
    bool resc = false;
#define START(P0, P1) do { const float rm = rowmax(P0, P1); resc = false; \
    { const float dl = rm; mhat = fadd_s(mhat, dl); \
      _Pragma("unroll") for (int r = 0; r < 16; ++r) { P0[r] = fsub_s(P0[r], dl); P1[r] = fsub_s(P1[r], dl); } \
      qx = make_qx(fq2 - mhat, hi); asm volatile("" : "+v"(qx)); } \
    _Pragma("unroll") for (int r = 0; r < 16; ++r) P0[r] = __builtin_amdgcn_exp2f(P0[r]); } while (0)
#define RESC() do { if (resc) { asm volatile("s_waitcnt lgkmcnt(0)" ::: "memory"); \
      _Pragma("unroll") for (int d_ = 0; d_ < 2; ++d_) _Pragma("unroll") for (int r = 0; r < 16; ++r) o[d_][r] *= wsf[crow(r, hi)]; } } while (0)
    f32x16 pA0, pA1, pB0, pB1;
    int sl_prev = 0, sl_cur = 0, sl_next = SLOTB;
#define ROT() do { sl_prev = sl_cur; sl_cur = sl_next; sl_next = (sl_next == (NSLOT - 1) * SLOTB) ? 0 : sl_next + SLOTB; } while (0)
    DMA_K(2, 2 * SLOTB);
    WAIT_BAR(5);
    kload8(kf, kp0); xload2(kx, xp0);
    pA0 = MF8(kx[0], qx, zero16); pA1 = MF8(kx[1], qx, zero16);
#pragma unroll
    for (int d0 = 0; d0 < 4; ++d0) { pA0 = MF16(kf[2 * d0], qr[d0], pA0); pA1 = MF16(kf[2 * d0 + 1], qr[d0], pA1); }
    asm volatile("s_nop 15\n\ts_nop 7" : "+v"(pA0), "+v"(pA1)); CMASK(pA0, pA1, 0);
    START(pA0, pA1);
    _Pragma("unroll") for (int r = 0; r < 16; ++r) pA1[r] = __builtin_amdgcn_exp2f(pA1[r]);
    WAIT_BAR(0);
    DMA_K(3, 0); DMA_V(1, SLOTB);
    ROT();
    kload8(kf, kp0 + sl_cur); xload2(kx, xp0 + sl_cur);
    WAIT_BAR(3);
    s16x4 vlo[8], vhi[8]; u32x4 pw0, pw1, pw2, pw3;
#define PKW(P, B) cvtpk_s(P[B], P[B + 1])
#define PAF(k) __builtin_bit_cast(bf16x8, pw##k)
#define VFR(i) (bf16x8){vlo[i][0], vlo[i][1], vlo[i][2], vlo[i][3], vhi[i][0], vhi[i][1], vhi[i][2], vhi[i][3]}
#define PIN(x) asm volatile("" : "+v"(x))
#define MX3(a, b, c) __builtin_fmaxf(__builtin_fmaxf((a), (b)), (c))
#define GAPA(MF, A0, A1, A2, A3, W0, W1, PW) do { MF; sacc += A0; sacc += A1; sacc += A2; sacc += A3; PIN(sacc); W0; W1; PIN(PW); SBAR(); } while (0)
#define EX(v) __builtin_amdgcn_exp2f(v)
#define GAPB(MF, X, B) do { MF; X[B] = EX(X[B]); X[B + 1] = EX(X[B + 1]); X[B + 2] = EX(X[B + 2]); X[B + 3] = EX(X[B + 3]); PIN(X); SBAR(); } while (0)
#define VRD(i) do { vlo[i] = vtr(vp_ + (((i) >> 2) * 4096 + ((i) & 3) * 1024)); vhi[i] = vtr(vp_ + (((i) >> 2) * 4096 + ((i) & 3) * 1024 + 512)); } while (0)
#define KRD(G, j) do { if (G) { kload2(kf, kp0 + sl_next, j); SBAR(); } } while (0)
#define XRD(G) do { if (G) { xload2(kx, xp0 + sl_next); SBAR(); } } while (0)
#define STEP(C0, C1, P0, P1, t, GK, GV, GL) do { SBAR(); \
    const lds_cptr vp_ = vp0 + sl_prev; \
    C0 = MF8(kx[0], qx, zero16); C1 = MF8(kx[1], qx, zero16); SBAR(); \
    VRD(0); SBAR(); float sacc = (P0[0] + P0[1]); \
    GAPA(C0 = MF16(kf[0], qr[0], C0), P0[2], P0[3], P0[4], P0[5],     pw0[0] = PKW(P0, 0), pw0[1] = PKW(P0, 2), pw0); \
    VRD(4); SBAR(); GAPA(C1 = MF16(kf[1], qr[0], C1), P0[6], P0[7], P0[8], P0[9],     pw0[2] = PKW(P0, 4), pw0[3] = PKW(P0, 6), pw0); \
    VRD(1); SBAR(); GAPA(C0 = MF16(kf[2], qr[1], C0),   P0[10], P0[11], P0[12], P0[13], pw1[0] = PKW(P0, 8), pw1[1] = PKW(P0, 10), pw1); \
    VRD(5); SBAR(); GAPA(C1 = MF16(kf[3], qr[1], C1),   P0[14], P0[15], P1[0], P1[1],   pw1[2] = PKW(P0, 12), pw1[3] = PKW(P0, 14), pw1); \
    VRD(2); SBAR(); GAPA(C0 = MF16(kf[4], qr[2], C0),   P1[2], P1[3], P1[4], P1[5],     pw2[0] = PKW(P1, 0), pw2[1] = PKW(P1, 2), pw2); \
    VRD(6); SBAR(); GAPA(C1 = MF16(kf[5], qr[2], C1),   P1[6], P1[7], P1[8], P1[9],     pw2[2] = PKW(P1, 4), pw2[3] = PKW(P1, 6), pw2); \
    VRD(3); SBAR(); GAPA(C0 = MF16(kf[6], qr[3], C0),   P1[10], P1[11], P1[12], P1[13], pw3[0] = PKW(P1, 8), pw3[1] = PKW(P1, 10), pw3); \
    VRD(7); SBAR(); GAPA(C1 = MF16(kf[7], qr[3], C1),   P1[14], P1[15], 0.f, 0.f,       pw3[2] = PKW(P1, 12), pw3[3] = PKW(P1, 14), pw3); \
    l_reg += sacc; \
    if (GK) { DMA_K((t) + 3, sl_cur); } if (GV) { DMA_V((t) + 1, sl_next); } \
    CMASK(C0, C1, t); \
    { float a = MX3(C0[0], C0[1], C1[0]), b_ = MX3(C0[2], C0[3], C1[1]); a = MX3(a, C1[2], C1[3]); \
      _Pragma("unroll") for (int r = 4; r < 16; r += 4) { a = MX3(a, C0[r], C0[r + 1]); b_ = MX3(b_, C0[r + 2], C0[r + 3]); a = MX3(a, C1[r], C1[r + 1]); b_ = MX3(b_, C1[r + 2], C1[r + 3]); } \
      float rm = __builtin_fmaxf(a, b_); { auto rr = __builtin_amdgcn_permlane32_swap(__float_as_uint(rm), __float_as_uint(rm), false, false); rm = __builtin_fmaxf(__uint_as_float(rr[0]), __uint_as_float(rr[1])); } \
      resc = false; \
      if (__builtin_expect(__any(rm > (float)THRL), 0)) { const float dl = __builtin_fmaxf(rm, 0.f); mhat += dl; \
        _Pragma("unroll") for (int r = 0; r < 16; ++r) { C0[r] -= dl; C1[r] -= dl; } \
        qx = make_qx(fq2 - mhat, hi); asm volatile("" : "+v"(qx)); \
        const float f = __builtin_amdgcn_exp2f(-dl); l_reg *= f; if (hi == 0) wsf[r32] = f; resc = true; } } \
    SBAR(); \
    GAPB(o[0] = MF16(PAF(0), VFR(0), o[0]), C0, 0); \
    GAPB(o[1] = MF16(PAF(0), VFR(4), o[1]), C0, 4); \
    KRD(GL, 0); GAPB(o[0] = MF16(PAF(1), VFR(1), o[0]), C0, 8); \
    KRD(GL, 1); GAPB(o[1] = MF16(PAF(1), VFR(5), o[1]), C0, 12); \
    KRD(GL, 2); GAPB(o[0] = MF16(PAF(2), VFR(2), o[0]), C1, 0); \
    KRD(GL, 3); GAPB(o[1] = MF16(PAF(2), VFR(6), o[1]), C1, 4); \
    XRD(GL); GAPB(o[0] = MF16(PAF(3), VFR(3), o[0]), C1, 8); \
    GAPB(o[1] = MF16(PAF(3), VFR(7), o[1]), C1, 12); \
    } while (0)
    int t = 1;
#undef CMASK
#define CMASK(P0, P1, t) do { } while (0)
    for (; t + 5 < NT; t += 2) {
        STEP(pB0, pB1, pA0, pA1, t, true, true, true);     WAIT_BAR(3); RESC(); ROT();
        STEP(pA0, pA1, pB0, pB1, t + 1, true, true, true); WAIT_BAR(3); RESC(); ROT();
    }
#undef CMASK
#define CMASK(P0, P1, t) do { int jb_ = (t) - (NT - 4); if (jb_ >= 0) cmask(P0, P1, jb_, qrel, hi); } while (0)
#define ENDW(tt) do { if ((tt) + 3 < NT) { WAIT_BAR(3); } else if ((tt) + 2 < NT) { WAIT_BAR(1); } else { WAIT_BAR(0); } } while (0)
    for (; t + 1 < NT; t += 2) {
        STEP(pB0, pB1, pA0, pA1, t, (t + 3 < NT), (t + 1 < NT), (t + 1 < NT));         ENDW(t);     RESC(); ROT();
        STEP(pA0, pA1, pB0, pB1, t + 1, (t + 4 < NT), (t + 2 < NT), (t + 2 < NT));     ENDW(t + 1); RESC(); ROT();
    }
    STEP(pB0, pB1, pA0, pA1, NT - 1, false, false, false); RESC();
    { float sacc = pB0[0] + pB0[1]; _Pragma("unroll") for (int r = 2; r < 16; ++r) sacc += pB0[r]; _Pragma("unroll") for (int r = 0; r < 16; ++r) sacc += pB1[r]; l_reg += sacc;
      pw0 = (u32x4){PKW(pB0, 0), PKW(pB0, 2), PKW(pB0, 4), PKW(pB0, 6)}; pw1 = (u32x4){PKW(pB0, 8), PKW(pB0, 10), PKW(pB0, 12), PKW(pB0, 14)};
      pw2 = (u32x4){PKW(pB1, 0), PKW(pB1, 2), PKW(pB1, 4), PKW(pB1, 6)}; pw3 = (u32x4){PKW(pB1, 8), PKW(pB1, 10), PKW(pB1, 12), PKW(pB1, 14)};
      SBAR(); pv(o, vb0 + sl_cur, PAF(0), PAF(1), PAF(2), PAF(3)); }
#undef PKW
#undef PAF
#undef VFR
#undef PIN
#undef MX3
#undef GAPA
#undef GAPB
#undef EX
#undef VRD
#undef KRD
#undef XRD
#undef STEP
#undef ENDW
    { auto rr = __builtin_amdgcn_permlane32_swap(__float_as_uint(l_reg), __float_as_uint(l_reg), false, false); l_reg = __uint_as_float(rr[0]) + __uint_as_float(rr[1]); }
    if (hi == 0) wsf[32 + r32] = l_reg; asm volatile("s_waitcnt lgkmcnt(0)" ::: "memory");
    float rli[16];
#pragma unroll
    for (int r = 0; r < 16; ++r) rli[r] = __builtin_amdgcn_rcpf(wsf[32 + crow(r, hi)]);
    { LAS float* stg = (LAS float*)(shm + LDS_OST + wid * OST_BYTES);
#pragma unroll
      for (int r = 0; r < 16; ++r) { const int orow = crow(r, hi);
#pragma unroll
          for (int d0 = 0; d0 < 2; ++d0) stg[orow * OST_STRIDE + d0 * 32 + r32] = o[d0][r] * rli[r]; }
      asm volatile("s_waitcnt lgkmcnt(0)" ::: "memory");
      bf16raw* Ow = MG + (rowbase + q0 + wid * QBLK) * DM + h * HD;
#pragma unroll
      for (int i = 0; i < 4; ++i) { const int row = i * 8 + (lane >> 3), c8 = (lane & 7) * 8;
          const v4f a = *(const LAS v4f*)(stg + row * OST_STRIDE + c8), c = *(const LAS v4f*)(stg + row * OST_STRIDE + c8 + 4);
          float ss = (a[0] * a[0] + a[1] * a[1]) + (a[2] * a[2] + a[3] * a[3]) + (c[0] * c[0] + c[1] * c[1]) + (c[2] * c[2] + c[3] * c[3]);
          ss = sum8_dpp(ss);
          const float rs = 1.0f / sqrtf(ss * (1.0f / 64.0f) + RMS_EPS);
          const v4f g0 = *(const v4f*)(gn_a + h * HD + c8), g1 = *(const v4f*)(gn_a + h * HD + c8 + 4);
          u32x4 w; w.x = cvtpk_s(a[0] * rs * g0[0], a[1] * rs * g0[1]); w.y = cvtpk_s(a[2] * rs * g0[2], a[3] * rs * g0[3]);
          w.z = cvtpk_s(c[0] * rs * g1[0], c[1] * rs * g1[1]); w.w = cvtpk_s(c[2] * rs * g1[2], c[3] * rs * g1[3]);
          *(u32x4*)(Ow + (long)row * DM + c8) = w; } }
    asm volatile("s_waitcnt lgkmcnt(0)\n\ts_barrier" ::: "memory");
#undef DMA_K
#undef DMA_V
#undef CMASK
#undef START
#undef RESC
#undef ROT
}
#undef SBAR
#undef WAIT_BAR
#undef MF16
#undef MF8
}

namespace dil {
typedef short bf16x8 __attribute__((ext_vector_type(8)));
typedef short s16x4 __attribute__((ext_vector_type(4)));
typedef float f32x16 __attribute__((ext_vector_type(16)));
constexpr int LDS_K = 0, LDS_V = 49152, LDS_BYTES = 98304;
constexpr int N_UNITS = NB * NH * 48;
__device__ __forceinline__ int crow(int r, int hi) { return (r & 3) + 8 * (r >> 2) + 4 * hi; }
__device__ __forceinline__ void glds16(const void* sbase, unsigned voff, unsigned lds_dst) { unsigned keep;
    asm volatile("s_mov_b32 %0, m0\n\ts_mov_b32 m0, %3\n\ts_nop 0\n\tglobal_load_lds_dwordx4 %1, %2\n\ts_mov_b32 m0, %0" : "=&s"(keep) : "v"(voff), "s"(sbase), "s"(lds_dst) : "memory"); }
typedef float f32x2_t __attribute__((ext_vector_type(2))); typedef __bf16 bf16x2_t __attribute__((ext_vector_type(2)));
__device__ __forceinline__ unsigned cvtpk_s(float lo, float hi) { f32x2_t v = {lo, hi}; bf16x2_t b = __builtin_convertvector(v, bf16x2_t); return __builtin_bit_cast(unsigned, b); }
typedef __attribute__((address_space(3))) const char* lds_cptr;
typedef short v4i16_t __attribute__((ext_vector_type(4)));
__device__ __forceinline__ s16x4 vtr(lds_cptr p) { return __builtin_bit_cast(s16x4, __builtin_amdgcn_ds_read_tr16_b64_v4i16((__attribute__((address_space(3))) v4i16_t*)p)); }
#define DMF16(a, b, c) __builtin_amdgcn_mfma_f32_32x32x16_bf16(a, b, c, 0, 0, 0)
struct DU { int b, h, pat, d, cls, i0; };
__device__ __forceinline__ DU decode(int u) { DU U; const int bh = u / 48, r = u % 48; U.b = bh >> 3; U.h = bh & 7;
    if (r < 16) { U.pat = 0; U.d = 1; U.cls = 0; U.i0 = 256 * r; }
    else if (r < 32) { U.pat = 1; U.d = 4; U.cls = (r - 16) >> 2; U.i0 = 256 * ((r - 16) & 3); }
    else { U.pat = 2; U.d = 16; U.cls = r - 32; U.i0 = 0; }
    return U; }
__device__ __forceinline__ void issue_K(const DU& U, const bf16raw* Z, unsigned lds0, int wid, int lane) {
    const bf16raw* base = Z + ZKB * ZSEC + ((size_t)(U.b * NH + U.h) * SEQ + U.cls) * HD; const unsigned stride = (unsigned)U.d * HD * 2u;
#pragma unroll
    for (int t = 0; t < 6; ++t) { int sp = U.i0 - 128 + 64 * t + lane; sp = sp < 0 ? 0 : sp;
        glds16(base, (unsigned)sp * stride + (unsigned)wid * 16u, (unsigned)__builtin_amdgcn_readfirstlane(lds0 + LDS_K + t * 8192 + wid * 1024)); }
}
__device__ __forceinline__ void issue_V(const DU& U, const bf16raw* Z, unsigned lds0, int wid, int lane) {
    const bf16raw* base = Z + ZVB * ZSEC + ((size_t)(U.b * NH + U.h) * SEQ + U.cls) * HD; const unsigned stride = (unsigned)U.d * HD * 2u;
#pragma unroll
    for (int t = 0; t < 6; ++t) { int sp = U.i0 - 128 + 64 * t + 16 * (wid & 3) + (lane >> 2); sp = sp < 0 ? 0 : sp;
        glds16(base, (unsigned)sp * stride + (unsigned)(((wid >> 2) * 32 + (lane & 3) * 8) * 2), (unsigned)__builtin_amdgcn_readfirstlane(lds0 + LDS_V + t * 8192 + wid * 1024)); }
}
__device__ __forceinline__ void load_q(bf16x8* q, const DU& U, const bf16raw* Z, int wid, int r32, int hi) {
    const bf16raw* qp = Z + ZQB * ZSEC + ((size_t)(U.b * NH + U.h) * SEQ + U.cls + (size_t)(U.i0 + wid * 32 + r32) * U.d) * HD + hi * 8;
#pragma unroll
    for (int d0 = 0; d0 < 4; ++d0) q[d0] = *(const bf16x8*)(qp + d0 * 16);
}
__device__ __forceinline__ void dil_phase(int u_lo, int u_hi, const bf16raw* __restrict__ Z, bf16raw* OP, float* LSE, LAS unsigned char* shm, const int tid) {
    if (u_lo >= u_hi) return;
    const int lane = tid & 63, r32 = lane & 31, hi = lane >> 5; const int wid = __builtin_amdgcn_readfirstlane(tid >> 6);
    const unsigned lds0 = (unsigned)(uintptr_t)shm; const lds_cptr shm3 = (lds_cptr)shm;
    const int t0 = wid >> 1, lo = 32 * (wid & 1) + r32;
    const lds_cptr kp0 = shm3 + LDS_K + t0 * 8192 + hi * 1024 + r32 * 16;
    const lds_cptr vp0 = shm3 + LDS_V + t0 * 8192 + ((lane >> 4) & 1) * 32 + (lane & 3) * 8 + (4 * hi + ((lane & 15) >> 2)) * 64;
    DU U = decode(u_lo);
    bf16x8 qr[4], qn[4];
    load_q(qr, U, Z, wid, r32, hi);
#pragma unroll
    for (int d0 = 0; d0 < 4; ++d0) asm volatile("" : "+v"(qr[d0]));
    issue_K(U, Z, lds0, wid, lane); issue_V(U, Z, lds0, wid, lane);
    v2u po[8]; float lse_prev = 0.f; long grow_prev = 0; int pat_prev = 0, h_prev = 0; bool have_prev = false;
#pragma unroll
    for (int i = 0; i < 8; ++i) po[i] = (v2u){0u, 0u};
    for (int u = u_lo; u < u_hi; ++u) {
        const bool has_next = (u + 1 < u_hi);
        DU Un = U; if (has_next) Un = decode(u + 1);
        asm volatile("s_waitcnt vmcnt(6)\n\ts_barrier" ::: "memory");
        if (has_next) load_q(qn, Un, Z, wid, r32, hi);
        if (have_prev) {
            bf16raw* op = OP + ((size_t)pat_prev * MTOK + grow_prev) * 512 + h_prev * HD + 4 * hi;
#pragma unroll
            for (int i = 0; i < 8; ++i) *(v2u*)(op + (i >> 2) * 32 + (i & 3) * 8) = po[i];
            if (hi == 0) LSE[((size_t)pat_prev * MTOK + grow_prev) * NH + h_prev] = lse_prev;
        }
        f32x16 s[3][2];
#pragma unroll
        for (int j = 0; j < 3; ++j) {
            bf16x8 kf[8];
#pragma unroll
            for (int c = 0; c < 4; ++c) { kf[2 * c] = *(const __attribute__((address_space(3))) bf16x8*)(kp0 + j * 8192 + c * 2048); kf[2 * c + 1] = *(const __attribute__((address_space(3))) bf16x8*)(kp0 + j * 8192 + c * 2048 + 512); }
            s[j][0] = DMF16(kf[0], qr[0], (f32x16){}); s[j][1] = DMF16(kf[1], qr[0], (f32x16){});
#pragma unroll
            for (int c = 1; c < 4; ++c) { s[j][0] = DMF16(kf[2 * c], qr[c], s[j][0]); s[j][1] = DMF16(kf[2 * c + 1], qr[c], s[j][1]); }
        }
        const float NEGI = -INFINITY;
#pragma unroll
        for (int r = 0; r < 16; ++r) { const int x = crow(r, hi);
            if (x < lo) s[0][0][r] = NEGI; if (x + 32 < lo) s[0][1][r] = NEGI;
            if (x > lo) s[2][0][r] = NEGI; if (x + 32 > lo) s[2][1][r] = NEGI; }
        if (U.i0 == 0 && t0 < 2) {
#pragma unroll
            for (int r = 0; r < 16; ++r) { s[0][0][r] = NEGI; s[0][1][r] = NEGI; if (t0 == 0) { s[1][0][r] = NEGI; s[1][1][r] = NEGI; } } }
        float m = NEGI;
#pragma unroll
        for (int j = 0; j < 3; ++j)
#pragma unroll
            for (int r = 0; r < 16; ++r) m = fmaxf(m, fmaxf(s[j][0][r], s[j][1][r]));
        { auto rr = __builtin_amdgcn_permlane32_swap(__float_as_uint(m), __float_as_uint(m), false, false); m = fmaxf(__uint_as_float(rr[0]), __uint_as_float(rr[1])); }
        float l = 0.f;
#pragma unroll
        for (int j = 0; j < 3; ++j)
#pragma unroll
            for (int r = 0; r < 16; ++r) { s[j][0][r] = __builtin_amdgcn_exp2f(s[j][0][r] - m); s[j][1][r] = __builtin_amdgcn_exp2f(s[j][1][r] - m); l += s[j][0][r] + s[j][1][r]; }
        { auto rr = __builtin_amdgcn_permlane32_swap(__float_as_uint(l), __float_as_uint(l), false, false); l = __uint_as_float(rr[0]) + __uint_as_float(rr[1]); }
        v4u pw[3][4];
#pragma unroll
        for (int j = 0; j < 3; ++j)
#pragma unroll
            for (int k = 0; k < 4; ++k) { const f32x16& ps = s[j][k >> 1]; const int b0 = (k & 1) * 8;
                pw[j][k] = (v4u){cvtpk_s(ps[b0], ps[b0 + 1]), cvtpk_s(ps[b0 + 2], ps[b0 + 3]), cvtpk_s(ps[b0 + 4], ps[b0 + 5]), cvtpk_s(ps[b0 + 6], ps[b0 + 7])}; }
        asm volatile("s_waitcnt vmcnt(0) lgkmcnt(0)\n\ts_barrier" ::: "memory");
        if (has_next) {
#pragma unroll
            for (int d0 = 0; d0 < 4; ++d0) asm volatile("" : "+v"(qn[d0]));
            issue_K(Un, Z, lds0, wid, lane);
        }
        f32x16 o[2]; o[0] = (f32x16){}; o[1] = (f32x16){};
#pragma unroll
        for (int j = 0; j < 3; ++j) {
            const lds_cptr vp = vp0 + j * 8192;
#pragma unroll
            for (int i = 0; i < 8; ++i) { const int d0 = i >> 2, ks = i & 3;
                const s16x4 a = vtr(vp + d0 * 4096 + ks * 1024), b2 = vtr(vp + d0 * 4096 + ks * 1024 + 512);
                const bf16x8 vf = (bf16x8){a[0], a[1], a[2], a[3], b2[0], b2[1], b2[2], b2[3]};
                o[d0] = DMF16(vf, __builtin_bit_cast(bf16x8, pw[j][ks]), o[d0]); }
        }
        asm volatile("s_waitcnt lgkmcnt(0)\n\ts_barrier" ::: "memory");
        if (has_next) issue_V(Un, Z, lds0, wid, lane);
        const float inv = 1.0f / l;
#pragma unroll
        for (int i = 0; i < 8; ++i) { const int d0 = i >> 2, g = i & 3;
            po[i] = (v2u){cvtpk_s(o[d0][4 * g] * inv, o[d0][4 * g + 1] * inv), cvtpk_s(o[d0][4 * g + 2] * inv, o[d0][4 * g + 3] * inv)}; }
        lse_prev = m + __builtin_amdgcn_logf(l);
        grow_prev = (long)U.b * SEQ + U.cls + (long)(U.i0 + wid * 32 + r32) * U.d; pat_prev = U.pat; h_prev = U.h; have_prev = true;
        if (has_next) {
#pragma unroll
            for (int d0 = 0; d0 < 4; ++d0) qr[d0] = qn[d0];
            U = Un; }
    }
    { bf16raw* op = OP + ((size_t)pat_prev * MTOK + grow_prev) * 512 + h_prev * HD + 4 * hi;
#pragma unroll
      for (int i = 0; i < 8; ++i) *(v2u*)(op + (i >> 2) * 32 + (i & 3) * 8) = po[i];
      if (hi == 0) LSE[((size_t)pat_prev * MTOK + grow_prev) * NH + h_prev] = lse_prev; }
    asm volatile("s_waitcnt vmcnt(0) lgkmcnt(0)\n\ts_barrier" ::: "memory");
}
#undef DMF16
}
#define XB_TMO      128
#define XB_XCNT(j)  (256  + 64 * (j))
#define XB_XSUB(j)  (1280 + 64 * (j))
#define XB_XGEN(j)  (2304 + 64 * (j))
#define XB_TOP      3328
#define XB_TOPGEN   3392
#define XCD_BAR_WORDS 3456
#define XB_SPIN_CAP (1u << 18)

__device__ __forceinline__ unsigned xb_ld(unsigned* p)              { return __hip_atomic_load(p, __ATOMIC_RELAXED, __HIP_MEMORY_SCOPE_AGENT); }
__device__ __forceinline__ unsigned xb_add(unsigned* p, unsigned v) { return __hip_atomic_fetch_add(p, v, __ATOMIC_RELAXED, __HIP_MEMORY_SCOPE_AGENT); }
__device__ __forceinline__ unsigned xb_xcc_id() { return (unsigned)__builtin_amdgcn_s_getreg((3 << 11) | 20) & 0xFu; }
#define XB_SPIN(cond, bar) do { unsigned _sp = 0; while (cond) { __builtin_amdgcn_s_sleep(1); \
    if ((++_sp & 255u) == 0u) { if (xb_ld(&(bar)[XB_TMO])) break; if (_sp > XB_SPIN_CAP) { atomicAdd(&(bar)[XB_TMO], 1u); break; } } } } while (0)

struct XcdBarrier {
    unsigned* bar; unsigned x;
    volatile LAS unsigned* st;
};

__device__ __forceinline__ XcdBarrier xcd_barrier_post(unsigned* bar, volatile LAS unsigned* st, const int tid) {
    XcdBarrier b; b.bar = bar; b.x = xb_xcc_id(); b.st = st;
    if (tid == 0) (void)xb_add(&bar[XB_XCNT(b.x)], 1u);
    return b;
}
__device__ __forceinline__ void xcd_barrier_complete(unsigned* bar, unsigned x, unsigned& nloc, unsigned& nx) {
    const unsigned G = gridDim.x * gridDim.y * gridDim.z;
    unsigned sum, cnt, mine, sp = 0u;
    for (;;) {
        sum = 0u; cnt = 0u; mine = 0u;
#pragma unroll
        for (unsigned j = 0; j < 16; ++j) { const unsigned c = xb_ld(&bar[XB_XCNT(j)]); sum += c; cnt += (c > 0u) ? 1u : 0u; mine = (j == x) ? c : mine; }
        if (sum == G) break;
        __builtin_amdgcn_s_sleep(1);
        if ((++sp & 255u) == 0u) { if (xb_ld(&bar[XB_TMO])) break; if (sp > XB_SPIN_CAP) { atomicAdd(&bar[XB_TMO], 1u); break; } }
    }
    nloc = mine > 0u ? mine : 1u; nx = cnt > 0u ? cnt : 1u;
}

__device__ __forceinline__ void xcd_barrier(const XcdBarrier& b, const int tid) {
    asm volatile("s_waitcnt vmcnt(0)" ::: "memory");
    __syncthreads();
    if (tid == 0) {
        unsigned* bar = b.bar;
        __builtin_amdgcn_s_waitcnt(0);
        unsigned nloc = b.st[0], nx = b.st[1];
        if (nloc == 0u) { xcd_barrier_complete(bar, b.x, nloc, nx); b.st[0] = nloc; b.st[1] = nx; }
        const unsigned old = xb_add(&bar[XB_XSUB(b.x)], 1u);
        const unsigned gen = old / nloc;
        if (old + 1u == (gen + 1u) * nloc) {
            __builtin_amdgcn_fence(__ATOMIC_RELEASE, "agent");
            asm volatile("s_waitcnt vmcnt(0)" ::: "memory");
            const unsigned og = xb_add(&bar[XB_TOP], 1u);
            const unsigned tg = og / nx;
            if (og + 1u == (tg + 1u) * nx) xb_add(&bar[XB_TOPGEN], 1u);
            else XB_SPIN(xb_ld(&bar[XB_TOPGEN]) == tg, bar);
            __builtin_amdgcn_fence(__ATOMIC_ACQUIRE, "agent");
            xb_add(&bar[XB_XGEN(b.x)], 1u);
            asm volatile("s_waitcnt vmcnt(0)" ::: "memory");
        } else {
            XB_SPIN(xb_ld(&bar[XB_XGEN(b.x)]) == gen, bar);
            __builtin_amdgcn_fence(__ATOMIC_ACQUIRE, "agent");
            asm volatile("s_waitcnt vmcnt(0)" ::: "memory");
        }
    }
    __syncthreads();
}

constexpr size_t MiB = 1u << 20;
#define RLX_AGENT __ATOMIC_RELAXED, __HIP_MEMORY_SCOPE_AGENT
constexpr size_t WS_ADA = 1 * MiB;
constexpr size_t WS_WIN = 2 * MiB, WS_WOUT = 9 * MiB, WS_WUP = 12 * MiB, WS_WDN = 24 * MiB;
constexpr size_t WS_FLOC = 30 * MiB, WS_FABS = 32 * MiB;
constexpr size_t WS_CT = 34 * MiB;
constexpr size_t WS_CS = 36 * MiB;
constexpr size_t WS_LSE = 40 * MiB;
constexpr size_t WS_ST1 = 48 * MiB;
constexpr size_t WS_KXT = 52 * MiB;
constexpr size_t WS_H = 64 * MiB;
constexpr size_t WS_Z = 192 * MiB;
constexpr size_t WS_OP = 576 * MiB;
constexpr size_t WS_MG = 768 * MiB;
constexpr size_t WS_G = 192 * MiB;
constexpr size_t WS_ULAST = 544 * MiB, WS_YFIRST = 576 * MiB;
constexpr size_t WS_END = 896 * MiB;

constexpr int LDS_BYTES = 147456;
constexpr int RING_BYTES = 131072;

struct Params {
    const float *x, *c; const int* pos; const float *w_ada, *b_ada, *w_in, *b_fgate, *gn_a, *gn_b, *w_out, *ln1_g, *ln1_b, *w_up, *conv_w, *conv_b, *w_down, *ln2_g, *ln2_b;
    float* out; unsigned char* ws; int ph_lo, ph_hi;
};

__device__ __forceinline__ int src_in(int n) {
    if (n < 1536) return n;
    const int s = n & 63; int sd = s;
    if (n < 2560 && s < 16) { const int a = s >> 2; sd = ((((a & 1) << 1) | (a >> 1)) << 2) | (s & 3); }
    return n - s + sd + 8;
}
__device__ __forceinline__ int src_up(int n) { return DFF * ((n >> 7) & 1) + 128 * (n >> 8) + (n & 127); }
template <int MAP> __device__ __forceinline__ void transpose_item(const float* W, int ldw, int K, int N, bf16raw* WT, LAS float* scr, int item, int lane) {
    const int nblk = N / 32, kb = item / nblk, nb = item % nblk, k0 = 64 * kb, n0 = 32 * nb;
    const int nsrc = (MAP == 1) ? src_in(n0 + (lane & 31)) : (MAP == 2) ? src_up(n0 + (lane & 31)) : n0 + (lane & 31);
#pragma unroll 8
    for (int i = 0; i < 32; ++i) { const int kk = 2 * i + (lane >> 5); scr[kk * 33 + (lane & 31)] = W[(size_t)(k0 + kk) * ldw + nsrc]; }
    asm volatile("s_waitcnt lgkmcnt(0)" ::: "memory");
    const int c = lane & 7;
#pragma unroll
    for (int j = 0; j < 4; ++j) { const int n = (lane >> 3) + 8 * j; const LAS float* s = scr + (8 * c) * 33 + n;
        v4u o; o.x = pk2(s[0 * 33], s[1 * 33]); o.y = pk2(s[2 * 33], s[3 * 33]); o.z = pk2(s[4 * 33], s[5 * 33]); o.w = pk2(s[6 * 33], s[7 * 33]);
        *(v4u*)(WT + (size_t)(n0 + n) * K + k0 + 8 * c) = o; }
    asm volatile("s_waitcnt lgkmcnt(0)" ::: "memory");
}

__device__ __forceinline__ void phase_prologue(const Params& p, LAS unsigned char* lds, const int tid) {
    const int lane = tid & 63, wave = __builtin_amdgcn_readfirstlane(tid >> 6);
    float* ADA = (float*)(p.ws + WS_ADA);
    for (int task = blockIdx.x; task < 96; task += gridDim.x) {
        LAS float* scT = (LAS float*)lds;
        LAS float* red = (LAS float*)(lds + 65536);
        for (int i = tid; i < NB * DM; i += 512) { const int b = i >> 10, k = i & 1023; const float v = p.c[i]; scT[k * 16 + b] = v / (1.0f + __expf(-v)); }
        __syncthreads();
        const int col = task * 64 + lane;
        float acc[16];
#pragma unroll
        for (int b = 0; b < 16; ++b) acc[b] = 0.f;
#pragma unroll 4
        for (int kk = 0; kk < 128; ++kk) { const int k = wave * 128 + kk; const float wv = p.w_ada[(size_t)k * (6 * DM) + col];
#pragma unroll
            for (int q = 0; q < 4; ++q) { const v4f s4 = *(const LAS v4f*)(scT + k * 16 + 4 * q);
                acc[4 * q + 0] += s4[0] * wv; acc[4 * q + 1] += s4[1] * wv; acc[4 * q + 2] += s4[2] * wv; acc[4 * q + 3] += s4[3] * wv; } }
#pragma unroll
        for (int b = 0; b < 16; ++b) red[(wave * 16 + b) * 64 + lane] = acc[b];
        __syncthreads();
        for (int i = tid; i < 16 * 64; i += 512) { const int b = i >> 6, cl = i & 63; float s = p.b_ada[task * 64 + cl];
#pragma unroll
            for (int w = 0; w < 8; ++w) s += red[(w * 16 + b) * 64 + cl];
            ADA[(size_t)b * (6 * DM) + task * 64 + cl] = s; }
        __syncthreads();
    }
    LAS float* scr = (LAS float*)(lds + wave * 16384);
    const int gw = blockIdx.x * 8 + wave, NGW = gridDim.x * 8;
    constexpr int I_IN = (DM / 64) * (NZ / 32), I_OUT = (DM / 64) * (DM / 32), I_UP = (DM / 64) * (NUP / 32), I_DN = (DFF / 64) * (DM / 32);
    for (int it = gw; it < I_IN + I_OUT + I_UP + I_DN; it += NGW) {
        int r = it;
        if (r < I_IN) { transpose_item<1>(p.w_in, DIN, DM, NZ, (bf16raw*)(p.ws + WS_WIN), scr, r, lane); continue; } r -= I_IN;
        if (r < I_OUT) { transpose_item<0>(p.w_out, DM, DM, DM, (bf16raw*)(p.ws + WS_WOUT), scr, r, lane); continue; } r -= I_OUT;
        if (r < I_UP) { transpose_item<2>(p.w_up, NUP, DM, NUP, (bf16raw*)(p.ws + WS_WUP), scr, r, lane); continue; } r -= I_UP;
        transpose_item<0>(p.w_down, DM, DFF, DM, (bf16raw*)(p.ws + WS_WDN), scr, r, lane);
    }
}

__device__ __forceinline__ void phase_pre1(const Params& p, LAS unsigned char* lds, const int tid) {
    const int lane = tid & 63, wave = __builtin_amdgcn_readfirstlane(tid >> 6);
    const float* ADA = (const float*)(p.ws + WS_ADA);
    bf16raw* H = (bf16raw*)(p.ws + WS_H);
    float* FLOC = (float*)(p.ws + WS_FLOC); float* CT = (float*)(p.ws + WS_CT); float* CS = (float*)(p.ws + WS_CS);
    LAS float* lfs = (LAS float*)lds;
    float wf[4][4][8];
#pragma unroll
    for (int j = 0; j < 4; ++j)
#pragma unroll
        for (int e = 0; e < 4; ++e) { const float* wp = p.w_in + (size_t)(4 * lane + 256 * j + e) * DIN + 1536;
            const v4f a = *(const v4f*)wp, b = *(const v4f*)(wp + 4);
            wf[j][e][0] = a[0]; wf[j][e][1] = a[1]; wf[j][e][2] = a[2]; wf[j][e][3] = a[3]; wf[j][e][4] = b[0]; wf[j][e][5] = b[1]; wf[j][e][6] = b[2]; wf[j][e][7] = b[3]; }
    for (int chunk = blockIdx.x; chunk < MTOK / 256; chunk += gridDim.x) {
        const int b = chunk >> 4, t0 = (chunk & 15) * 256;
        v4f sc[4], sh[4];
#pragma unroll
        for (int j = 0; j < 4; ++j) { sh[j] = *(const v4f*)(ADA + (size_t)b * (6 * DM) + 4 * lane + 256 * j); sc[j] = *(const v4f*)(ADA + (size_t)b * (6 * DM) + DM + 4 * lane + 256 * j) + 1.0f; }
        for (int i = 0; i < 32; ++i) {
            const int rl = wave * 32 + i; const size_t row = (size_t)b * SEQ + t0 + rl;
            const v4f* xr = (const v4f*)(p.x + row * DM) + lane;
            float s[8];
#pragma unroll
            for (int hh = 0; hh < 8; ++hh) s[hh] = 0.f;
            unsigned long long* o8 = (unsigned long long*)(H + row * DM) + lane;
#pragma unroll
            for (int j = 0; j < 4; ++j) { const v4f hv = xr[64 * j] * sc[j] + sh[j];
                o8[64 * j] = (unsigned long long)pk2(hv[0], hv[1]) | ((unsigned long long)pk2(hv[2], hv[3]) << 32);
#pragma unroll
                for (int e = 0; e < 4; ++e)
#pragma unroll
                    for (int hh = 0; hh < 8; ++hh) s[hh] += hv[e] * wf[j][e][hh]; }
#pragma unroll
            for (int hh = 0; hh < 8; ++hh) s[hh] = wave_sum(s[hh]);
            if (lane < 8) { float v = s[0];
#pragma unroll
                for (int hh = 1; hh < 8; ++hh) v = (lane == hh) ? s[hh] : v;
                v += p.b_fgate[lane];
                lfs[rl * 8 + lane] = fminf(v, 0.f) - log1pf(expf(-fabsf(v))); }
        }
        for (int i = tid; i < 256 * 8; i += 512) { const int rl = i >> 3, fi = i & 7; const size_t row = (size_t)b * SEQ + t0 + rl;
            const float fr = (fi == 0) ? 1.0f : (fi == 1) ? 0.1939227432012558f : (fi == 2) ? 0.03760603070259094f : (fi == 3) ? 0.007292664609849453f : (fi == 4) ? 0.0014142135623842478f
                           : (fi == 5) ? 0.00027424818836152554f : (fi == 6) ? 5.3182957344688475e-05f : 1.0313385246263351e-05f;
            double rev = (double)p.pos[row] * (double)fr * 0.15915494309189535; rev -= __builtin_floor(rev);
            const float rf = (float)rev;
            CS[row * 16 + fi] = __builtin_amdgcn_cosf(rf); CS[row * 16 + 8 + fi] = __builtin_amdgcn_sinf(rf); }
        __syncthreads();
        { const int hh = wave; float a0 = lfs[(4 * lane + 0) * 8 + hh], a1 = lfs[(4 * lane + 1) * 8 + hh], a2 = lfs[(4 * lane + 2) * 8 + hh], a3 = lfs[(4 * lane + 3) * 8 + hh];
          a1 += a0; a2 += a1; a3 += a2; float run = a3;
#pragma unroll
          for (int o = 1; o < 64; o <<= 1) { const float v = __shfl_up(run, o); if (lane >= o) run += v; }
          const float excl = run - a3;
          *(v4f*)(FLOC + (size_t)(b * NH + hh) * SEQ + t0 + 4 * lane) = (v4f){a0 + excl, a1 + excl, a2 + excl, a3 + excl};
          if (lane == 63) CT[(b * NH + hh) * 16 + (chunk & 15)] = run; }
        __syncthreads();
    }
}
__device__ __forceinline__ void phase_fabs(const Params& p, const int tid) {
    const float* FLOC = (const float*)(p.ws + WS_FLOC); const float* CT = (const float*)(p.ws + WS_CT); float* FABS = (float*)(p.ws + WS_FABS);
    for (int i = blockIdx.x * 512 + tid; i < NB * NH * SEQ; i += gridDim.x * 512) {
        const int bh = i >> 12, t = i & 4095, ch = t >> 8; float off = 0.f;
        for (int c2 = 0; c2 < ch; ++c2) off += CT[bh * 16 + c2];
        const float F = FLOC[i] + off; FABS[i] = F;
        const float bq = -F * LOG2E; const unsigned w1 = f2bf(bq); const float r1 = bq - __builtin_bit_cast(float, w1 << 16); const unsigned w2 = f2bf(r1);
        const float r2 = r1 - __builtin_bit_cast(float, w2 << 16); const unsigned w3 = f2bf(r2);
        unsigned char* img = p.ws + WS_KXT + ((size_t)bh * (SEQ / 64) + (t >> 6)) * 1024 + (t & 63) * 8;
        *(v2u*)img = (v2u){0x3f803f80u, 0x3f80u | (w1 << 16)}; *(v2u*)(img + 512) = (v2u){w2 | (w3 << 16), 0u}; }
}
__device__ __forceinline__ void phase_merge(const Params& p, const int tid) {
    const int lane = tid & 63, wave = tid >> 6;
    const bf16raw* OP = (const bf16raw*)(p.ws + WS_OP); const float* LSE = (const float*)(p.ws + WS_LSE); bf16raw* MG = (bf16raw*)(p.ws + WS_MG);
    const int hh = lane >> 3;
    const v4f g0 = *(const v4f*)(p.gn_b + lane * 8), g1 = *(const v4f*)(p.gn_b + lane * 8 + 4);
    for (size_t row = (size_t)blockIdx.x * 8 + wave; row < (size_t)MTOK; row += (size_t)gridDim.x * 8) {
        float ls[3]; v4u w[3];
#pragma unroll
        for (int q = 0; q < 3; ++q) { ls[q] = LSE[((size_t)q * MTOK + row) * NH + hh]; w[q] = *(const v4u*)(OP + ((size_t)q * MTOK + row) * 512 + lane * 8); }
        const float mx = fmaxf(ls[0], fmaxf(ls[1], ls[2]));
        float e[3]; e[0] = __builtin_amdgcn_exp2f(ls[0] - mx); e[1] = __builtin_amdgcn_exp2f(ls[1] - mx); e[2] = __builtin_amdgcn_exp2f(ls[2] - mx);
        const float inv = 1.0f / (e[0] + e[1] + e[2]);
        float o[8];
#pragma unroll
        for (int k = 0; k < 8; ++k) o[k] = 0.f;
#pragma unroll
        for (int q = 0; q < 3; ++q) { const float wq = e[q] * inv;
            o[0] += wq * bflo(w[q].x); o[1] += wq * bfhi(w[q].x); o[2] += wq * bflo(w[q].y); o[3] += wq * bfhi(w[q].y);
            o[4] += wq * bflo(w[q].z); o[5] += wq * bfhi(w[q].z); o[6] += wq * bflo(w[q].w); o[7] += wq * bfhi(w[q].w); }
        float ss = 0.f;
#pragma unroll
        for (int k = 0; k < 8; ++k) ss += o[k] * o[k];
        ss = sum8_dpp(ss);
        const float rs = 1.0f / sqrtf(ss * (1.0f / 64.0f) + RMS_EPS);
        v4u ow; ow.x = pk2(o[0] * rs * g0[0], o[1] * rs * g0[1]); ow.y = pk2(o[2] * rs * g0[2], o[3] * rs * g0[3]);
        ow.z = pk2(o[4] * rs * g1[0], o[5] * rs * g1[1]); ow.w = pk2(o[6] * rs * g1[2], o[7] * rs * g1[3]);
        *(v4u*)(MG + row * DM + 512 + lane * 8) = ow;
    }
}
__device__ __forceinline__ void phase_ln1(const Params& p, const int tid) {
    const int lane = tid & 63, wave = tid >> 6;
    const float* ADA = (const float*)(p.ws + WS_ADA); bf16raw* H = (bf16raw*)(p.ws + WS_H); float* ST = (float*)(p.ws + WS_ST1);
    v4f lg[4], lb[4];
#pragma unroll
    for (int j = 0; j < 4; ++j) { lg[j] = *(const v4f*)(p.ln1_g + 4 * lane + 256 * j); lb[j] = *(const v4f*)(p.ln1_b + 4 * lane + 256 * j); }
    for (size_t row = (size_t)blockIdx.x * 8 + wave; row < (size_t)MTOK; row += (size_t)gridDim.x * 8) {
        const int b = (int)(row >> 12);
        const v4f* yr = (const v4f*)(p.out + row * DM) + lane;
        v4f v[4]; float s = 0.f;
#pragma unroll
        for (int j = 0; j < 4; ++j) { v[j] = yr[64 * j]; s += (v[j][0] + v[j][1]) + (v[j][2] + v[j][3]); }
        const float mean = wave_sum(s) * (1.0f / DM); float s2 = 0.f;
#pragma unroll
        for (int j = 0; j < 4; ++j) { v[j] = v[j] - mean; s2 += (v[j][0] * v[j][0] + v[j][1] * v[j][1]) + (v[j][2] * v[j][2] + v[j][3] * v[j][3]); }
        const float rstd = 1.0f / sqrtf(wave_sum(s2) * (1.0f / DM) + LN_EPS);
        if (lane == 0) *(v2f*)(ST + row * 2) = (v2f){mean, rstd};
        unsigned long long* o8 = (unsigned long long*)(H + row * DM) + lane;
#pragma unroll
        for (int j = 0; j < 4; ++j) { const v4f x1 = v[j] * rstd * lg[j] + lb[j];
            const v4f shf = *(const v4f*)(ADA + (size_t)b * (6 * DM) + 3 * DM + 4 * lane + 256 * j), scf = *(const v4f*)(ADA + (size_t)b * (6 * DM) + 4 * DM + 4 * lane + 256 * j);
            const v4f hv = x1 * (scf + 1.0f) + shf;
            o8[64 * j] = (unsigned long long)pk2(hv[0], hv[1]) | ((unsigned long long)pk2(hv[2], hv[3]) << 32); }
    }
}
__device__ __forceinline__ void phase_convfix(const Params& p, const int tid) {
    const float* ULAST = (const float*)(p.ws + WS_ULAST); const float* YFIRST = (const float*)(p.ws + WS_YFIRST); bf16raw* G = (bf16raw*)(p.ws + WS_G);
    constexpr int CH = DFF / 4;
    for (int i = blockIdx.x * 512 + tid; i < (MTOK / 128) * CH; i += gridDim.x * 512) {
        const int s = i / CH, c4 = (i % CH) * 4; const bool halo = (s & 31) != 0;
        v4f y[2][2];
#pragma unroll
        for (int part = 0; part < 2; ++part) { const int col = part * DFF + c4;
            y[part][0] = *(const v4f*)(YFIRST + ((size_t)s * 2 + 0) * NUP + col); y[part][1] = *(const v4f*)(YFIRST + ((size_t)s * 2 + 1) * NUP + col);
            if (halo) { const v4f u6 = *(const v4f*)(ULAST + ((size_t)(s - 1) * 2 + 0) * NUP + col), u7 = *(const v4f*)(ULAST + ((size_t)(s - 1) * 2 + 1) * NUP + col);
                const v4f w0 = *(const v4f*)(p.conv_w + col), w1 = *(const v4f*)(p.conv_w + NUP + col);
                y[part][0] += w0 * u6 + w1 * u7; y[part][1] += w0 * u7; } }
#pragma unroll
        for (int t = 0; t < 2; ++t) { float r[4];
#pragma unroll
            for (int e = 0; e < 4; ++e) { const float g = y[1][t][e]; r[e] = y[0][t][e] * g / (1.0f + __expf(-g)); }
            *(v2u*)(G + ((size_t)s * 128 + t) * DFF + c4) = (v2u){pk2(r[0], r[1]), pk2(r[2], r[3])}; }
    }
}
__device__ __forceinline__ void phase_ln2(const Params& p, const int tid) {
    const int lane = tid & 63, wave = tid >> 6;
    v4f lg[4], lb[4];
#pragma unroll
    for (int j = 0; j < 4; ++j) { lg[j] = *(const v4f*)(p.ln2_g + 4 * lane + 256 * j); lb[j] = *(const v4f*)(p.ln2_b + 4 * lane + 256 * j); }
    for (size_t row = (size_t)blockIdx.x * 8 + wave; row < (size_t)MTOK; row += (size_t)gridDim.x * 8) {
        v4f* yr = (v4f*)(p.out + row * DM) + lane;
        v4f v[4]; float s = 0.f;
#pragma unroll
        for (int j = 0; j < 4; ++j) { v[j] = yr[64 * j]; s += (v[j][0] + v[j][1]) + (v[j][2] + v[j][3]); }
        const float mean = wave_sum(s) * (1.0f / DM); float s2 = 0.f;
#pragma unroll
        for (int j = 0; j < 4; ++j) { v[j] = v[j] - mean; s2 += (v[j][0] * v[j][0] + v[j][1] * v[j][1]) + (v[j][2] * v[j][2] + v[j][3] * v[j][3]); }
        const float rstd = 1.0f / sqrtf(wave_sum(s2) * (1.0f / DM) + LN_EPS);
#pragma unroll
        for (int j = 0; j < 4; ++j) yr[64 * j] = v[j] * rstd * lg[j] + lb[j];
    }
}

#ifndef REP_FOX
#define REP_FOX 1
#endif
#ifndef REP_DIL
#define REP_DIL 1
#endif
#ifndef REPMASK
#define REPMASK 0
#endif
constexpr size_t WS_CTL = 0, CTL_ZERO_BYTES = 65536;
constexpr int LDSCTL_OFF = RING_BYTES;

constexpr int N_PHASES = 14;
__global__ void __launch_bounds__(512, 2) fwd_megakernel(Params p) {
    extern __shared__ __attribute__((aligned(16))) unsigned char lds_raw[];
    LAS unsigned char* lds = (LAS unsigned char*)lds_raw;
    cg::grid_group grid = cg::this_grid();
    const int wid_k = __builtin_amdgcn_readfirstlane(threadIdx.x >> 6);
#define MK_TID() (wid_k * 64 + lane_id())
    const int lo = p.ph_lo, hi = p.ph_hi;
    XcdBarrier bar;
    { const int t0 = MK_TID();
      for (int u = t0; u < (LDS_BYTES - LDSCTL_OFF) / 4; u += 512) ((LAS unsigned*)(lds + LDSCTL_OFF))[u] = 0u;
      __syncthreads();
      bar = xcd_barrier_post((unsigned*)(p.ws + WS_CTL), (volatile LAS unsigned*)(lds + LDSCTL_OFF) + 8, t0); }
#define IN(k) (lo <= (k) && (k) < hi)
#define SEAM(k) do { if (IN(k) && IN((k) + 1)) { if ((k) == 0) grid.sync(); else xcd_barrier(bar, MK_TID()); } } while (0)
    bf16raw* H = (bf16raw*)(p.ws + WS_H); bf16raw* Z = (bf16raw*)(p.ws + WS_Z); bf16raw* MG = (bf16raw*)(p.ws + WS_MG);
    const float* ADA = (const float*)(p.ws + WS_ADA);
    if (IN(0)) for (int rp = 0; rp <= ((REPMASK >> (0)) & 1); ++rp) { phase_prologue(p, lds, MK_TID()); } SEAM(0);
    if (IN(1)) for (int rp = 0; rp <= ((REPMASK >> (1)) & 1); ++rp) { phase_pre1(p, lds, MK_TID()); } SEAM(1);
    if (IN(2)) for (int rp = 0; rp <= ((REPMASK >> (2)) & 1); ++rp) {
        phase_fabs(p, MK_TID());
        pg8::Gemm g{H, (const bf16raw*)(p.ws + WS_WIN), MTOK, NZ, DM}; pg8::StaticOrder S; S.init(MTOK, NZ, gridDim.x, (int)blockIdx.x);
        pg8::EpiIn E{Z, (const float*)(p.ws + WS_CS)};
        pg8::gemm_phase<pg8::EpiIn, pg8::StaticOrder, true, true>(lds, g, S, E, MK_TID());
    } SEAM(2);
    if (IN(3)) for (int rp = 0; rp <= ((REPMASK >> (3)) & 1); ++rp) {
        { const int G = gridDim.x, bx = blockIdx.x, vcu = (G % 8 == 0) ? (bx % 8) * (G / 8) + bx / 8 : bx, per = (1024 + G - 1) / G;
          const int ftid = MK_TID();
          for (int rep = 0; rep < REP_FOX; ++rep)
          for (int u = vcu * per; u < (vcu + 1) * per && u < 1024; ++u) { const int bh = u >> 3, j = u & 7;
              fox::fox_unit<8>(bh >> 3, bh & 7, 15 - j, Z, (const float*)(p.ws + WS_FABS), p.ws + WS_KXT, MG, p.gn_a, lds, ftid);
              fox::fox_unit<8>(bh >> 3, bh & 7, j, Z, (const float*)(p.ws + WS_FABS), p.ws + WS_KXT, MG, p.gn_a, lds, ftid); } }
        { const int G = gridDim.x, bx = blockIdx.x, vcu = (G % 8 == 0) ? (bx % 8) * (G / 8) + bx / 8 : bx, per = (dil::N_UNITS + G - 1) / G;
          const int ulo = vcu * per, uhi = (vcu + 1) * per < dil::N_UNITS ? (vcu + 1) * per : dil::N_UNITS;
          for (int rep = 0; rep < REP_DIL; ++rep) dil::dil_phase(ulo, uhi, Z, (bf16raw*)(p.ws + WS_OP), (float*)(p.ws + WS_LSE), lds, MK_TID()); }
    } SEAM(3);
    if (IN(4)) for (int rp = 0; rp <= ((REPMASK >> (4)) & 1); ++rp) { phase_merge(p, MK_TID()); } SEAM(4);
    if (IN(5)) for (int rp = 0; rp <= ((REPMASK >> (5)) & 1); ++rp) {
        pg8::Gemm g{MG, (const bf16raw*)(p.ws + WS_WOUT), MTOK, DM, DM}; pg8::StaticOrder S; S.init(MTOK, DM, gridDim.x, (int)blockIdx.x);
        pg8::EpiOut E{p.x, p.out, ADA};
        pg8::gemm_phase<pg8::EpiOut, pg8::StaticOrder, true, true>(lds, g, S, E, MK_TID());
    } SEAM(5);
    if (IN(6)) for (int rp = 0; rp <= ((REPMASK >> (6)) & 1); ++rp) { phase_ln1(p, MK_TID()); } SEAM(6);
    if (IN(7)) for (int rp = 0; rp <= ((REPMASK >> (7)) & 1); ++rp) {
        pg8::Gemm g{H, (const bf16raw*)(p.ws + WS_WUP), MTOK, NUP, DM}; pg8::StaticOrder S; S.init(MTOK, NUP, gridDim.x, (int)blockIdx.x);
        pg8::EpiUpConv E{(bf16raw*)(p.ws + WS_G), (float*)(p.ws + WS_ULAST), (float*)(p.ws + WS_YFIRST), p.conv_w, p.conv_b};
        pg8::gemm_phase<pg8::EpiUpConv, pg8::StaticOrder, true, true, 1>(lds, g, S, E, MK_TID());
    } SEAM(7);
    if (IN(8)) for (int rp = 0; rp <= ((REPMASK >> (8)) & 1); ++rp) { phase_convfix(p, MK_TID()); } SEAM(8);
    if (IN(11)) for (int rp = 0; rp <= ((REPMASK >> (11)) & 1); ++rp) {
        pg8::Gemm g{(const bf16raw*)(p.ws + WS_G), (const bf16raw*)(p.ws + WS_WDN), MTOK, DM, DFF}; pg8::StaticOrder S; S.init(MTOK, DM, gridDim.x, (int)blockIdx.x);
        pg8::EpiDown E{p.out, (const float*)(p.ws + WS_ST1), ADA, p.ln1_g, p.ln1_b};
        pg8::gemm_phase<pg8::EpiDown, pg8::StaticOrder, true, true>(lds, g, S, E, MK_TID());
    } SEAM(11);
    if (IN(12)) for (int rp = 0; rp <= ((REPMASK >> (12)) & 1); ++rp) { phase_ln2(p, MK_TID()); }
#undef IN
#undef SEAM
}

extern "C" void kernel_launch(void* const* d_in, const int* in_sizes, int n_in, void* d_out, int out_size, void* d_ws, size_t ws_size, hipStream_t stream) {
    static int grid = 0;
    if (grid == 0) {
        if (n_in != 18 || out_size != MTOK * DM || ws_size < WS_END) { fprintf(stderr, "kernel_launch: unexpected problem (n_in %d out %d ws %zu)\n", n_in, out_size, ws_size); grid = -1; return; }
        int dev = 0, cus = 0, per_cu = 0;
        hipGetDevice(&dev); hipDeviceGetAttribute(&cus, hipDeviceAttributeMultiprocessorCount, dev);
        if (hipFuncSetAttribute((const void*)fwd_megakernel, hipFuncAttributeMaxDynamicSharedMemorySize, LDS_BYTES) != hipSuccess) { fprintf(stderr, "kernel_launch: hipFuncSetAttribute failed\n"); grid = -1; return; }
        if (hipOccupancyMaxActiveBlocksPerMultiprocessor(&per_cu, (const void*)fwd_megakernel, 512, LDS_BYTES) != hipSuccess || per_cu < 1) { fprintf(stderr, "kernel_launch: occupancy query says %d\n", per_cu); per_cu = 1; }
        (void)hipGetLastError();
        if (per_cu > 1) per_cu = 1;
        grid = cus * per_cu;
    }
    if (grid < 0) return;
    Params p{};
    p.x = (const float*)d_in[0]; p.c = (const float*)d_in[1]; p.pos = (const int*)d_in[2]; p.w_ada = (const float*)d_in[3]; p.b_ada = (const float*)d_in[4];
    p.w_in = (const float*)d_in[5]; p.b_fgate = (const float*)d_in[6]; p.gn_a = (const float*)d_in[7]; p.gn_b = (const float*)d_in[8]; p.w_out = (const float*)d_in[9];
    p.ln1_g = (const float*)d_in[10]; p.ln1_b = (const float*)d_in[11]; p.w_up = (const float*)d_in[12]; p.conv_w = (const float*)d_in[13]; p.conv_b = (const float*)d_in[14];
    p.w_down = (const float*)d_in[15]; p.ln2_g = (const float*)d_in[16]; p.ln2_b = (const float*)d_in[17];
    p.out = (float*)d_out; p.ws = (unsigned char*)d_ws;
#if MK_SPLIT
    for (int ph = 0; ph < N_PHASES - 1; ++ph) { p.ph_lo = ph; p.ph_hi = ph + 1; hipLaunchKernelGGL(fwd_megakernel, dim3(grid), dim3(512), LDS_BYTES, stream, p); }
#else
    p.ph_lo = 0; p.ph_hi = N_PHASES;
    if (hipMemsetAsync((char*)d_ws + WS_CTL, 0, CTL_ZERO_BYTES, stream) != hipSuccess) { fprintf(stderr, "kernel_launch: memset failed\n"); return; }
    void* args[] = {&p};
    hipError_t e = hipLaunchCooperativeKernel((const void*)fwd_megakernel, dim3(grid), dim3(512), args, LDS_BYTES, stream);
    if (e != hipSuccess) fprintf(stderr, "cooperative launch failed: %s (grid %d)\n", hipGetErrorString(e), grid);
#endif
}
```
